# Optimizing an MI355X kernel written in HIP

```python
import jax, jax.numpy as jnp
from jax import lax
import numpy as np

D_MODEL = 2048
BATCH = 32
SEQ = 256
DEPTH = 4
DEC_BATCH = 4
DEC_SEQ = 2048
PAST_LEN = 256

GRID_W = 64
N_EVEN = (DEPTH + 1) // 2
N_ODD = DEPTH // 2
H_A = 8
DH_A = 128
NA = H_A * DH_A
WIN_R = 8
WIN_C = 16
NB = 1024
CONV_W = 3
IN_AB = 3 * NA + 3 * NB
H_C = 16
Q_LORA = 512
KV_LORA = 256
NOPE = 128
ROPE = 64
V_DIM = 128
QK_DIM = NOPE + ROPE
ROPE_BASE = 10000.0
D_FF = -(-8 * D_MODEL // (3 * 256)) * 256
Q_BLOCK = 128
EPS = 1e-6

kernel_name = "hybrid_nat_conv_mla_diffusion_step"


def rms_norm(x, g):
    xf = x.astype(jnp.float32)
    y = xf * lax.rsqrt(jnp.mean(xf * xf, axis=-1, keepdims=True) + EPS)
    return (y * g.astype(jnp.float32)).astype(x.dtype)


def adaln(cond, w, b):
    m = jax.nn.silu(cond) @ w + b
    return jnp.split(m[..., None, :], 6, axis=-1)


def modulate(x, g, shift, scale):
    return rms_norm(x, g) * (1.0 + scale) + shift


def _heads(t, n_heads):
    b, l, _ = t.shape
    return t.reshape(b, l, n_heads, -1).transpose(0, 2, 1, 3)


def _merge(t):
    b, n, l, d = t.shape
    return t.transpose(0, 2, 1, 3).reshape(b, l, n * d)


def attend(q, k, v, scale):
    b, h, lq, dq = q.shape
    nb = lq // Q_BLOCK
    qb = q.reshape(b, h, nb, Q_BLOCK, dq).transpose(2, 0, 1, 3, 4)

    def one(qi):
        s = jnp.einsum('bhqd,bhkd->bhqk', qi, k, preferred_element_type=jnp.float32) * scale
        p = jax.nn.softmax(s, axis=-1).astype(v.dtype)
        return jnp.einsum('bhqk,bhkd->bhqd', p, v)

    o = lax.map(one, qb)
    return o.transpose(1, 2, 0, 3, 4).reshape(b, h, lq, -1)


def axial_rope(x, n_tok):
    t = jnp.arange(n_tok)
    half = x.shape[-1] // 2
    freqs = ROPE_BASE ** (-jnp.arange(half // 2, dtype=jnp.float32) / (half // 2))

    def rot(xa, pos):
        ang = pos.astype(jnp.float32)[:, None] * freqs
        cos, sin = jnp.cos(ang), jnp.sin(ang)
        x1, x2 = jnp.split(xa.astype(jnp.float32), 2, axis=-1)
        return jnp.concatenate([x1 * cos - x2 * sin, x1 * sin + x2 * cos], axis=-1)

    xr, xc = jnp.split(x, 2, axis=-1)
    return jnp.concatenate([rot(xr, t // GRID_W), rot(xc, t % GRID_W)], axis=-1).astype(x.dtype)


def short_conv(u, w):
    return lax.conv_general_dilated(u, w[:, None, :], window_strides=(1,), padding=((1, 1),),
                                    dimension_numbers=('NWC', 'WIO', 'NWC'),
                                    feature_group_count=u.shape[-1])


def ab_split(h, w_in, g_qn, g_kn, conv_w):
    proj = h @ w_in
    q, k, v, gb, gc, u = jnp.split(proj, [NA, 2 * NA, 3 * NA, 3 * NA + NB, 3 * NA + 2 * NB], axis=-1)
    q = rms_norm(_heads(q, H_A), g_qn)
    k = rms_norm(_heads(k, H_A), g_kn)
    v = _heads(v, H_A)
    y_b = gb * short_conv(gc * u, conv_w)
    return q, k, v, y_b


def neighbourhood_attention(q, k, v, ctx_k, ctx_v, rpb):
    b, h, n, dh = q.shape
    rows = n // GRID_W
    kr = min(WIN_R, rows)
    r = jnp.arange(rows)
    rs = jnp.clip(r - kr // 2, 0, rows - kr)
    key_rows = rs[:, None] + jnp.arange(kr)
    j = jnp.arange(GRID_W)
    cs = jnp.clip(j - WIN_C // 2, 0, GRID_W - WIN_C)
    col_in = (j[None, :] >= cs[:, None]) & (j[None, :] < cs[:, None] + WIN_C)
    qg = q.reshape(b, h, rows, GRID_W, dh)
    kg = k.reshape(b, h, rows, GRID_W, dh)[:, :, key_rows]
    vg = v.reshape(b, h, rows, GRID_W, dh)[:, :, key_rows]
    scale = dh ** -0.5
    s_loc = jnp.einsum('bhrqd,bhrikd->bhrqik', qg, kg, preferred_element_type=jnp.float32) * scale
    ro = key_rows - r[:, None] + (WIN_R - 1)
    co = jnp.clip(j[None, :] - j[:, None] + (WIN_C - 1), 0, 2 * WIN_C - 2)
    bias = rpb[:, ro[:, None, :, None], co[None, :, None, :]].astype(jnp.float32)
    s_loc = jnp.where(col_in[None, None, None, :, None, :], s_loc + bias[None], -jnp.inf)
    s_ctx = jnp.einsum('bhrqd,bhcd->bhrqc', qg, ctx_k, preferred_element_type=jnp.float32) * scale
    lw = kr * GRID_W
    s = jnp.concatenate([s_loc.reshape(b, h, rows, GRID_W, lw), s_ctx], axis=-1)
    p = jax.nn.softmax(s, axis=-1).astype(v.dtype)
    o = (jnp.einsum('bhrqik,bhrikd->bhrqd', p[..., :lw].reshape(b, h, rows, GRID_W, kr, GRID_W), vg)
         + jnp.einsum('bhrqc,bhcd->bhrqd', p[..., lw:], ctx_v))
    return o.reshape(b, h, n, dh)


def mla_latents(h, w_down, g_cq, g_ckv):
    cq, ckv, kr = jnp.split(h @ w_down, [Q_LORA, Q_LORA + KV_LORA], axis=-1)
    return rms_norm(cq, g_cq), rms_norm(ckv, g_ckv), kr


def mla_q(cq, w_uq, g_qn):
    return rms_norm(_heads(cq @ w_uq, H_C), g_qn)


def mla_kv(ckv, kr, w_ukv, g_kn):
    kv = _heads(ckv @ w_ukv, H_C)
    k_nope, v = jnp.split(kv, [NOPE], axis=-1)
    k_r = jnp.broadcast_to(kr[:, None], k_nope.shape[:-1] + (ROPE,))
    k = rms_norm(jnp.concatenate([k_nope, k_r], axis=-1), g_kn)
    return k, v


def rope_part(t):
    return jnp.concatenate([t[..., :NOPE], axial_rope(t[..., NOPE:], t.shape[-2])], axis=-1)


def swiglu(h, w_in, w_out):
    gate, up = jnp.split(h @ w_in, 2, axis=-1)
    return (jax.nn.silu(gate) * up) @ w_out


def setup_inputs(seed: int = 0) -> dict:
    key = jax.random.key(seed)
    ks = iter(jax.random.split(key, 32))

    def nrm(shape, scale):
        return jax.random.normal(next(ks), shape, jnp.float32) * scale

    def gain(shape):
        return 1.0 + nrm(shape, 0.02)

    D = D_MODEL
    return {
        'x_prompt': nrm((BATCH, SEQ, D), 1.0),
        'x_sample': nrm((DEC_BATCH, DEC_SEQ, D), 1.0),
        'cache_nat_k': nrm((DEC_BATCH, N_EVEN, H_A, PAST_LEN, DH_A), 1.0),
        'cache_nat_v': nrm((DEC_BATCH, N_EVEN, H_A, PAST_LEN, DH_A), 1.0),
        'cache_mla_ckv': nrm((DEC_BATCH, N_ODD, PAST_LEN, KV_LORA), 1.0),
        'cache_mla_krope': nrm((DEC_BATCH, N_ODD, PAST_LEN, ROPE), 1.0),
        'c': nrm((DEC_BATCH, D), 1.0),
        'c_ctx': nrm((D,), 1.0),
        'norm1_g': gain((DEPTH, D)),
        'norm2_g': gain((DEPTH, D)),
        'w_ada': nrm((DEPTH, D, 6 * D), 0.5 * D ** -0.5),
        'b_ada': nrm((DEPTH, 6 * D), 0.01),
        'w_in_ab': nrm((N_EVEN, D, IN_AB), D ** -0.5),
        'g_qn_a': gain((N_EVEN, DH_A)),
        'g_kn_a': gain((N_EVEN, DH_A)),
        'rpb_a': nrm((N_EVEN, H_A, 2 * WIN_R - 1, 2 * WIN_C - 1), 0.1),
        'conv_b_w': nrm((N_EVEN, CONV_W, NB), CONV_W ** -0.5),
        'w_out_ab': nrm((N_EVEN, NA + NB, D), (NA + NB) ** -0.5),
        'w_down_c': nrm((N_ODD, D, Q_LORA + KV_LORA + ROPE), D ** -0.5),
        'g_cq': gain((N_ODD, Q_LORA)),
        'g_ckv': gain((N_ODD, KV_LORA)),
        'w_uq_c': nrm((N_ODD, Q_LORA, H_C * QK_DIM), Q_LORA ** -0.5),
        'w_ukv_c': nrm((N_ODD, KV_LORA, H_C * (NOPE + V_DIM)), KV_LORA ** -0.5),
        'g_qn_c': gain((N_ODD, QK_DIM)),
        'g_kn_c': gain((N_ODD, QK_DIM)),
        'w_o_c': nrm((N_ODD, H_C * V_DIM, D), (H_C * V_DIM) ** -0.5),
        'w_ffn_in': nrm((DEPTH, D, 2 * D_FF), D ** -0.5),
        'w_ffn_out': nrm((DEPTH, D_FF, D), D_FF ** -0.5),
    }


def reference(x_prompt, x_sample, cache_nat_k, cache_nat_v, cache_mla_ckv, cache_mla_krope, c, c_ctx,
              norm1_g, norm2_g, w_ada, b_ada, w_in_ab, g_qn_a, g_kn_a, rpb_a, conv_b_w, w_out_ab,
              w_down_c, g_cq, g_ckv, w_uq_c, w_ukv_c, g_qn_c, g_kn_c, w_o_c, w_ffn_in, w_ffn_out):
    xc = x_prompt
    xs = x_sample
    nat_k, nat_v, mla_ckv, mla_kr = [], [], [], []
    for l in range(DEPTH):
        i = l // 2
        mc = adaln(c_ctx, w_ada[l], b_ada[l])
        ms = adaln(c, w_ada[l], b_ada[l])
        hc = modulate(xc, norm1_g[l], mc[0], mc[1])
        hs = modulate(xs, norm1_g[l], ms[0], ms[1])
        if l % 2 == 0:
            q, k, v, yb = ab_split(hc, w_in_ab[i], g_qn_a[i], g_kn_a[i], conv_b_w[i])
            ya = attend(q, k, v, DH_A ** -0.5)
            yc = jnp.concatenate([_merge(ya), yb], axis=-1) @ w_out_ab[i]
            nat_k.append(k)
            nat_v.append(v)
            q, k, v, yb = ab_split(hs, w_in_ab[i], g_qn_a[i], g_kn_a[i], conv_b_w[i])
            ya = neighbourhood_attention(q, k, v, cache_nat_k[:, i], cache_nat_v[:, i], rpb_a[i])
            ys = jnp.concatenate([_merge(ya), yb], axis=-1) @ w_out_ab[i]
        else:
            scale = QK_DIM ** -0.5
            cq, ckv, kr = mla_latents(hc, w_down_c[i], g_cq[i], g_ckv[i])
            q = mla_q(cq, w_uq_c[i], g_qn_c[i])
            k, v = mla_kv(ckv, kr, w_ukv_c[i], g_kn_c[i])
            yc = _merge(attend(q, k, v, scale)) @ w_o_c[i]
            mla_ckv.append(ckv)
            mla_kr.append(kr)
            cq, ckv, kr = mla_latents(hs, w_down_c[i], g_cq[i], g_ckv[i])
            q = rope_part(mla_q(cq, w_uq_c[i], g_qn_c[i]))
            k, v = mla_kv(ckv, kr, w_ukv_c[i], g_kn_c[i])
            k = rope_part(k)
            kx, vx = mla_kv(cache_mla_ckv[:, i], cache_mla_krope[:, i], w_ukv_c[i], g_kn_c[i])
            o = attend(q, jnp.concatenate([kx, k], axis=2), jnp.concatenate([vx, v], axis=2), scale)
            ys = _merge(o) @ w_o_c[i]
        xc = xc + mc[2] * yc
        xs = xs + ms[2] * ys
        xc = xc + mc[5] * swiglu(modulate(xc, norm2_g[l], mc[3], mc[4]), w_ffn_in[l], w_ffn_out[l])
        xs = xs + ms[5] * swiglu(modulate(xs, norm2_g[l], ms[3], ms[4]), w_ffn_in[l], w_ffn_out[l])
    return (xc, xs, jnp.stack(nat_k, axis=1), jnp.stack(nat_v, axis=1),
            jnp.stack(mla_ckv, axis=1), jnp.stack(mla_kr, axis=1))
```

```cpp
#include <hip/hip_runtime.h>
#include <cstdio>
#include <cstdint>
#include <cstddef>
namespace pg8 {
#define PG8_LAS __attribute__((address_space(3)))
typedef unsigned short bf16_t;
typedef short bf16x8 __attribute__((ext_vector_type(8)));
typedef float f32x4 __attribute__((ext_vector_type(4)));
typedef unsigned u32x4 __attribute__((ext_vector_type(4)));
constexpr int BM = 256, BK = 64, HALF = 128, HTB = HALF * BK * 2  , STAGE_BYTES = 8 * HTB, NXCD = 8, WGM = 8;

__host__ __device__ __forceinline__ int lds_byte(int r, int c) { const int st = (r >> 4) * 2 + (c >> 5), rr = r & 15, cc = c & 31, ob = rr * 64 + cc * 2; return st * 1024 + (ob ^ (((ob >> 9) & 1) << 5)); }
__host__ __device__ __forceinline__ void stage_rc(int b, int& R, int& C) { const int st = b / 1024, sb = b % 1024, swz = sb ^ (((sb >> 9) & 1) << 5); R = (st >> 1) * 16 + swz / 64; C = (st & 1) * 32 + (swz % 64) / 2; }
__host__ __device__ __forceinline__ int perm32(int rho) { const int n = rho >> 4, i = rho & 15; return 8 * (i >> 2) + 4 * n + (i & 3); }

struct Unit { int pm, pn; };
struct Gemm { const bf16_t* A; const bf16_t* Bt; int M, N, K; };

struct StaticOrder {
    int nM, nN, nwg, G, c;
    __host__ __device__ void init(int M, int N, int G_, int c_) { nM = M / BM; nN = N / BM; nwg = nM * nN; G = G_; c = c_; }
    __host__ __device__ bool next(int i, Unit& u) const {
        const long L = (long)i * G + c; if (L >= nwg) return false;
        int wgid = (int)L; { const int q = nwg / NXCD, r = nwg % NXCD, xcd = wgid % NXCD, off = wgid / NXCD; wgid = (xcd < r ? xcd * (q + 1) : r * (q + 1) + (xcd - r) * q) + off; }
        const int nig = WGM * nN, gid = wgid / nig, fm = gid * WGM, gsz = (nM - fm) < WGM ? (nM - fm) : WGM;
        u.pm = fm + ((wgid % nig) % gsz); u.pn = (wgid % nig) / gsz; return true;
    }
    __device__ __forceinline__ void a_ready(const Unit&) const {}
    __device__ __forceinline__ void done(const Unit&) const {}
};
__device__ __forceinline__ unsigned cvt_pk_bf16(float lo, float hi) { unsigned r; asm volatile("v_cvt_pk_bf16_f32 %0, %1, %2" : "=v"(r) : "v"(lo), "v"(hi)); return r; }

__device__ __forceinline__ int cond_of_pm(int pm) { return pm < 32 ? 0 : 1 + ((pm - 32) >> 3); }

struct EpiBf16P {
    static constexpr bool PERM = true, AFTER_DRAIN = false;
    bf16_t* O; int ldc;
    __device__ __forceinline__ void operator()(const f32x4 (&acc)[2][2][4][2], const Unit& u, int wr, int wc, int fr, int fq) const {
        const int row0 = u.pm * BM + wr * 64 + fr, col0 = u.pn * BM + wc * 32 + 8 * fq;
#pragma unroll
        for (int ai = 0; ai < 2; ++ai)
#pragma unroll
            for (int m = 0; m < 4; ++m) { bf16_t* rowp = O + (size_t)(row0 + ai * HALF + m * 16) * ldc + col0;
#pragma unroll
                for (int bj = 0; bj < 2; ++bj) { const f32x4 v0 = acc[ai][bj][m][0], v1 = acc[ai][bj][m][1];
                    u32x4 w; w.x = cvt_pk_bf16(v0[0], v0[1]); w.y = cvt_pk_bf16(v0[2], v0[3]); w.z = cvt_pk_bf16(v1[0], v1[1]); w.w = cvt_pk_bf16(v1[2], v1[3]);
                    *(u32x4*)(rowp + bj * HALF) = w; } }
    }
};
struct EpiF32P {
    static constexpr bool PERM = false, AFTER_DRAIN = false;
    float* C; int ldc;
    __device__ __forceinline__ void operator()(const f32x4 (&acc)[2][2][4][2], const Unit& u, int wr, int wc, int fr, int fq) const {
        const int row0 = u.pm * BM + wr * 64 + fr, col0 = u.pn * BM + wc * 32 + 4 * fq;
#pragma unroll
        for (int ai = 0; ai < 2; ++ai)
#pragma unroll
            for (int m = 0; m < 4; ++m) { float* rowp = C + (size_t)(row0 + ai * HALF + m * 16) * ldc + col0;
#pragma unroll
                for (int bj = 0; bj < 2; ++bj)
#pragma unroll
                    for (int n = 0; n < 2; ++n) *(f32x4*)(rowp + bj * HALF + n * 16) = acc[ai][bj][m][n]; }
    }
};
struct EpiRes {
    static constexpr bool PERM = false, AFTER_DRAIN = false;
    const float* base_c; const float* base_s; float* out; const float* gate;
    __device__ __forceinline__ void operator()(const f32x4 (&acc)[2][2][4][2], const Unit& u, int wr, int wc, int fr, int fq) const {
        const int row0 = u.pm * BM + wr * 64 + fr, col0 = u.pn * BM + wc * 32 + 4 * fq;
        const float* g = gate + (size_t)cond_of_pm(u.pm) * 12288 + col0;
        const float* base = u.pm < 32 ? base_c : base_s;
        f32x4 gv[2][2];
#pragma unroll
        for (int bj = 0; bj < 2; ++bj)
#pragma unroll
            for (int n = 0; n < 2; ++n) gv[bj][n] = *(const f32x4*)(g + bj * HALF + n * 16);
#pragma unroll
        for (int ai = 0; ai < 2; ++ai)
#pragma unroll
            for (int m = 0; m < 4; ++m) { const size_t off = (size_t)(row0 + ai * HALF + m * 16) * 2048 + col0;
#pragma unroll
                for (int bj = 0; bj < 2; ++bj)
#pragma unroll
                    for (int n = 0; n < 2; ++n) { const f32x4 bs = *(const f32x4*)(base + off + bj * HALF + n * 16);
                        *(f32x4*)(out + off + bj * HALF + n * 16) = bs + gv[bj][n] * acc[ai][bj][m][n]; }
                if (m & 1) asm volatile("" ::: "memory"); }
    }
};
__device__ __forceinline__ float silu_f(float x) { return x * __builtin_amdgcn_rcpf(1.0f + __builtin_amdgcn_exp2f(-1.4426950408889634f * x)); }
struct EpiSwiGLU {
    static constexpr bool PERM = true, AFTER_DRAIN = false;
    bf16_t* O; int ldc;
    __device__ __forceinline__ void operator()(const f32x4 (&acc)[2][2][4][2], const Unit& u, int wr, int wc, int fr, int fq) const {
        const int row0 = u.pm * BM + wr * 64 + fr, col0 = u.pn * HALF + wc * 32 + 8 * fq;
#pragma unroll
        for (int ai = 0; ai < 2; ++ai)
#pragma unroll
            for (int m = 0; m < 4; ++m) { bf16_t* rowp = O + (size_t)(row0 + ai * HALF + m * 16) * ldc + col0;
                const f32x4 g0 = acc[ai][0][m][0], g1 = acc[ai][0][m][1], u0 = acc[ai][1][m][0], u1 = acc[ai][1][m][1];
                u32x4 w; w.x = cvt_pk_bf16(silu_f(g0[0]) * u0[0], silu_f(g0[1]) * u0[1]); w.y = cvt_pk_bf16(silu_f(g0[2]) * u0[2], silu_f(g0[3]) * u0[3]);
                w.z = cvt_pk_bf16(silu_f(g1[0]) * u1[0], silu_f(g1[1]) * u1[1]); w.w = cvt_pk_bf16(silu_f(g1[2]) * u1[2], silu_f(g1[3]) * u1[3]);
                *(u32x4*)rowp = w; }
    }
};
template <class Epi, class Sched, bool ALIGN_EPI = false, bool SP2 = false>
__device__ __forceinline__ void gemm_phase(PG8_LAS unsigned char* lds, const Gemm g, const Sched& S, const Epi& E) {
    int tid_ = threadIdx.x; asm volatile("" : "+v"(tid_));
    const int tid = tid_, wid = __builtin_amdgcn_readfirstlane(tid >> 6), lane = tid & 63, wr = wid >> 2, wc = wid & 3, fr = lane & 15, fq = lane >> 4;
    const int K = g.K, nt = K / BK;
    unsigned voffA[2], voffB[2];
#pragma unroll
    for (int i = 0; i < 2; ++i) { int R, C; stage_rc(tid * 16 + i * 8192, R, C); const int Rb = Epi::PERM ? ((R & ~31) + perm32(R & 31)) : R;
        voffA[i] = (unsigned)(R * K + C) * 2u; voffB[i] = (unsigned)(Rb * K + C) * 2u; }
    const size_t kstep = (size_t)(BK * 2);
    const size_t hstep = (size_t)HALF * K * 2;
    const size_t tstep = 2 * hstep;
    const unsigned ldsw = (unsigned)wid * 1024u;
    const int aoff = lds_byte(wr * 64 + fr, fq * 8), boff = lds_byte(wc * 32 + fr, fq * 8);
#define PG8_SA(b, h) (((b) * 2 + (h)) * HTB)
#define PG8_SB(b, h) ((4 + (b) * 2 + (h)) * HTB)
#define PG8_STAGE(bufoff, gbase, voff) do { _Pragma("unroll") for (int _i = 0; _i < 2; ++_i) \
        __builtin_amdgcn_global_load_lds((const unsigned*)((const char*)(gbase) + (voff)[_i]), (PG8_LAS unsigned*)(lds + (bufoff) + ldsw + _i * 8192), 16, 0, 0); } while (0)
#define PG8_LDA(dst, b, h) do { _Pragma("unroll") for (int m = 0; m < 4; ++m) _Pragma("unroll") for (int k = 0; k < 2; ++k) dst[m][k] = *(const PG8_LAS bf16x8*)(lds + PG8_SA(b, h) + aoff + m * 2048 + k * 1024); } while (0)
#define PG8_LDB(dst, b, h) do { _Pragma("unroll") for (int n = 0; n < 2; ++n) _Pragma("unroll") for (int k = 0; k < 2; ++k) dst[n][k] = *(const PG8_LAS bf16x8*)(lds + PG8_SB(b, h) + boff + n * 2048 + k * 1024); } while (0)
#define PG8_MMA(ai, bj, At, Bt) do { __builtin_amdgcn_s_setprio(1); _Pragma("unroll") for (int m = 0; m < 4; ++m) _Pragma("unroll") for (int n = 0; n < 2; ++n) _Pragma("unroll") for (int k = 0; k < 2; ++k) \
        acc[ai][bj][m][n] = __builtin_amdgcn_mfma_f32_16x16x32_bf16(Bt[n][k], At[m][k], acc[ai][bj][m][n], 0, 0, 0); __builtin_amdgcn_s_setprio(0); } while (0)
#define PG8_WAIT_V(n) asm volatile("s_waitcnt vmcnt(" #n ")" ::: "memory")
#define PG8_WAIT_L(n) asm volatile("s_waitcnt lgkmcnt(" #n ")" ::: "memory")
#define PG8_BAR __builtin_amdgcn_s_barrier()
#define PG8_SCHED __builtin_amdgcn_sched_barrier(0)
    Unit cur, nxt; int ui = 0;
    if (!S.next(0, cur)) return;
    f32x4 acc[2][2][4][2];
#pragma unroll
    for (int a = 0; a < 2; ++a)
#pragma unroll
        for (int b = 0; b < 2; ++b)
#pragma unroll
            for (int m = 0; m < 4; ++m)
#pragma unroll
                for (int n = 0; n < 2; ++n) acc[a][b][m][n] = (f32x4){0.f, 0.f, 0.f, 0.f};
    bf16x8 At[4][2], B0[2][2], B1[2][2];
    const char* cA = (const char*)g.A + (size_t)cur.pm * tstep; const char* cB = (const char*)g.Bt + (size_t)cur.pn * tstep;
    S.a_ready(cur);
    if constexpr (SP2) {
        PG8_STAGE(PG8_SB(0, 0), cB, voffB); PG8_STAGE(PG8_SB(0, 1), cB + hstep, voffB); PG8_STAGE(PG8_SA(0, 0), cA, voffA); PG8_STAGE(PG8_SA(0, 1), cA + hstep, voffA);
        if (wr == 1) PG8_BAR;
        PG8_WAIT_V(2); PG8_BAR;
        PG8_STAGE(PG8_SB(1, 0), cB + kstep, voffB); PG8_STAGE(PG8_SA(1, 0), cA + kstep, voffA); PG8_STAGE(PG8_SB(1, 1), cB + hstep + kstep, voffB);
        PG8_WAIT_V(6); PG8_BAR;
    } else {
        PG8_STAGE(PG8_SB(0, 0), cB, voffB); PG8_STAGE(PG8_SA(0, 0), cA, voffA); PG8_STAGE(PG8_SB(0, 1), cB + hstep, voffB); PG8_STAGE(PG8_SA(0, 1), cA + hstep, voffA);
        if (wr == 1) PG8_BAR;
        PG8_WAIT_V(4); PG8_BAR;
        PG8_STAGE(PG8_SB(1, 0), cB + kstep, voffB); PG8_STAGE(PG8_SA(1, 0), cA + kstep, voffA); PG8_STAGE(PG8_SB(1, 1), cB + hstep + kstep, voffB);
        PG8_WAIT_V(6); PG8_BAR;
    }
    for (;;) {
        const bool has_next = S.next(ui + 1, nxt);
        const char* nA = has_next ? (const char*)g.A + (size_t)nxt.pm * tstep : cA; const char* nB = has_next ? (const char*)g.Bt + (size_t)nxt.pn * tstep : cB;
        for (int t = 0; t < nt; t += 2) {
            const bool last = (t == nt - 2);
            const char* a1 = cA + (size_t)(t + 1) * kstep;
            const char* a2 = last ? nA : cA + (size_t)(t + 2) * kstep; const char* b2 = last ? nB : cB + (size_t)(t + 2) * kstep;
            const char* a3 = a2 + kstep; const char* b3 = b2 + kstep;
            if (last && has_next) S.a_ready(nxt);
            if constexpr (SP2) {
            PG8_LDB(B0, 0, 0); PG8_LDB(B1, 0, 1); PG8_SCHED; PG8_LDA(At, 0, 0); PG8_STAGE(PG8_SA(1, 1), a1 + hstep, voffA);
            PG8_WAIT_V(8); PG8_WAIT_L(0); PG8_BAR; PG8_MMA(0, 0, At, B0); PG8_MMA(0, 1, At, B1); PG8_BAR; PG8_SCHED;
            PG8_LDA(At, 0, 1); PG8_STAGE(PG8_SB(0, 0), b2, voffB); PG8_STAGE(PG8_SB(0, 1), b2 + hstep, voffB); PG8_STAGE(PG8_SA(0, 0), a2, voffA);
            PG8_WAIT_V(8); PG8_WAIT_L(0); PG8_BAR; PG8_MMA(1, 0, At, B0); PG8_MMA(1, 1, At, B1); PG8_BAR; PG8_SCHED;
            PG8_LDB(B0, 1, 0); PG8_LDB(B1, 1, 1); PG8_SCHED; PG8_LDA(At, 1, 0); PG8_STAGE(PG8_SA(0, 1), a2 + hstep, voffA);
            PG8_WAIT_V(8); PG8_WAIT_L(0); PG8_BAR; PG8_MMA(0, 0, At, B0); PG8_MMA(0, 1, At, B1); PG8_BAR; PG8_SCHED;
            PG8_LDA(At, 1, 1); PG8_STAGE(PG8_SB(1, 0), b3, voffB); PG8_STAGE(PG8_SB(1, 1), b3 + hstep, voffB); PG8_STAGE(PG8_SA(1, 0), a3, voffA);
            PG8_WAIT_V(8); PG8_WAIT_L(0); PG8_BAR; PG8_MMA(1, 0, At, B0); PG8_MMA(1, 1, At, B1); PG8_BAR; PG8_SCHED;
            } else {
            PG8_LDB(B0, 0, 0); PG8_SCHED; PG8_LDA(At, 0, 0); PG8_STAGE(PG8_SA(1, 1), a1 + hstep, voffA);
            PG8_WAIT_L(8); PG8_BAR; PG8_WAIT_L(0); PG8_MMA(0, 0, At, B0); PG8_BAR; PG8_SCHED;
            PG8_LDB(B1, 0, 1); PG8_STAGE(PG8_SB(0, 0), b2, voffB);
            PG8_BAR; PG8_WAIT_L(0); PG8_MMA(0, 1, At, B1); PG8_BAR;
            PG8_LDA(At, 0, 1); PG8_STAGE(PG8_SA(0, 0), a2, voffA);
            PG8_BAR; PG8_WAIT_L(0); PG8_MMA(1, 0, At, B0); PG8_BAR; PG8_SCHED;
            PG8_STAGE(PG8_SB(0, 1), b2 + hstep, voffB);
            PG8_WAIT_V(6); PG8_BAR; PG8_MMA(1, 1, At, B1); PG8_BAR;
            PG8_LDB(B0, 1, 0); PG8_SCHED; PG8_LDA(At, 1, 0); PG8_STAGE(PG8_SA(0, 1), a2 + hstep, voffA);
            PG8_WAIT_L(8); PG8_BAR; PG8_WAIT_L(0); PG8_MMA(0, 0, At, B0); PG8_BAR; PG8_SCHED;
            PG8_LDB(B1, 1, 1); PG8_STAGE(PG8_SB(1, 0), b3, voffB);
            PG8_BAR; PG8_WAIT_L(0); PG8_MMA(0, 1, At, B1); PG8_BAR;
            PG8_LDA(At, 1, 1); PG8_STAGE(PG8_SA(1, 0), a3, voffA);
            PG8_BAR; PG8_WAIT_L(0); PG8_MMA(1, 0, At, B0); PG8_BAR; PG8_SCHED;
            PG8_STAGE(PG8_SB(1, 1), b3 + hstep, voffB);
            PG8_WAIT_V(6); PG8_BAR; PG8_MMA(1, 1, At, B1); PG8_BAR;
            }
        }
        if constexpr (ALIGN_EPI) { if (wr == 0) PG8_BAR; }
        if constexpr (!Epi::AFTER_DRAIN) { E(acc, cur, wr, wc, fr, fq); S.done(cur); }
        if (!has_next) break;
#pragma unroll
        for (int a = 0; a < 2; ++a)
#pragma unroll
            for (int b = 0; b < 2; ++b)
#pragma unroll
                for (int m = 0; m < 4; ++m)
#pragma unroll
                    for (int n = 0; n < 2; ++n) acc[a][b][m][n] = (f32x4){0.f, 0.f, 0.f, 0.f};
        cur = nxt; cA = nA; cB = nB; ++ui;
        if constexpr (ALIGN_EPI) { if (wr == 1) PG8_BAR; }
    }
    PG8_WAIT_V(0);
    if constexpr (!ALIGN_EPI) { if (wr == 0) PG8_BAR; }
    PG8_BAR;
    if constexpr (Epi::AFTER_DRAIN) { E.fused(acc, cur, wr, wc, fr, fq, lds, wid, lane); S.done(cur); }
#undef PG8_SA
#undef PG8_SB
#undef PG8_STAGE
#undef PG8_LDA
#undef PG8_LDB
#undef PG8_MMA
#undef PG8_WAIT_V
#undef PG8_WAIT_L
#undef PG8_BAR
#undef PG8_SCHED
}
}
#define GAS __attribute__((address_space(1)))
#define LAS __attribute__((address_space(3)))
typedef unsigned short bf16;
typedef unsigned v4u __attribute__((ext_vector_type(4)));
typedef float f32x4 __attribute__((ext_vector_type(4)));
typedef short bf16x8 __attribute__((ext_vector_type(8)));
typedef GAS unsigned gu32;
typedef GAS unsigned long long gu64;
#define RLX_AGENT __ATOMIC_RELAXED, __HIP_MEMORY_SCOPE_AGENT
#define LDS_WAIT() asm volatile("s_waitcnt lgkmcnt(0)" ::: "memory")
#define VM_WAIT() asm volatile("s_waitcnt vmcnt(0)" ::: "memory")
__device__ __forceinline__ unsigned long long rt() { return __builtin_amdgcn_s_memrealtime(); }
__device__ __forceinline__ unsigned f2bf(float f) { unsigned u = __builtin_bit_cast(unsigned, f); return (u + 0x7fffu + ((u >> 16) & 1u)) >> 16; }
__device__ __forceinline__ unsigned pk2(float lo, float hi) { return f2bf(lo) | (f2bf(hi) << 16); }
#define XB_TMO      128
#define XB_XCNT(j)  (256  + 64 * (j))
#define XB_XSUB(j)  (1280 + 64 * (j))
#define XB_XGEN(j)  (2304 + 64 * (j))
#define XB_TOP      3328
#define XB_TOPGEN   3392
#define XCD_BAR_WORDS 3456
#define XB_SPIN_CAP (1u << 18)

__device__ __forceinline__ unsigned xb_ld(unsigned* p)              { return __hip_atomic_load(p, __ATOMIC_RELAXED, __HIP_MEMORY_SCOPE_AGENT); }
__device__ __forceinline__ unsigned xb_add(unsigned* p, unsigned v) { return __hip_atomic_fetch_add(p, v, __ATOMIC_RELAXED, __HIP_MEMORY_SCOPE_AGENT); }
__device__ __forceinline__ unsigned xb_xcc_id() { return (unsigned)__builtin_amdgcn_s_getreg((3 << 11) | 20) & 0xFu; }
#define XB_SPIN(cond, bar) do { unsigned _sp = 0; while (cond) { __builtin_amdgcn_s_sleep(1); \
    if ((++_sp & 255u) == 0u) { if (xb_ld(&(bar)[XB_TMO])) break; if (_sp > XB_SPIN_CAP) { atomicAdd(&(bar)[XB_TMO], 1u); break; } } } } while (0)

struct XcdBarrier {
    unsigned* bar; unsigned x;
    volatile LAS unsigned* st;
};

__device__ __forceinline__ XcdBarrier xcd_barrier_post(unsigned* bar, volatile LAS unsigned* st) {
    XcdBarrier b; b.bar = bar; b.x = xb_xcc_id(); b.st = st;
    if (threadIdx.x == 0) (void)xb_add(&bar[XB_XCNT(b.x)], 1u);
    return b;
}
__device__ __forceinline__ void xcd_barrier_complete(unsigned* bar, unsigned x, unsigned& nloc, unsigned& nx) {
    const unsigned G = gridDim.x * gridDim.y * gridDim.z;
    unsigned sum, cnt, mine, sp = 0u;
    for (;;) {
        sum = 0u; cnt = 0u; mine = 0u;
#pragma unroll
        for (unsigned j = 0; j < 16; ++j) { const unsigned c = xb_ld(&bar[XB_XCNT(j)]); sum += c; cnt += (c > 0u) ? 1u : 0u; mine = (j == x) ? c : mine; }
        if (sum == G) break;
        __builtin_amdgcn_s_sleep(1);
        if ((++sp & 255u) == 0u) { if (xb_ld(&bar[XB_TMO])) break; if (sp > XB_SPIN_CAP) { atomicAdd(&bar[XB_TMO], 1u); break; } }
    }
    nloc = mine > 0u ? mine : 1u; nx = cnt > 0u ? cnt : 1u;
}

__device__ __forceinline__ void xcd_barrier(const XcdBarrier& b) {
    asm volatile("s_waitcnt vmcnt(0)" ::: "memory");
    __syncthreads();
    if (threadIdx.x == 0) {
        unsigned* bar = b.bar;
        __builtin_amdgcn_s_waitcnt(0);
        unsigned nloc = b.st[0], nx = b.st[1];
        if (nloc == 0u) { xcd_barrier_complete(bar, b.x, nloc, nx); b.st[0] = nloc; b.st[1] = nx; }
        const unsigned old = xb_add(&bar[XB_XSUB(b.x)], 1u);
        const unsigned gen = old / nloc;
        if (old + 1u == (gen + 1u) * nloc) {
            __builtin_amdgcn_fence(__ATOMIC_RELEASE, "agent");
            asm volatile("s_waitcnt vmcnt(0)" ::: "memory");
            const unsigned og = xb_add(&bar[XB_TOP], 1u);
            const unsigned tg = og / nx;
            if (og + 1u == (tg + 1u) * nx) xb_add(&bar[XB_TOPGEN], 1u);
            else XB_SPIN(xb_ld(&bar[XB_TOPGEN]) == tg, bar);
            __builtin_amdgcn_fence(__ATOMIC_ACQUIRE, "agent");
            xb_add(&bar[XB_XGEN(b.x)], 1u);
            asm volatile("s_waitcnt vmcnt(0)" ::: "memory");
        } else {
            XB_SPIN(xb_ld(&bar[XB_XGEN(b.x)]) == gen, bar);
            __builtin_amdgcn_fence(__ATOMIC_ACQUIRE, "agent");
            asm volatile("s_waitcnt vmcnt(0)" ::: "memory");
        }
    }
    __syncthreads();
}

namespace att {
typedef unsigned short bf16_t;
using bf16x8 = __attribute__((ext_vector_type(8))) short;
using s16x4  = __attribute__((ext_vector_type(4))) short;
using f32x16 = __attribute__((ext_vector_type(16))) float;
using u32x4  = __attribute__((ext_vector_type(4))) unsigned;
constexpr int NW = 8, QBLK = 32, KVBLK = 64;
constexpr int VBUF = KVBLK * 128 * 2;
#define ATT_SBAR() __builtin_amdgcn_sched_barrier(0)
__device__ __forceinline__ int crow(int r, int hi) { return (r & 3) + 8 * (r >> 2) + 4 * hi; }
__device__ __forceinline__ unsigned cvtpk(float lo, float hi) { unsigned r; asm volatile("v_cvt_pk_bf16_f32 %0, %1, %2" : "=v"(r) : "v"(lo), "v"(hi)); return r; }
template <int DQ> __device__ __forceinline__ int kswz(int row, int colB) { return row * (DQ * 2) + (colB ^ ((row & 7) << 4)); }

__device__ __forceinline__ void partialSM(f32x16& p0, f32x16& p1, float& m_reg, float& mn, float& alpha, const float C, const float thr) {
  float pmax = p0[0];
#pragma unroll
  for (int r = 1; r < 16; ++r) pmax = fmaxf(pmax, p0[r]);
#pragma unroll
  for (int r = 0; r < 16; ++r) pmax = fmaxf(pmax, p1[r]);
  { auto rr = __builtin_amdgcn_permlane32_swap(__float_as_uint(pmax), __float_as_uint(pmax), false, false);
    pmax = fmaxf(__uint_as_float(rr[0]), __uint_as_float(rr[1])); }
  if (__builtin_expect(__all(pmax - m_reg <= thr), 1)) { mn = m_reg; alpha = 1.f; }
  else { mn = fmaxf(m_reg, pmax); alpha = __builtin_amdgcn_exp2f((m_reg - mn) * C); m_reg = mn; }
  const float mnC = -mn * C;
#pragma unroll
  for (int r = 0; r < 16; ++r) p0[r] = fmaf(p0[r], C, mnC);
#pragma unroll
  for (int r = 0; r < 16; ++r) p1[r] = fmaf(p1[r], C, mnC);
#pragma unroll
  for (int r = 0; r < 16; ++r) p0[r] = __builtin_amdgcn_exp2f(p0[r]);
}
__device__ __forceinline__ void finishSM(f32x16& p0, f32x16& p1, float alpha, float& l_reg, bf16x8& pa0, bf16x8& pa1, bf16x8& pa2, bf16x8& pa3) {
#pragma unroll
  for (int r = 0; r < 16; ++r) p1[r] = __builtin_amdgcn_exp2f(p1[r]);
  float ps = 0;
#pragma unroll
  for (int r = 0; r < 16; ++r) ps += p0[r];
#pragma unroll
  for (int r = 0; r < 16; ++r) ps += p1[r];
  { auto rr = __builtin_amdgcn_permlane32_swap(__float_as_uint(ps), __float_as_uint(ps), false, false);
    ps = __uint_as_float(rr[0]) + __uint_as_float(rr[1]); }
  l_reg = l_reg * alpha + ps;
#define ATT_PK4(P, BASE, OUT) do { unsigned a0 = cvtpk(P[BASE + 0], P[BASE + 1]), a1 = cvtpk(P[BASE + 2], P[BASE + 3]);   \
    unsigned b0 = cvtpk(P[BASE + 4], P[BASE + 5]), b1 = cvtpk(P[BASE + 6], P[BASE + 7]);                              \
    auto r0 = __builtin_amdgcn_permlane32_swap(a0, b0, false, false); auto r1 = __builtin_amdgcn_permlane32_swap(a1, b1, false, false); \
    u32x4 w = {r0[0], r1[0], r0[1], r1[1]}; OUT = *reinterpret_cast<bf16x8*>(&w); } while (0)
  ATT_PK4(p0, 0, pa0); ATT_PK4(p0, 8, pa1); ATT_PK4(p1, 0, pa2); ATT_PK4(p1, 8, pa3);
#undef ATT_PK4
}
template <int DQ> __device__ __forceinline__ void qkt(f32x16& p0, f32x16& p1, const char* Ks, const bf16x8* qr, int r32, int hi) {
  p0 = f32x16{}; p1 = f32x16{};
#pragma unroll
  for (int d0 = 0; d0 < DQ / 16; ++d0) { const int cb = (d0 * 16 + hi * 8) * 2;
    const bf16x8 b0 = *reinterpret_cast<const bf16x8*>(Ks + kswz<DQ>(r32, cb));
    const bf16x8 b1 = *reinterpret_cast<const bf16x8*>(Ks + kswz<DQ>(32 + r32, cb));
    p0 = __builtin_amdgcn_mfma_f32_32x32x16_bf16(b0, qr[d0], p0, 0, 0, 0);
    p1 = __builtin_amdgcn_mfma_f32_32x32x16_bf16(b1, qr[d0], p1, 0, 0, 0); }
}
__device__ __forceinline__ int v_st(int k, int c) { const int kk = (k & ~0xC) | ((k & 4) << 1) | ((k & 8) >> 1); return ((kk >> 3) * 4 + (c >> 5)) * 512 + ((kk & 7) * 32 + (c & 31)) * 2; }
__device__ __forceinline__ int v_rd_base(int lane) { return ((lane & 3) << 3) | (((lane >> 2) & 3) << 6) | (((lane >> 4) & 1) << 5) | (((lane >> 5) & 1) << 8); }
constexpr int v_rd_off(int d0, int ks, int half) { return d0 * 512 + ks * 4096 + half * 2048; }
template <int OFF> __device__ __forceinline__ s16x4 tr_read(int vb) {
  s16x4 r; asm volatile("ds_read_b64_tr_b16 %0, %1 offset:%2" : "=&v"(r) : "v"(vb), "i"(OFF) : "memory"); return r;
}
template <int D0> __device__ __forceinline__ void pv_one(f32x16& od, int vb, bf16x8 pa0, bf16x8 pa1, bf16x8 pa2, bf16x8 pa3) {
  const s16x4 l0 = tr_read<v_rd_off(D0, 0, 0)>(vb), h0 = tr_read<v_rd_off(D0, 0, 1)>(vb), l1 = tr_read<v_rd_off(D0, 1, 0)>(vb), h1 = tr_read<v_rd_off(D0, 1, 1)>(vb);
  const s16x4 l2 = tr_read<v_rd_off(D0, 2, 0)>(vb), h2 = tr_read<v_rd_off(D0, 2, 1)>(vb), l3 = tr_read<v_rd_off(D0, 3, 0)>(vb), h3 = tr_read<v_rd_off(D0, 3, 1)>(vb);
  asm volatile("s_waitcnt lgkmcnt(0)" ::: "memory"); ATT_SBAR();
#define ATT_PK(L, H) (bf16x8){L[0], L[1], L[2], L[3], H[0], H[1], H[2], H[3]}
  od = __builtin_amdgcn_mfma_f32_32x32x16_bf16(pa0, ATT_PK(l0, h0), od, 0, 0, 0);
  od = __builtin_amdgcn_mfma_f32_32x32x16_bf16(pa1, ATT_PK(l1, h1), od, 0, 0, 0);
  od = __builtin_amdgcn_mfma_f32_32x32x16_bf16(pa2, ATT_PK(l2, h2), od, 0, 0, 0);
  od = __builtin_amdgcn_mfma_f32_32x32x16_bf16(pa3, ATT_PK(l3, h3), od, 0, 0, 0);
#undef ATT_PK
}
__device__ __forceinline__ void pv_d0(f32x16* o, int vb, bf16x8 pa0, bf16x8 pa1, bf16x8 pa2, bf16x8 pa3) {
  pv_one<0>(o[0], vb, pa0, pa1, pa2, pa3); pv_one<1>(o[1], vb, pa0, pa1, pa2, pa3); pv_one<2>(o[2], vb, pa0, pa1, pa2, pa3); pv_one<3>(o[3], vb, pa0, pa1, pa2, pa3);
}

struct AUnit {
  const bf16_t* q; bf16_t* o; const bf16_t *k0, *v0, *k1, *v1;
  int ldq, ldo, ldk0, ldv0, ldk1, ldv1, n0, ntiles; float scale;
  int r0, kr_lo; const float* rpb;
};
constexpr int TBL_FLOATS = 15 * 128;
template <int DQ> constexpr int attn_lds_bytes() { return 2 * VBUF + 2 * KVBLK * DQ * 2 + NW * 64 * 4 + TBL_FLOATS * 4; }

template <int DQ, bool NAT>
__device__ __forceinline__ void attn_unit(const AUnit& U, char* lds) {
  constexpr int KB = KVBLK * DQ * 2, NKC = DQ / 64, CPR = DQ / 8;
  int tid_ = threadIdx.x; asm volatile("" : "+v"(tid_));
  const int tid = tid_, wid = __builtin_amdgcn_readfirstlane(tid >> 6), lane = tid & 63, r32 = lane & 31, hi = lane >> 5;
  char* V_lds = lds; char* K_lds = lds + 2 * VBUF;
  float* ws = (float*)(lds + 2 * VBUF + 2 * KB) + wid * 64; float* li_l = ws; float* al_l = ws + 32;
  float* tbl = (float*)(lds + 2 * VBUF + 2 * KB + NW * 64 * 4);
  const float C = U.scale * 1.4426950408889634f, thr = 8.f / U.scale;
  if constexpr (NAT) {
    const float inv = 1.0f / U.scale;
    for (int idx = tid; idx < TBL_FLOATS; idx += 512) { const int ro = idx >> 7, d = (idx & 127) - 48; tbl[idx] = (d >= 0 && d <= 30) ? U.rpb[ro * 31 + d] * inv : 0.f; }
  }
  float m_reg = -1e30f, l_reg = 0.f; f32x16 o[4] = {}; bf16x8 qr[DQ / 16];
  const bf16_t* Qw = U.q + (long)(wid * QBLK + r32) * U.ldq + hi * 8;
#pragma unroll
  for (int d0 = 0; d0 < DQ / 16; ++d0) qr[d0] = *reinterpret_cast<const bf16x8*>(Qw + d0 * 16);
  const int sr = tid >> 4, sc = (tid & 15) * 8, vst0 = v_st(sr, sc), vst1 = v_st(32 + sr, sc);
  const int vb0 = (int)(uintptr_t)V_lds + v_rd_base(lane);
  bf16x8 vs0, vs1, ks[NKC];
#define ATT_SLOAD(j) do { const int j_ = (j); const bool f_ = j_ < U.n0; const int jj_ = f_ ? j_ : j_ - U.n0; \
    const int ldk_ = f_ ? U.ldk0 : U.ldk1, ldv_ = f_ ? U.ldv0 : U.ldv1; \
    const bf16_t* kp_ = (f_ ? U.k0 : U.k1) + (long)jj_ * KVBLK * ldk_; const bf16_t* vp_ = (f_ ? U.v0 : U.v1) + (long)jj_ * KVBLK * ldv_; \
    vs0 = *reinterpret_cast<const bf16x8*>(vp_ + (long)sr * ldv_ + sc); vs1 = *reinterpret_cast<const bf16x8*>(vp_ + (long)(32 + sr) * ldv_ + sc); \
    _Pragma("unroll") for (int i_ = 0; i_ < NKC; ++i_) { const int c_ = tid + 512 * i_, kr_ = c_ / CPR, kc_ = c_ % CPR; ks[i_] = *reinterpret_cast<const bf16x8*>(kp_ + (long)kr_ * ldk_ + kc_ * 8); } } while (0)
#define ATT_SWRITE(b) do { *(bf16x8*)(V_lds + (b) * VBUF + vst0) = vs0; *(bf16x8*)(V_lds + (b) * VBUF + vst1) = vs1; \
    _Pragma("unroll") for (int i_ = 0; i_ < NKC; ++i_) { const int c_ = tid + 512 * i_, kr_ = c_ / CPR, kc_ = c_ % CPR; *(bf16x8*)(K_lds + (b) * KB + kswz<DQ>(kr_, kc_ * 16)) = ks[i_]; } } while (0)
  const int NT = U.ntiles;
  const int R = U.r0 + (wid >> 1), rs = min(max(R - 4, 0), 24), qc = (wid & 1) * 32 + r32, cs = min(max(qc - 8, 0), 48);
  ATT_SLOAD(0);
  for (int j = 0; j < NT; ++j) {
    const int b = j & 1;
    asm volatile("s_waitcnt vmcnt(0)" ::: "memory");
    ATT_SWRITE(b);
    if (j + 1 < NT) ATT_SLOAD(j + 1);
    __syncthreads();
    bool act = true; int kr = 0;
    if constexpr (NAT) { if (j >= U.n0) { kr = U.kr_lo + (j - U.n0); act = (kr >= rs) && (kr <= rs + 7); } }
    if (act) {
      f32x16 p0, p1; float mn, alpha; bf16x8 pa0, pa1, pa2, pa3;
      qkt<DQ>(p0, p1, K_lds + b * KB, qr, r32, hi);
      if constexpr (NAT) { if (j >= U.n0) {
        const int ro = kr - R + 7; const float* tb = tbl + ro * 128 + 63 - qc + 4 * hi; const int t0 = 4 * hi - cs; const float NEG = -INFINITY;
#pragma unroll
        for (int r = 0; r < 16; ++r) { const int kc = (r & 3) + 8 * (r >> 2);
          p0[r] = ((unsigned)(t0 + kc) < 16u) ? p0[r] + tb[kc] : NEG;
          p1[r] = ((unsigned)(t0 + kc + 32) < 16u) ? p1[r] + tb[kc + 32] : NEG; } } }
      partialSM(p0, p1, m_reg, mn, alpha, C, thr);
      if (__any(alpha < 1.f)) { if (hi == 0) al_l[r32] = alpha; asm volatile("s_waitcnt lgkmcnt(0)" ::: "memory");
#pragma unroll
        for (int d = 0; d < 4; ++d)
#pragma unroll
          for (int r = 0; r < 16; ++r) o[d][r] *= al_l[crow(r, hi)]; }
      finishSM(p0, p1, alpha, l_reg, pa0, pa1, pa2, pa3); ATT_SBAR();
      pv_d0(o, vb0 + b * VBUF, pa0, pa1, pa2, pa3);
    }
  }
  if (hi == 0) li_l[r32] = l_reg; asm volatile("s_waitcnt lgkmcnt(0)" ::: "memory");
  float rli[16];
#pragma unroll
  for (int r = 0; r < 16; ++r) rli[r] = __builtin_amdgcn_rcpf(li_l[crow(r, hi)]);
  bf16_t* Ow = U.o + (long)(wid * QBLK) * U.ldo;
#pragma unroll
  for (int r = 0; r < 16; ++r) { const int orow = crow(r, hi);
#pragma unroll
    for (int d0 = 0; d0 < 4; ++d0) { const float v = o[d0][r] * rli[r]; unsigned u = __float_as_uint(v); u = (u + 0x7fffu + ((u >> 16) & 1u)) >> 16; Ow[(long)orow * U.ldo + d0 * 32 + r32] = (bf16_t)u; } }
  __syncthreads();
#undef ATT_SLOAD
#undef ATT_SWRITE
}
}

constexpr int D = 2048, NTOK = 16384, NCTX = 8192, DEPTH = 4;
constexpr int IN_AB = 6144, DFF = 5632, NDOWN = 832, NDOWN_P = 1024, QL = 512, KVL = 256, ROPE_D = 64;
constexpr int NKVROWS = NTOK + 1024;
constexpr float EPS = 1e-6f;
constexpr int NWAVES = 8;
constexpr size_t O_X = 0, O_NATK = (size_t)NTOK * D, O_NATV = O_NATK + 16777216, O_CKV = O_NATV + 16777216, O_KR = O_CKV + 4194304, O_END = O_KR + 1048576;
constexpr size_t MiB = 1u << 20;
constexpr size_t WS_CTL = 0, CTL_ZERO_BYTES = 1 * MiB;
constexpr size_t WS_MOD = 1 * MiB;
constexpr size_t WS_W = 2 * MiB;
constexpr size_t SZ_FFN_IN = (size_t)2 * DFF * D * 2, SZ_FFN_OUT = (size_t)D * DFF * 2, SZ_IN_AB = (size_t)IN_AB * D * 2, SZ_DD = (size_t)D * D * 2;
constexpr size_t SZ_DOWN = (size_t)NDOWN_P * D * 2, SZ_UQ = (size_t)3072 * QL * 2, SZ_UKV = (size_t)4096 * KVL * 2;
constexpr size_t W_FFN_IN = WS_W, W_FFN_OUT = W_FFN_IN + 4 * SZ_FFN_IN, W_IN_AB = W_FFN_OUT + 4 * SZ_FFN_OUT, W_OUT_AB = W_IN_AB + 2 * SZ_IN_AB;
constexpr size_t W_DOWN = W_OUT_AB + 2 * SZ_DD, W_UQ = W_DOWN + 2 * SZ_DOWN, W_UKV = W_UQ + 2 * SZ_UQ, W_O = W_UKV + 2 * SZ_UKV, W_END = W_O + 2 * SZ_DD;
constexpr size_t WS_H = 384 * MiB;
constexpr size_t WS_C = WS_H + 64 * MiB;
constexpr size_t WS_SM = WS_C + 64 * MiB;
constexpr size_t SM_CQN = WS_SM, SM_CKVN = SM_CQN + (size_t)NTOK * QL * 2, SM_KR = SM_CKVN + (size_t)NKVROWS * KVL * 2, SM_CK = SM_KR + (size_t)NKVROWS * 64 * 4, SM_CV = SM_CK + 4 * MiB, SM_END = SM_CV + 4 * MiB;
constexpr size_t WS_BIG = WS_SM + 48 * MiB;
constexpr size_t B_P = WS_BIG;
constexpr size_t B_L = WS_BIG, B_QC = B_L + 64 * MiB, B_KV = B_QC + 96 * MiB, B_KN = B_KV + 136 * MiB;
constexpr size_t B_F = WS_BIG;
constexpr size_t WS_END = WS_BIG + 512 * MiB;
static_assert(W_END <= WS_H && SM_END <= WS_BIG && B_KN + (size_t)NKVROWS * 3072 * 2 <= WS_END && B_F + (size_t)NTOK * DFF * 2 <= WS_END, "d_ws map");
constexpr int CW_BAR = 4096;
constexpr int RING_BYTES = 131072, LDSCTL_OFF = RING_BYTES, LDS_BYTES = 147456;

typedef unsigned short bf16;
typedef float f32x2 __attribute__((ext_vector_type(2)));
typedef unsigned u32x2 __attribute__((ext_vector_type(2)));

__device__ __forceinline__ float wave_sum(float v) {
#pragma unroll
    for (int o = 1; o < 64; o <<= 1) v += __shfl_xor(v, o);
    return v;
}
__device__ __forceinline__ float bf2f(unsigned short b) { return __uint_as_float(((unsigned)b) << 16); }
__device__ __forceinline__ float bflo(unsigned w) { return __uint_as_float(w << 16); }
__device__ __forceinline__ float bfhi(unsigned w) { return __uint_as_float(w & 0xffff0000u); }

struct Frame {
    LAS unsigned char* lds; char* ldsg;
    int tid, lane, wave, G, vcu, gw, NGW;
    const float* in[28]; float* out; unsigned char* ws;
};

__device__ __forceinline__ bool fresh(Frame& F) {
    int t = threadIdx.x; asm volatile("" : "+v"(t)); F.tid = t; F.lane = t & 63; F.wave = __builtin_amdgcn_readfirstlane(t >> 6); F.gw = F.vcu * NWAVES + F.wave; return true;
}
__device__ __forceinline__ void p0_transpose_item(const float* W, int K, int N, bf16* WT, int k0, int n0, int drow0, LAS float* scr, int lane) {
#pragma unroll 8
    for (int i = 0; i < 32; ++i) { const int kk = 2 * i + (lane >> 5); scr[kk * 33 + (lane & 31)] = W[(size_t)(k0 + kk) * N + n0 + (lane & 31)]; }
    LDS_WAIT(); asm volatile("" ::: "memory");
    const int c = lane & 7;
#pragma unroll
    for (int j = 0; j < 4; ++j) { const int n = (lane >> 3) + 8 * j; const LAS float* s = scr + (8 * c) * 33 + n;
        v4u o; o.x = pk2(s[0 * 33], s[1 * 33]); o.y = pk2(s[2 * 33], s[3 * 33]); o.z = pk2(s[4 * 33], s[5 * 33]); o.w = pk2(s[6 * 33], s[7 * 33]);
        *(GAS v4u*)(WT + (size_t)(drow0 + n) * K + k0 + 8 * c) = o; }
    LDS_WAIT(); asm volatile("" ::: "memory");
}
__device__ __forceinline__ void p0_do_matrix(const float* W, int K, int N, bf16* WT, int item, int ffn_map, LAS float* scr, int lane) {
    const int nblk = N / 32, kb = item / nblk, nb = item % nblk, k0 = 64 * kb, n0 = 32 * nb;
    int drow0 = n0;
    if (ffn_map) { const int up = n0 >= DFF ? 1 : 0, j = n0 - up * DFF; drow0 = (j >> 7) * 256 + up * 128 + (j & 127); }
    p0_transpose_item(W, K, N, WT, k0, n0, drow0, scr, lane);
}
__device__ __forceinline__ void phase_prologue(Frame& F) {
    {
        LAS float* sil = (LAS float*)F.lds;
        LAS float* red = sil + 5 * 2048;
        const float* c = F.in[6]; const float* cctx = F.in[7];
        for (int i = F.tid; i < 5 * 2048; i += 512) { const int cc = i >> 11, k = i & 2047; const float x = cc == 0 ? cctx[k] : c[(cc - 1) * 2048 + k]; sil[i] = x / (1.0f + __expf(-x)); }
        __syncthreads();
        const float* w_ada = F.in[10]; const float* b_ada = F.in[11]; float* mod = (float*)(F.ws + WS_MOD);
        for (int task = F.vcu; task < 4 * 192; task += F.G) {
            const int l = task / 192, n = (task % 192) * 64 + F.lane;
            const float* wp = w_ada + ((size_t)l * 2048 + F.wave * 256) * 12288 + n;
            float a0 = 0.f, a1 = 0.f, a2 = 0.f, a3 = 0.f, a4 = 0.f;
            for (int k = 0; k < 256; k += 8) {
                float w[8];
#pragma unroll
                for (int u = 0; u < 8; ++u) w[u] = wp[(size_t)(k + u) * 12288];
#pragma unroll
                for (int u = 0; u < 8; ++u) { const int kk = F.wave * 256 + k + u; a0 += sil[kk] * w[u]; a1 += sil[2048 + kk] * w[u]; a2 += sil[4096 + kk] * w[u]; a3 += sil[6144 + kk] * w[u]; a4 += sil[8192 + kk] * w[u]; }
            }
            red[(F.wave * 5 + 0) * 64 + F.lane] = a0; red[(F.wave * 5 + 1) * 64 + F.lane] = a1; red[(F.wave * 5 + 2) * 64 + F.lane] = a2; red[(F.wave * 5 + 3) * 64 + F.lane] = a3; red[(F.wave * 5 + 4) * 64 + F.lane] = a4;
            __syncthreads();
            if (F.tid < 320) { const int cc = F.tid >> 6, ln = F.tid & 63; float s = 0.f;
#pragma unroll
                for (int w8 = 0; w8 < 8; ++w8) s += red[(w8 * 5 + cc) * 64 + ln];
                const int nn = (task % 192) * 64 + ln; mod[((size_t)l * 5 + cc) * 12288 + nn] = s + b_ada[(size_t)l * 12288 + nn]; }
            __syncthreads();
        }
    }
    {
        LAS float* scr = (LAS float*)(F.lds + F.wave * 16384);
        constexpr int I_FI = 32 * 352, I_FO = 88 * 64, I_IA = 32 * 192, I_DD = 32 * 64, I_DN = 32 * 26, I_UQ = 8 * 96, I_UK = 4 * 128;
        constexpr int NITEMS = 4 * I_FI + 4 * I_FO + 2 * I_IA + 2 * I_DD + 2 * I_DN + 2 * I_UQ + 2 * I_UK + 2 * I_DD;
        unsigned char* ws = F.ws;
        for (int it = F.gw; it < NITEMS; it += F.NGW) {
            int r = it;
            if (r < 4 * I_FI) { const int l = r / I_FI; p0_do_matrix(F.in[26] + (size_t)l * D * 2 * DFF, D, 2 * DFF, (bf16*)(ws + W_FFN_IN + l * SZ_FFN_IN), r % I_FI, 1, scr, F.lane); continue; } r -= 4 * I_FI;
            if (r < 4 * I_FO) { const int l = r / I_FO; p0_do_matrix(F.in[27] + (size_t)l * DFF * D, DFF, D, (bf16*)(ws + W_FFN_OUT + l * SZ_FFN_OUT), r % I_FO, 0, scr, F.lane); continue; } r -= 4 * I_FO;
            if (r < 2 * I_IA) { const int l = r / I_IA; p0_do_matrix(F.in[12] + (size_t)l * D * IN_AB, D, IN_AB, (bf16*)(ws + W_IN_AB + l * SZ_IN_AB), r % I_IA, 0, scr, F.lane); continue; } r -= 2 * I_IA;
            if (r < 2 * I_DD) { const int l = r / I_DD; p0_do_matrix(F.in[17] + (size_t)l * D * D, D, D, (bf16*)(ws + W_OUT_AB + l * SZ_DD), r % I_DD, 0, scr, F.lane); continue; } r -= 2 * I_DD;
            if (r < 2 * I_DN) { const int l = r / I_DN; p0_do_matrix(F.in[18] + (size_t)l * D * NDOWN, D, NDOWN, (bf16*)(ws + W_DOWN + l * SZ_DOWN), r % I_DN, 0, scr, F.lane); continue; } r -= 2 * I_DN;
            if (r < 2 * I_UQ) { const int l = r / I_UQ; p0_do_matrix(F.in[21] + (size_t)l * QL * 3072, QL, 3072, (bf16*)(ws + W_UQ + l * SZ_UQ), r % I_UQ, 0, scr, F.lane); continue; } r -= 2 * I_UQ;
            if (r < 2 * I_UK) { const int l = r / I_UK; p0_do_matrix(F.in[22] + (size_t)l * KVL * 4096, KVL, 4096, (bf16*)(ws + W_UKV + l * SZ_UKV), r % I_UK, 0, scr, F.lane); continue; } r -= 2 * I_UK;
            { const int l = r / I_DD; p0_do_matrix(F.in[25] + (size_t)l * D * D, D, D, (bf16*)(ws + W_O + l * SZ_DD), r % I_DD, 0, scr, F.lane); }
        }
        const int gt = F.vcu * 512 + F.tid, NT = F.G * 512;
        for (int i = gt; i < 2 * (NDOWN_P - NDOWN) * D / 8; i += NT) { const int l = i / ((NDOWN_P - NDOWN) * D / 8), e = i % ((NDOWN_P - NDOWN) * D / 8);
            *(v4u*)(ws + W_DOWN + l * SZ_DOWN + (size_t)NDOWN * D * 2 + (size_t)e * 16) = (v4u){0u, 0u, 0u, 0u}; }
        const float* ck = F.in[2]; const float* cv = F.in[3];
        for (int i = gt; i < 2 * 262144; i += NT) { const bool isk = i < 262144; const int e = isk ? i : i - 262144; const float* s = (isk ? ck : cv) + (size_t)e * 8;
            const f32x4 a = *(const f32x4*)s, b = *(const f32x4*)(s + 4); v4u o; o.x = pk2(a[0], a[1]); o.y = pk2(a[2], a[3]); o.z = pk2(b[0], b[1]); o.w = pk2(b[2], b[3]);
            *(v4u*)(ws + (isk ? SM_CK : SM_CV) + (size_t)e * 16) = o; }
    }
}

__device__ __forceinline__ void phase_mod(Frame& F, const float* xc, const float* xs, const float* g, const float* mod_l, int chunk, bf16* Hb) {
    for (int rb = F.gw; rb < NTOK / 8; rb += F.NGW) {
        const int row0 = rb * 8, cond = row0 < NCTX ? 0 : 1 + ((row0 - NCTX) >> 11);
        const float* sh = mod_l + (size_t)cond * 12288 + chunk * 2048; const float* scl = sh + 2048;
        f32x4 a[8], b[8];
#pragma unroll
        for (int j = 0; j < 8; ++j) { const int c = 4 * (64 * j + F.lane); const f32x4 gv = *(const f32x4*)(g + c), sv = *(const f32x4*)(scl + c); a[j] = gv * (sv + 1.0f); b[j] = *(const f32x4*)(sh + c); }
        for (int rr = 0; rr < 8; ++rr) {
            const int row = row0 + rr; const float* xr = (row < NCTX ? xc : xs) + (size_t)row * D;
            f32x4 v[8]; float ss = 0.f;
#pragma unroll
            for (int j = 0; j < 8; ++j) { v[j] = *(const f32x4*)(xr + 4 * (64 * j + F.lane)); ss += (v[j][0] * v[j][0] + v[j][1] * v[j][1]) + (v[j][2] * v[j][2] + v[j][3] * v[j][3]); }
            const float rstd = 1.0f / sqrtf(wave_sum(ss) * (1.0f / D) + EPS);
            bf16* orow = Hb + (size_t)row * D;
#pragma unroll
            for (int j = 0; j < 8; ++j) { const f32x4 y = v[j] * rstd * a[j] + b[j]; u32x2 w; w.x = pk2(y[0], y[1]); w.y = pk2(y[2], y[3]); *(u32x2*)(orow + 4 * (64 * j + F.lane)) = w; }
        }
    }
}

__device__ __forceinline__ void phase_even_thin(Frame& F, int i, bf16* P, bf16* Cb) {
    const float* gq = F.in[13] + i * 128; const float* gk = F.in[14] + i * 128; const float* cw = F.in[16] + (size_t)i * 3 * 1024;
    for (int row = F.gw; row < NTOK; row += F.NGW) {
        bf16* pr = P + (size_t)row * IN_AB;
#pragma unroll
        for (int j = 0; j < 4; ++j) {
            const int chunk = F.lane + 64 * j, hh = chunk >> 4, d0 = (chunk & 15) * 8;
            const v4u w = *(const v4u*)(pr + chunk * 8);
            float x[8] = {bflo(w.x), bfhi(w.x), bflo(w.y), bfhi(w.y), bflo(w.z), bfhi(w.z), bflo(w.w), bfhi(w.w)};
            float ss = 0.f;
#pragma unroll
            for (int e = 0; e < 8; ++e) ss += x[e] * x[e];
            ss += __shfl_xor(ss, 1); ss += __shfl_xor(ss, 2); ss += __shfl_xor(ss, 4); ss += __shfl_xor(ss, 8);
            const float rstd = 1.0f / sqrtf(ss * (1.0f / 128.0f) + EPS);
            const float* gg = (hh < 8 ? gq : gk) + d0;
            const f32x4 g0 = *(const f32x4*)gg, g1 = *(const f32x4*)(gg + 4);
            float y[8];
#pragma unroll
            for (int e = 0; e < 4; ++e) { y[e] = x[e] * rstd * g0[e]; y[4 + e] = x[4 + e] * rstd * g1[e]; }
            v4u o; o.x = pk2(y[0], y[1]); o.y = pk2(y[2], y[3]); o.z = pk2(y[4], y[5]); o.w = pk2(y[6], y[7]);
            *(v4u*)(pr + chunk * 8) = o;
            if (row < NCTX && hh >= 8) { const int b = row >> 8, t = row & 255, h = hh - 8;
                float* dst = F.out + O_NATK + ((((size_t)b * 2 + i) * 8 + h) * 256 + t) * 128 + d0;
                *(f32x4*)dst = (f32x4){y[0], y[1], y[2], y[3]}; *(f32x4*)(dst + 4) = (f32x4){y[4], y[5], y[6], y[7]}; }
        }
        if (row < NCTX) {
            const int b = row >> 8, t = row & 255;
#pragma unroll
            for (int j = 0; j < 2; ++j) { const int chunk = F.lane + 64 * j, h = chunk >> 4, d0 = (chunk & 15) * 8;
                const v4u w = *(const v4u*)(pr + 2048 + chunk * 8);
                float* dst = F.out + O_NATV + ((((size_t)b * 2 + i) * 8 + h) * 256 + t) * 128 + d0;
                *(f32x4*)dst = (f32x4){bflo(w.x), bfhi(w.x), bflo(w.y), bfhi(w.y)}; *(f32x4*)(dst + 4) = (f32x4){bflo(w.z), bfhi(w.z), bflo(w.w), bfhi(w.w)}; }
        }
    }
    const int gt = F.vcu * 512 + F.tid, NT = F.G * 512;
    for (int idx = gt; idx < NTOK * 128; idx += NT) {
        const int row = idx >> 7, c = (idx & 127) * 8;
        int t, L; if (row < NCTX) { t = row & 255; L = 256; } else { t = (row - NCTX) & 2047; L = 2048; }
        const bf16* pr = P + (size_t)row * IN_AB;
        const v4u gb = *(const v4u*)(pr + 3072 + c);
        float acc[8];
#pragma unroll
        for (int e = 0; e < 8; ++e) acc[e] = 0.f;
#pragma unroll
        for (int j = 0; j < 3; ++j) {
            const int tt = t + j - 1;
            if (tt >= 0 && tt < L) {
                const bf16* p2 = pr + (ptrdiff_t)(j - 1) * IN_AB;
                const v4u gc = *(const v4u*)(p2 + 4096 + c), uu = *(const v4u*)(p2 + 5120 + c);
                const f32x4 w0 = *(const f32x4*)(cw + j * 1024 + c), w1 = *(const f32x4*)(cw + j * 1024 + c + 4);
                acc[0] += w0[0] * bflo(gc.x) * bflo(uu.x); acc[1] += w0[1] * bfhi(gc.x) * bfhi(uu.x); acc[2] += w0[2] * bflo(gc.y) * bflo(uu.y); acc[3] += w0[3] * bfhi(gc.y) * bfhi(uu.y);
                acc[4] += w1[0] * bflo(gc.z) * bflo(uu.z); acc[5] += w1[1] * bfhi(gc.z) * bfhi(uu.z); acc[6] += w1[2] * bflo(gc.w) * bflo(uu.w); acc[7] += w1[3] * bfhi(gc.w) * bfhi(uu.w);
            }
        }
        v4u o; o.x = pk2(bflo(gb.x) * acc[0], bfhi(gb.x) * acc[1]); o.y = pk2(bflo(gb.y) * acc[2], bfhi(gb.y) * acc[3]); o.z = pk2(bflo(gb.z) * acc[4], bfhi(gb.z) * acc[5]); o.w = pk2(bflo(gb.w) * acc[6], bfhi(gb.w) * acc[7]);
        *(v4u*)(Cb + (size_t)row * D + 1024 + c) = o;
    }
}

__device__ __forceinline__ void phase_odd_thin1(Frame& F, int i, const float* L, bf16* cqn, bf16* ckvn, float* KR) {
    const float* gcq = F.in[19] + i * QL; const float* gckv = F.in[20] + i * KVL;
    for (int row = F.gw; row < NKVROWS; row += F.NGW) {
        if (row < NTOK) {
            const float* lr = L + (size_t)row * NDOWN_P;
            const f32x4 q0 = *(const f32x4*)(lr + F.lane * 8), q1 = *(const f32x4*)(lr + F.lane * 8 + 4);
            float ss = (q0[0] * q0[0] + q0[1] * q0[1]) + (q0[2] * q0[2] + q0[3] * q0[3]) + (q1[0] * q1[0] + q1[1] * q1[1]) + (q1[2] * q1[2] + q1[3] * q1[3]);
            float rstd = 1.0f / sqrtf(wave_sum(ss) * (1.0f / QL) + EPS);
            const f32x4 g0 = *(const f32x4*)(gcq + F.lane * 8), g1 = *(const f32x4*)(gcq + F.lane * 8 + 4);
            v4u o; o.x = pk2(q0[0] * rstd * g0[0], q0[1] * rstd * g0[1]); o.y = pk2(q0[2] * rstd * g0[2], q0[3] * rstd * g0[3]);
            o.z = pk2(q1[0] * rstd * g1[0], q1[1] * rstd * g1[1]); o.w = pk2(q1[2] * rstd * g1[2], q1[3] * rstd * g1[3]);
            *(v4u*)(cqn + (size_t)row * QL + F.lane * 8) = o;
            const f32x4 kv = *(const f32x4*)(lr + QL + F.lane * 4);
            ss = (kv[0] * kv[0] + kv[1] * kv[1]) + (kv[2] * kv[2] + kv[3] * kv[3]);
            rstd = 1.0f / sqrtf(wave_sum(ss) * (1.0f / KVL) + EPS);
            const f32x4 gv = *(const f32x4*)(gckv + F.lane * 4);
            const f32x4 y = kv * rstd * gv;
            u32x2 w; w.x = pk2(y[0], y[1]); w.y = pk2(y[2], y[3]); *(u32x2*)(ckvn + (size_t)row * KVL + F.lane * 4) = w;
            const float krv = lr[QL + KVL + F.lane];
            KR[(size_t)row * 64 + F.lane] = krv;
            if (row < NCTX) { const int b = row >> 8, t = row & 255;
                *(f32x4*)(F.out + O_CKV + (((size_t)b * 2 + i) * 256 + t) * 256 + F.lane * 4) = y;
                F.out[O_KR + (((size_t)b * 2 + i) * 256 + t) * 64 + F.lane] = krv; }
        } else {
            const int cr = row - NTOK, b = cr >> 8, t = cr & 255;
            const f32x4 y = *(const f32x4*)(F.in[4] + (((size_t)b * 2 + i) * 256 + t) * 256 + F.lane * 4);
            u32x2 w; w.x = pk2(y[0], y[1]); w.y = pk2(y[2], y[3]); *(u32x2*)(ckvn + (size_t)row * KVL + F.lane * 4) = w;
            KR[(size_t)row * 64 + F.lane] = F.in[5][(((size_t)b * 2 + i) * 256 + t) * 64 + F.lane];
        }
    }
}
__device__ __forceinline__ void phase_odd_thin2(Frame& F, int i, bf16* Qc, const bf16* KV, const float* KR, bf16* Kn) {
    const float* gq = F.in[23] + i * 192; const float* gk = F.in[24] + i * 192;
    const float gq0 = gq[F.lane], gq1 = gq[64 + F.lane], gq2 = gq[128 + F.lane], gk0 = gk[F.lane], gk1 = gk[64 + F.lane], gk2 = gk[128 + F.lane];
    const int sec = F.lane >> 5, idx = F.lane & 31, jf = idx & 15, isx2 = idx >> 4;
    const float freq = exp2f(-(float)jf * (13.287712379549449f / 16.0f));
    for (int row = F.gw; row < NKVROWS; row += F.NGW) {
        const bool lat = row >= NCTX && row < NTOK;
        float cs = 1.f, sn = 0.f;
        if (lat) { const int t = (row - NCTX) & 2047; const float pos = (float)(sec ? (t & 63) : (t >> 6)); const float ang = pos * freq; cs = __cosf(ang); sn = __sinf(ang); }
        const float krv = KR[(size_t)row * 64 + F.lane];
        const bf16* kvr = KV + (size_t)row * 4096; bf16* knr = Kn + (size_t)row * 3072;
        for (int h = 0; h < 16; ++h) {
            const float a0 = bf2f(kvr[h * 256 + F.lane]), a1 = bf2f(kvr[h * 256 + 64 + F.lane]);
            const float rstd = 1.0f / sqrtf(wave_sum(a0 * a0 + a1 * a1 + krv * krv) * (1.0f / 192.0f) + EPS);
            const float y0 = a0 * rstd * gk0, y1 = a1 * rstd * gk1; float y2 = krv * rstd * gk2;
            const float pr = __shfl_xor(y2, 16);
            if (lat) y2 = isx2 ? (pr * sn + y2 * cs) : (y2 * cs - pr * sn);
            knr[h * 192 + F.lane] = (bf16)f2bf(y0); knr[h * 192 + 64 + F.lane] = (bf16)f2bf(y1); knr[h * 192 + 128 + F.lane] = (bf16)f2bf(y2);
        }
        if (row < NTOK) {
            bf16* qr = Qc + (size_t)row * 3072;
            for (int h = 0; h < 16; ++h) {
                const float a0 = bf2f(qr[h * 192 + F.lane]), a1 = bf2f(qr[h * 192 + 64 + F.lane]), a2 = bf2f(qr[h * 192 + 128 + F.lane]);
                const float rstd = 1.0f / sqrtf(wave_sum(a0 * a0 + a1 * a1 + a2 * a2) * (1.0f / 192.0f) + EPS);
                const float y0 = a0 * rstd * gq0, y1 = a1 * rstd * gq1; float y2 = a2 * rstd * gq2;
                const float pr = __shfl_xor(y2, 16);
                if (lat) y2 = isx2 ? (pr * sn + y2 * cs) : (y2 * cs - pr * sn);
                qr[h * 192 + F.lane] = (bf16)f2bf(y0); qr[h * 192 + 64 + F.lane] = (bf16)f2bf(y1); qr[h * 192 + 128 + F.lane] = (bf16)f2bf(y2);
            }
        }
    }
}

__device__ __forceinline__ void phase_even_attn(Frame& F, int i, const bf16* P, bf16* Cb) {
    const bf16* CK = (const bf16*)(F.ws + SM_CK); const bf16* CV = (const bf16*)(F.ws + SM_CV);
    for (int u = F.vcu; u < 512; u += F.G) {
        att::AUnit U;
        U.scale = 0.08838834764831845f; U.ldq = IN_AB; U.ldo = D; U.r0 = 0; U.kr_lo = 0; U.rpb = nullptr;
        if (u < 256) {
            const int b = u >> 3, h = u & 7; const size_t r0 = (size_t)b * 256;
            U.q = P + r0 * IN_AB + h * 128; U.o = Cb + r0 * D + h * 128;
            U.k0 = P + r0 * IN_AB + 1024 + h * 128; U.v0 = P + r0 * IN_AB + 2048 + h * 128; U.ldk0 = IN_AB; U.ldv0 = IN_AB; U.n0 = 4; U.ntiles = 4;
            U.k1 = U.k0; U.v1 = U.v0; U.ldk1 = IN_AB; U.ldv1 = IN_AB;
            att::attn_unit<128, false>(U, F.ldsg);
        } else {
            const int n = u - 256, b = n >> 6, h = (n >> 3) & 7, rb = n & 7, r0 = 4 * rb;
            const size_t row0 = (size_t)NCTX + (size_t)b * 2048 + (size_t)r0 * 64;
            U.q = P + row0 * IN_AB + h * 128; U.o = Cb + row0 * D + h * 128;
            const size_t coff = ((((size_t)b * 2 + i) * 8 + h) * 256) * 128;
            U.k0 = CK + coff; U.v0 = CV + coff; U.ldk0 = 128; U.ldv0 = 128; U.n0 = 4;
            const int kr_lo = min(max(r0 - 4, 0), 24), kr_hi = min(max(r0 - 1, 0), 24) + 7;
            const size_t krow0 = (size_t)NCTX + (size_t)b * 2048 + (size_t)kr_lo * 64;
            U.k1 = P + krow0 * IN_AB + 1024 + h * 128; U.v1 = P + krow0 * IN_AB + 2048 + h * 128; U.ldk1 = IN_AB; U.ldv1 = IN_AB;
            U.ntiles = 4 + (kr_hi - kr_lo + 1); U.r0 = r0; U.kr_lo = kr_lo; U.rpb = F.in[15] + ((size_t)i * 8 + h) * 15 * 31;
            att::attn_unit<128, true>(U, F.ldsg);
        }
    }
}
__device__ __forceinline__ void phase_odd_attn(Frame& F, const bf16* Qn, const bf16* Kn, const bf16* KV, bf16* Ob) {
    for (int u = F.vcu; u < 1024; u += F.G) {
        att::AUnit U;
        U.scale = 0.07216878364870323f; U.ldq = 3072; U.ldo = D; U.r0 = 0; U.kr_lo = 0; U.rpb = nullptr;
        U.ldk0 = 3072; U.ldv0 = 4096; U.ldk1 = 3072; U.ldv1 = 4096;
        if (u < 512) {
            const int b = u >> 4, h = u & 15; const size_t r0 = (size_t)b * 256;
            U.q = Qn + r0 * 3072 + h * 192; U.o = Ob + r0 * D + h * 128;
            U.k0 = Kn + r0 * 3072 + h * 192; U.v0 = KV + r0 * 4096 + h * 256 + 128; U.n0 = 4; U.ntiles = 4; U.k1 = U.k0; U.v1 = U.v0;
        } else {
            const int n = u - 512, b = n >> 7, h = (n >> 3) & 15, qb = n & 7;
            const size_t row0 = (size_t)NCTX + (size_t)b * 2048 + (size_t)qb * 256, kc0 = (size_t)NTOK + (size_t)b * 256, kl0 = (size_t)NCTX + (size_t)b * 2048;
            U.q = Qn + row0 * 3072 + h * 192; U.o = Ob + row0 * D + h * 128;
            U.k0 = Kn + kc0 * 3072 + h * 192; U.v0 = KV + kc0 * 4096 + h * 256 + 128; U.n0 = 4;
            U.k1 = Kn + kl0 * 3072 + h * 192; U.v1 = KV + kl0 * 4096 + h * 256 + 128; U.ntiles = 36;
        }
        att::attn_unit<192, false>(U, F.ldsg);
    }
}

struct Args { const float* in[28]; float* out; unsigned char* ws; int ph_lo, ph_hi; };
constexpr int PH_END = 1 + DEPTH * 10;
__host__ __device__ constexpr int pid(int l, int s) { return 1 + l * 10 + s; }

__global__ void __launch_bounds__(NWAVES * 64, 2) fwd_kernel(Args args) {
    extern __shared__ __attribute__((aligned(16))) unsigned char lds[];
    Frame F;
    F.lds = (LAS unsigned char*)lds; F.ldsg = (char*)lds;
    F.tid = threadIdx.x; F.lane = F.tid & 63; F.wave = __builtin_amdgcn_readfirstlane(F.tid >> 6);
    F.G = gridDim.x; { const int bx = blockIdx.x; F.vcu = (F.G % 8 == 0) ? (bx % 8) * (F.G / 8) + bx / 8 : bx; }
    F.gw = F.vcu * NWAVES + F.wave; F.NGW = F.G * NWAVES;
#pragma unroll
    for (int k = 0; k < 28; ++k) F.in[k] = args.in[k];
    F.out = args.out; F.ws = args.ws;
    unsigned char* ws = args.ws;
    for (int u = F.tid; u < (LDS_BYTES - LDSCTL_OFF) / 4; u += NWAVES * 64) ((LAS unsigned*)(F.lds + LDSCTL_OFF))[u] = 0u;
    __syncthreads();
    const int lo = args.ph_lo, hi = args.ph_hi;
    XcdBarrier bar; bar.bar = (unsigned*)(ws + WS_CTL) + CW_BAR; bar.x = 0; bar.st = nullptr;
    if (hi - lo > 1) bar = xcd_barrier_post((unsigned*)(ws + WS_CTL) + CW_BAR, (volatile LAS unsigned*)(F.lds + LDSCTL_OFF) + 8);
#ifndef PH_MASK
#define PH_MASK 0xFFFF
#endif
#define EN(k) ((PH_MASK >> (k)) & 1)
#define RUN(p) (lo <= (p) && (p) < hi && fresh(F))
#define SEAM(p) do { if ((p) + 1 < hi) xcd_barrier(bar); } while (0)

    float* X = F.out + O_X; float* modp = (float*)(ws + WS_MOD);
    bf16* Hb = (bf16*)(ws + WS_H); bf16* Cb = (bf16*)(ws + WS_C); bf16* Fb = (bf16*)(ws + B_F);

    if (EN(0) && RUN(0)) { phase_prologue(F); SEAM(0); }

    for (int l = 0; l < DEPTH; ++l) {
        const int i = l >> 1;
        const float* mod_l = modp + (size_t)l * 5 * 12288;
        const float* xc = l == 0 ? F.in[0] : X; const float* xs = l == 0 ? F.in[1] - (size_t)NCTX * D : X;
        if (EN(1) && RUN(pid(l, 0))) { phase_mod(F, xc, xs, F.in[8] + (size_t)l * D, mod_l, 0, Hb); SEAM(pid(l, 0)); }
        if ((l & 1) == 0) {
            bf16* P = (bf16*)(ws + B_P);
            if (EN(2) && RUN(pid(l, 1))) {
                pg8::Gemm g{Hb, (const bf16*)(ws + W_IN_AB + i * SZ_IN_AB), NTOK, IN_AB, D}; pg8::StaticOrder S; S.init(NTOK, IN_AB, F.G, (int)blockIdx.x);
                pg8::EpiBf16P E{P, IN_AB};
                pg8::gemm_phase<pg8::EpiBf16P, pg8::StaticOrder, true, true>(F.lds, g, S, E);
                SEAM(pid(l, 1));
            }
            if (EN(3) && RUN(pid(l, 2))) { phase_even_thin(F, i, P, Cb); SEAM(pid(l, 2)); }
            if (EN(4) && RUN(pid(l, 5))) { phase_even_attn(F, i, P, Cb); SEAM(pid(l, 5)); }
        } else {
            float* L = (float*)(ws + B_L); bf16* Qc = (bf16*)(ws + B_QC); bf16* KV = (bf16*)(ws + B_KV); bf16* Kn = (bf16*)(ws + B_KN);
            bf16* cqn = (bf16*)(ws + SM_CQN); bf16* ckvn = (bf16*)(ws + SM_CKVN); float* KR = (float*)(ws + SM_KR);
            if (EN(5) && RUN(pid(l, 1))) {
                pg8::Gemm g{Hb, (const bf16*)(ws + W_DOWN + i * SZ_DOWN), NTOK, NDOWN_P, D}; pg8::StaticOrder S; S.init(NTOK, NDOWN_P, F.G, (int)blockIdx.x);
                pg8::EpiF32P E{L, NDOWN_P};
                pg8::gemm_phase<pg8::EpiF32P, pg8::StaticOrder, true, true>(F.lds, g, S, E);
                SEAM(pid(l, 1));
            }
            if (EN(6) && RUN(pid(l, 2))) { phase_odd_thin1(F, i, L, cqn, ckvn, KR); SEAM(pid(l, 2)); }
            if (EN(7) && RUN(pid(l, 3))) {
                { pg8::Gemm g{cqn, (const bf16*)(ws + W_UQ + i * SZ_UQ), NTOK, 3072, QL}; pg8::StaticOrder S; S.init(NTOK, 3072, F.G, (int)blockIdx.x);
                  pg8::EpiBf16P E{Qc, 3072};
                  pg8::gemm_phase<pg8::EpiBf16P, pg8::StaticOrder, true, true>(F.lds, g, S, E); }
                { pg8::Gemm g{ckvn, (const bf16*)(ws + W_UKV + i * SZ_UKV), NKVROWS, 4096, KVL}; pg8::StaticOrder S; S.init(NKVROWS, 4096, F.G, (int)blockIdx.x);
                  pg8::EpiBf16P E{KV, 4096};
                  pg8::gemm_phase<pg8::EpiBf16P, pg8::StaticOrder, true, true>(F.lds, g, S, E); }
                SEAM(pid(l, 3));
            }
            if (EN(8) && RUN(pid(l, 4))) { phase_odd_thin2(F, i, Qc, KV, KR, Kn); SEAM(pid(l, 4)); }
            if (EN(9) && RUN(pid(l, 5))) { phase_odd_attn(F, Qc, Kn, KV, Cb); SEAM(pid(l, 5)); }
        }
        if (EN(10) && RUN(pid(l, 6))) {
            const bf16* Wt = (l & 1) ? (const bf16*)(ws + W_O + i * SZ_DD) : (const bf16*)(ws + W_OUT_AB + i * SZ_DD);
            pg8::Gemm g{Cb, Wt, NTOK, D, D}; pg8::StaticOrder S; S.init(NTOK, D, F.G, (int)blockIdx.x);
            pg8::EpiRes E{xc, xs, X, mod_l + 2 * 2048};
            pg8::gemm_phase<pg8::EpiRes, pg8::StaticOrder, true, true>(F.lds, g, S, E);
            SEAM(pid(l, 6));
        }
        if (EN(11) && RUN(pid(l, 7))) { phase_mod(F, X, X, F.in[9] + (size_t)l * D, mod_l, 3, Hb); SEAM(pid(l, 7)); }
        if (EN(12) && RUN(pid(l, 8))) {
            pg8::Gemm g{Hb, (const bf16*)(ws + W_FFN_IN + l * SZ_FFN_IN), NTOK, 2 * DFF, D}; pg8::StaticOrder S; S.init(NTOK, 2 * DFF, F.G, (int)blockIdx.x);
            pg8::EpiSwiGLU E{Fb, DFF};
            pg8::gemm_phase<pg8::EpiSwiGLU, pg8::StaticOrder, true, true>(F.lds, g, S, E);
            SEAM(pid(l, 8));
        }
        if (EN(13) && RUN(pid(l, 9))) {
            pg8::Gemm g{Fb, (const bf16*)(ws + W_FFN_OUT + l * SZ_FFN_OUT), NTOK, D, DFF}; pg8::StaticOrder S; S.init(NTOK, D, F.G, (int)blockIdx.x);
            pg8::EpiRes E{X, X, X, mod_l + 5 * 2048};
            pg8::gemm_phase<pg8::EpiRes, pg8::StaticOrder, true, true>(F.lds, g, S, E);
            SEAM(pid(l, 9));
        }
    }
#undef RUN
#undef SEAM
}

#ifndef MK_ONE_LAUNCH
#define MK_ONE_LAUNCH 0
#endif
extern "C" void kernel_launch(void* const* d_in, const int* in_sizes, int n_in, void* d_out, int out_size, void* d_ws, size_t ws_size, hipStream_t stream) {
    static int grid = 0;
    if (grid == 0) {
        if (n_in != 28 || (size_t)out_size != O_END || ws_size < WS_END) { fprintf(stderr, "kernel_launch: unexpected shapes: n_in %d out %d ws %zu (need %zu)\n", n_in, out_size, ws_size, (size_t)WS_END); grid = -1; return; }
        int dev = 0, cus = 0, per_cu = 0;
        if (hipGetDevice(&dev) != hipSuccess || hipDeviceGetAttribute(&cus, hipDeviceAttributeMultiprocessorCount, dev) != hipSuccess) { grid = -1; return; }
        if (hipFuncSetAttribute((const void*)fwd_kernel, hipFuncAttributeMaxDynamicSharedMemorySize, LDS_BYTES) != hipSuccess) { fprintf(stderr, "kernel_launch: hipFuncSetAttribute failed\n"); grid = -1; return; }
        if (hipOccupancyMaxActiveBlocksPerMultiprocessor(&per_cu, (const void*)fwd_kernel, NWAVES * 64, LDS_BYTES) != hipSuccess || per_cu < 1) { fprintf(stderr, "kernel_launch: occupancy query says %d blocks per CU\n", per_cu); }
        (void)hipGetLastError();
        grid = cus;
    }
    if (grid < 0) return;
    (void)in_sizes;
    if (hipMemsetAsync((char*)d_ws + WS_CTL, 0, CTL_ZERO_BYTES, stream) != hipSuccess) { fprintf(stderr, "kernel_launch: memset failed\n"); return; }
    Args a{};
    for (int k = 0; k < 28; ++k) a.in[k] = (const float*)d_in[k];
    a.out = (float*)d_out; a.ws = (unsigned char*)d_ws;
#if MK_ONE_LAUNCH
    a.ph_lo = 0; a.ph_hi = PH_END;
    hipLaunchKernelGGL(fwd_kernel, dim3(grid), dim3(NWAVES * 64), LDS_BYTES, stream, a);
#else
    for (int p = 0; p < PH_END; ++p) {
        if (p > 0) { const int l = (p - 1) / 10, s = (p - 1) % 10; if ((l & 1) == 0 && (s == 3 || s == 4)) continue; }
        a.ph_lo = p; a.ph_hi = p + 1;
        hipLaunchKernelGGL(fwd_kernel, dim3(grid), dim3(NWAVES * 64), LDS_BYTES, stream, a);
    }
#endif
    const hipError_t le = hipPeekAtLastError();
    if (le != hipSuccess) fprintf(stderr, "kernel_launch: launch failed: %s\n", hipGetErrorName(le));
}
```

```cpp
#include <hip/hip_runtime.h>
#include <cstdio>
#include <cstdint>
#include <cstddef>
__device__ __forceinline__ int lane_id_fresh() { int l = (int)__builtin_amdgcn_mbcnt_hi(~0u, __builtin_amdgcn_mbcnt_lo(~0u, 0u)); asm volatile("" : "+v"(l)); return l; }
namespace pg8 {
#define PG8_LAS __attribute__((address_space(3)))
typedef unsigned short bf16_t;
typedef short bf16x8 __attribute__((ext_vector_type(8)));
typedef float f32x4 __attribute__((ext_vector_type(4)));
typedef unsigned u32x4 __attribute__((ext_vector_type(4)));
constexpr int BM = 256, BK = 64, HALF = 128, HTB = HALF * BK * 2  , STAGE_BYTES = 8 * HTB, NXCD = 8, WGM = 8;

__host__ __device__ __forceinline__ int lds_byte(int r, int c) { const int st = (r >> 4) * 2 + (c >> 5), rr = r & 15, cc = c & 31, ob = rr * 64 + cc * 2; return st * 1024 + (ob ^ (((ob >> 9) & 1) << 5)); }
__host__ __device__ __forceinline__ void stage_rc(int b, int& R, int& C) { const int st = b / 1024, sb = b % 1024, swz = sb ^ (((sb >> 9) & 1) << 5); R = (st >> 1) * 16 + swz / 64; C = (st & 1) * 32 + (swz % 64) / 2; }
__host__ __device__ __forceinline__ int perm32(int rho) { const int n = rho >> 4, i = rho & 15; return 8 * (i >> 2) + 4 * n + (i & 3); }

struct Unit { int pm, pn; };
struct Gemm { const bf16_t* A; const bf16_t* Bt; int M, N, K; };

struct StaticOrder {
    int nM, nN, nwg, G, c;
    __host__ __device__ void init(int M, int N, int G_, int c_) { nM = M / BM; nN = N / BM; nwg = nM * nN; G = G_; c = c_; }
    __host__ __device__ bool next(int i, Unit& u) const {
        const long L = (long)i * G + c; if (L >= nwg) return false;
        int wgid = (int)L; { const int q = nwg / NXCD, r = nwg % NXCD, xcd = wgid % NXCD, off = wgid / NXCD; wgid = (xcd < r ? xcd * (q + 1) : r * (q + 1) + (xcd - r) * q) + off; }
        const int nig = WGM * nN, gid = wgid / nig, fm = gid * WGM, gsz = (nM - fm) < WGM ? (nM - fm) : WGM;
        u.pm = fm + ((wgid % nig) % gsz); u.pn = (wgid % nig) / gsz;
        if (u.pm < 64) u.pm = ((u.pm & 1) << 5) | (u.pm >> 1);
        return true;
    }
    __device__ __forceinline__ void a_ready(const Unit&) const {}
    __device__ __forceinline__ void done(const Unit&) const {}
};
__device__ __forceinline__ unsigned cvt_pk_bf16(float lo, float hi) { unsigned r; asm volatile("v_cvt_pk_bf16_f32 %0, %1, %2" : "=v"(r) : "v"(lo), "v"(hi)); return r; }

__device__ __forceinline__ int cond_of_pm(int pm) { return pm < 32 ? 0 : 1 + ((pm - 32) >> 3); }

struct EpiBf16P {
    static constexpr bool PERM = true, AFTER_DRAIN = false;
    bf16_t* O; int ldc;
    __device__ __forceinline__ void operator()(const f32x4 (&acc)[2][2][4][2], const Unit& u, int wr, int wc, int fr_in, int fq_in) const {
        (void)fr_in; (void)fq_in; const int lane_e = lane_id_fresh(), fr = lane_e & 15, fq = lane_e >> 4;
        const int row0 = u.pm * BM + wr * 64 + fr, col0 = u.pn * BM + wc * 32 + 8 * fq;
#pragma unroll
        for (int ai = 0; ai < 2; ++ai)
#pragma unroll
            for (int m = 0; m < 4; ++m) { bf16_t* rowp = O + (unsigned)(row0 + ai * HALF + m * 16) * (unsigned)ldc + col0;
#pragma unroll
                for (int bj = 0; bj < 2; ++bj) { const f32x4 v0 = acc[ai][bj][m][0], v1 = acc[ai][bj][m][1];
                    u32x4 w; w.x = cvt_pk_bf16(v0[0], v0[1]); w.y = cvt_pk_bf16(v0[2], v0[3]); w.z = cvt_pk_bf16(v1[0], v1[1]); w.w = cvt_pk_bf16(v1[2], v1[3]);
                    *(u32x4*)(rowp + bj * HALF) = w; } }
    }
};
struct EpiF32P {
    static constexpr bool PERM = false, AFTER_DRAIN = false;
    float* C; int ldc;
    __device__ __forceinline__ void operator()(const f32x4 (&acc)[2][2][4][2], const Unit& u, int wr, int wc, int fr_in, int fq_in) const {
        (void)fr_in; (void)fq_in; const int lane_e = lane_id_fresh(), fr = lane_e & 15, fq = lane_e >> 4;
        const int row0 = u.pm * BM + wr * 64 + fr, col0 = u.pn * BM + wc * 32 + 4 * fq;
#pragma unroll
        for (int ai = 0; ai < 2; ++ai)
#pragma unroll
            for (int m = 0; m < 4; ++m) { float* rowp = C + (unsigned)(row0 + ai * HALF + m * 16) * (unsigned)ldc + col0;
#pragma unroll
                for (int bj = 0; bj < 2; ++bj)
#pragma unroll
                    for (int n = 0; n < 2; ++n) *(f32x4*)(rowp + bj * HALF + n * 16) = acc[ai][bj][m][n]; }
    }
};
struct EpiRes {
    static constexpr bool PERM = false, AFTER_DRAIN = false;
    const _Float16* base; float* out; const float* gate;
    __device__ __forceinline__ void operator()(const f32x4 (&acc)[2][2][4][2], const Unit& u, int wr, int wc, int fr_in, int fq_in) const {
        typedef _Float16 h16x4 __attribute__((ext_vector_type(4)));
        (void)fr_in; (void)fq_in; const int lane_e = lane_id_fresh(), fr = lane_e & 15, fq = lane_e >> 4;
        const int row0 = u.pm * BM + wr * 64 + fr, col0 = u.pn * BM + wc * 32 + 4 * fq;
        const float* g = gate + (unsigned)cond_of_pm(u.pm) * 12288u + col0;
        f32x4 gv[2][2];
#pragma unroll
        for (int bj = 0; bj < 2; ++bj)
#pragma unroll
            for (int n = 0; n < 2; ++n) gv[bj][n] = *(const f32x4*)(g + bj * HALF + n * 16);
#pragma unroll
        for (int ai = 0; ai < 2; ++ai)
#pragma unroll
            for (int m = 0; m < 4; ++m) { const unsigned off = (unsigned)(row0 + ai * HALF + m * 16) * 2048u + col0;
#pragma unroll
                for (int bj = 0; bj < 2; ++bj)
#pragma unroll
                    for (int n = 0; n < 2; ++n) { const f32x4 bs = __builtin_convertvector(*(const h16x4*)(base + off + bj * HALF + n * 16), f32x4);
                        *(f32x4*)(out + off + bj * HALF + n * 16) = bs + gv[bj][n] * acc[ai][bj][m][n]; }
                if (m & 1) asm volatile("" ::: "memory"); }
    }
};
__device__ __forceinline__ float silu_f(float x) { return x * __builtin_amdgcn_rcpf(1.0f + __builtin_amdgcn_exp2f(-1.4426950408889634f * x)); }
__device__ __forceinline__ f32x4 swiglu4(const f32x4 g, const f32x4 u) {
    const f32x4 t = g * (-1.4426950408889634f);
    f32x4 d; d[0] = __builtin_amdgcn_exp2f(t[0]); d[1] = __builtin_amdgcn_exp2f(t[1]); d[2] = __builtin_amdgcn_exp2f(t[2]); d[3] = __builtin_amdgcn_exp2f(t[3]);
    d = d + 1.0f;
    f32x4 r; r[0] = __builtin_amdgcn_rcpf(d[0]); r[1] = __builtin_amdgcn_rcpf(d[1]); r[2] = __builtin_amdgcn_rcpf(d[2]); r[3] = __builtin_amdgcn_rcpf(d[3]);
    return (g * u) * r;
}
struct EpiSwiGLU {
    static constexpr bool PERM = true, AFTER_DRAIN = false;
    bf16_t* O; int ldc;
    __device__ __forceinline__ void operator()(const f32x4 (&acc)[2][2][4][2], const Unit& u, int wr, int wc, int fr_in, int fq_in) const {
        (void)fr_in; (void)fq_in; const int lane_e = lane_id_fresh(), fr = lane_e & 15, fq = lane_e >> 4;
        const int row0 = u.pm * BM + wr * 64 + fr, col0 = u.pn * HALF + wc * 32 + 8 * fq;
#pragma unroll
        for (int ai = 0; ai < 2; ++ai)
#pragma unroll
            for (int m = 0; m < 4; ++m) { bf16_t* rowp = O + (unsigned)(row0 + ai * HALF + m * 16) * (unsigned)ldc + col0;
                const f32x4 g0 = acc[ai][0][m][0], g1 = acc[ai][0][m][1], u0 = acc[ai][1][m][0], u1 = acc[ai][1][m][1];
                const f32x4 h0 = swiglu4(g0, u0), h1 = swiglu4(g1, u1);
                u32x4 w; w.x = cvt_pk_bf16(h0[0], h0[1]); w.y = cvt_pk_bf16(h0[2], h0[3]); w.z = cvt_pk_bf16(h1[0], h1[1]); w.w = cvt_pk_bf16(h1[2], h1[3]);
                *(u32x4*)rowp = w; }
    }
};

constexpr float NORM_EPS = 1e-6f;
__device__ __forceinline__ float sum_rows4(float s) {
    const auto a = __builtin_amdgcn_permlane16_swap(__float_as_uint(s), __float_as_uint(s), false, false); s = __uint_as_float(a[0]) + __uint_as_float(a[1]);
    const auto b = __builtin_amdgcn_permlane32_swap(__float_as_uint(s), __float_as_uint(s), false, false); return __uint_as_float(b[0]) + __uint_as_float(b[1]);
}
__device__ __forceinline__ float xor32(float y, bool upper) { const auto b = __builtin_amdgcn_permlane32_swap(__float_as_uint(y), __float_as_uint(y), false, false); return __uint_as_float(upper ? b[0] : b[1]); }
__device__ __forceinline__ void row_half_allreduce(float (&ss)[2][4][2], PG8_LAS float* red, int wr, int wc, int fr, int fq) {
#pragma unroll
    for (int ai = 0; ai < 2; ++ai)
#pragma unroll
        for (int m = 0; m < 4; ++m)
#pragma unroll
            for (int bj = 0; bj < 2; ++bj) ss[ai][m][bj] = sum_rows4(ss[ai][m][bj]);
    if (fq == 0) {
#pragma unroll
        for (int ai = 0; ai < 2; ++ai)
#pragma unroll
            for (int m = 0; m < 4; ++m)
#pragma unroll
                for (int bj = 0; bj < 2; ++bj) red[((ai * HALF + wr * 64 + m * 16 + fr) * 2 + bj) * 4 + wc] = ss[ai][m][bj];
    }
    asm volatile("s_waitcnt lgkmcnt(0)" ::: "memory"); __builtin_amdgcn_s_barrier(); asm volatile("" ::: "memory");
}
__device__ __forceinline__ void row_half_read(const PG8_LAS float* red, int ai, int m, int wr, int fr, float& s0, float& s1) {
    const PG8_LAS f32x4* p = (const PG8_LAS f32x4*)(red + (ai * HALF + wr * 64 + m * 16 + fr) * 8);
    const f32x4 a = p[0], b = p[1]; s0 = (a[0] + a[1]) + (a[2] + a[3]); s1 = (b[0] + b[1]) + (b[2] + b[3]);
}
__device__ __forceinline__ float dot4(const f32x4 a) { return (a[0] * a[0] + a[1] * a[1]) + (a[2] * a[2] + a[3] * a[3]); }
__device__ __forceinline__ u32x4 pack8(const f32x4 a, const f32x4 b) { u32x4 w; w.x = cvt_pk_bf16(a[0], a[1]); w.y = cvt_pk_bf16(a[2], a[3]); w.z = cvt_pk_bf16(b[0], b[1]); w.w = cvt_pk_bf16(b[2], b[3]); return w; }

struct EpiInAB {
    static constexpr bool PERM = true, AFTER_DRAIN = false;
    bf16_t* P; const float* gq; const float* gk; float* natk; float* natv; PG8_LAS float* red;
    __device__ __forceinline__ void operator()(const f32x4 (&acc)[2][2][4][2], const Unit& u, int wr, int wc, int fr_in, int fq_in) const {
        (void)fr_in; (void)fq_in; const int lane_e = lane_id_fresh(), fr = lane_e & 15, fq = lane_e >> 4;
        const int row0 = u.pm * BM + wr * 64 + fr, col0 = u.pn * BM + wc * 32 + 8 * fq, dh = wc * 32 + 8 * fq;
        if (u.pn < 8) {
            float ss[2][4][2];
#pragma unroll
            for (int ai = 0; ai < 2; ++ai)
#pragma unroll
                for (int m = 0; m < 4; ++m)
#pragma unroll
                    for (int bj = 0; bj < 2; ++bj) ss[ai][m][bj] = dot4(acc[ai][bj][m][0]) + dot4(acc[ai][bj][m][1]);
            row_half_allreduce(ss, red, wr, wc, fr, fq);
            const float* g = (u.pn < 4 ? gq : gk) + dh; const f32x4 g0 = *(const f32x4*)g, g1 = *(const f32x4*)(g + 4);
            const bool emit = u.pn >= 4 && u.pm < 32;
#pragma unroll
            for (int ai = 0; ai < 2; ++ai)
#pragma unroll
                for (int m = 0; m < 4; ++m) { bf16_t* rowp = P + (unsigned)(row0 + ai * HALF + m * 16) * 6144u + col0;
                    float st[2]; row_half_read(red, ai, m, wr, fr, st[0], st[1]);
#pragma unroll
                    for (int bj = 0; bj < 2; ++bj) { const float rstd = __builtin_amdgcn_rsqf(st[bj] * (1.0f / 128.0f) + NORM_EPS);
                        const f32x4 y0 = acc[ai][bj][m][0] * rstd * g0, y1 = acc[ai][bj][m][1] * rstd * g1;
                        *(u32x4*)(rowp + bj * HALF) = pack8(y0, y1);
                        if (emit) { const int h = (u.pn - 4) * 2 + bj, t = ai * HALF + wr * 64 + m * 16 + fr; float* dst = natk + ((unsigned)(u.pm * 16 + h) * 256u + (unsigned)t) * 128u + dh;
                            *(f32x4*)dst = y0; *(f32x4*)(dst + 4) = y1; } }
                    asm volatile("" ::: "memory"); }
        } else {
            const bool emit = u.pn < 12 && u.pm < 32;
#pragma unroll
            for (int ai = 0; ai < 2; ++ai)
#pragma unroll
                for (int m = 0; m < 4; ++m) { bf16_t* rowp = P + (unsigned)(row0 + ai * HALF + m * 16) * 6144u + col0;
#pragma unroll
                    for (int bj = 0; bj < 2; ++bj) { const f32x4 y0 = acc[ai][bj][m][0], y1 = acc[ai][bj][m][1];
                        *(u32x4*)(rowp + bj * HALF) = pack8(y0, y1);
                        if (emit) { const int h = (u.pn - 8) * 2 + bj, t = ai * HALF + wr * 64 + m * 16 + fr; float* dst = natv + ((unsigned)(u.pm * 16 + h) * 256u + (unsigned)t) * 128u + dh;
                            *(f32x4*)dst = y0; *(f32x4*)(dst + 4) = y1; } } }
        }
    }
};
struct EpiUQ {
    static constexpr bool PERM = true, AFTER_DRAIN = false;
    bf16_t* Qn; const float* gq; const float* CQP; float* QSQ;
    __device__ __forceinline__ void operator()(const f32x4 (&acc)[2][2][4][2], const Unit& u, int wr, int wc, int fr_in, int fq_in) const {
        (void)fr_in; (void)fq_in; const int lane_e = lane_id_fresh(), fr = lane_e & 15, fq = lane_e >> 4;
        const int row0 = u.pm * BM + wr * 64 + fr;
        float rq[2][4];
#pragma unroll
        for (int ai = 0; ai < 2; ++ai)
#pragma unroll
            for (int m = 0; m < 4; ++m) { const float* cp = CQP + (unsigned)(row0 + ai * HALF + m * 16) * 8u; const f32x4 a = *(const f32x4*)cp, b = *(const f32x4*)(cp + 4);
                rq[ai][m] = __builtin_amdgcn_rsqf((((a[0] + a[1]) + (a[2] + a[3])) + ((b[0] + b[1]) + (b[2] + b[3]))) * (1.0f / 512.0f) + NORM_EPS); }
        const bool lat = u.pm >= 32; const int jf = 8 * (fq & 1); const bool isx2 = (fq >> 1) != 0;
        f32x4 fr0, fr1;
#pragma unroll
        for (int e4 = 0; e4 < 4; ++e4) { fr0[e4] = exp2f(-(float)(jf + e4) * (13.287712379549449f / 16.0f)) * 0.15915494309189535f; fr1[e4] = exp2f(-(float)(jf + 4 + e4) * (13.287712379549449f / 16.0f)) * 0.15915494309189535f; }
#pragma unroll
        for (int bj = 0; bj < 2; ++bj) {
            const int blk = 4 * u.pn + 2 * bj + (wc >> 1), hd = blk / 3, part = blk - 3 * hd;
            const int dh = part * 64 + (wc & 1) * 32 + 8 * fq;
            const f32x4 g0 = *(const f32x4*)(gq + dh), g1 = *(const f32x4*)(gq + dh + 4);
            const bool rope = part == 2 && lat;
#pragma unroll
            for (int ai = 0; ai < 2; ++ai)
#pragma unroll
                for (int m = 0; m < 4; ++m) { const unsigned row = (unsigned)(row0 + ai * HALF + m * 16);
                    const f32x4 q0 = acc[ai][bj][m][0] * rq[ai][m], q1 = acc[ai][bj][m][1] * rq[ai][m];
                    const float s = sum_rows4(dot4(q0) + dot4(q1));
                    if (fq == 0) QSQ[row * 96u + 2 * blk + (wc & 1)] = s;
                    f32x4 y0 = q0 * g0, y1 = q1 * g1;
                    if (rope) {
                        const int t = ((int)row - 8192) & 2047; const float pos = (float)((wc & 1) ? (t & 63) : (t >> 6));
                        f32x4 c0, c1, s0, s1, p0, p1;
#pragma unroll
                        for (int e4 = 0; e4 < 4; ++e4) { c0[e4] = __builtin_amdgcn_cosf(pos * fr0[e4]); s0[e4] = __builtin_amdgcn_sinf(pos * fr0[e4]); c1[e4] = __builtin_amdgcn_cosf(pos * fr1[e4]); s1[e4] = __builtin_amdgcn_sinf(pos * fr1[e4]); }
#pragma unroll
                        for (int e4 = 0; e4 < 4; ++e4) { p0[e4] = xor32(y0[e4], isx2); p1[e4] = xor32(y1[e4], isx2); }
                        if (isx2) { y0 = p0 * s0 + y0 * c0; y1 = p1 * s1 + y1 * c1; } else { y0 = y0 * c0 - p0 * s0; y1 = y1 * c1 - p1 * s1; }
                    }
                    *(u32x4*)(Qn + row * 3072u + u.pn * BM + bj * HALF + wc * 32 + 8 * fq) = pack8(y0, y1);
                    asm volatile("" ::: "memory"); }
        }
    }
};
struct EpiUKV {
    static constexpr bool PERM = true, AFTER_DRAIN = false;
    bf16_t* Kn; bf16_t* Vn; const float* gk; const float* RK; const float* KRSQ; PG8_LAS float* red;
    __device__ __forceinline__ void operator()(const f32x4 (&acc)[2][2][4][2], const Unit& u, int wr, int wc, int fr_in, int fq_in) const {
        typedef unsigned u32x2v __attribute__((ext_vector_type(2)));
        (void)fr_in; (void)fq_in; const int lane_e = lane_id_fresh(), fr = lane_e & 15, fq = lane_e >> 4;
        const int row0 = u.pm * BM + wr * 64 + fr, dh = wc * 32 + 8 * fq, kc = wc * 16 + 4 * fq;
        f32x4 rk[2][4]; float ksq[2][4];
#pragma unroll
        for (int ai = 0; ai < 2; ++ai)
#pragma unroll
            for (int m = 0; m < 4; ++m) { const unsigned row = (unsigned)(row0 + ai * HALF + m * 16); rk[ai][m] = *(const f32x4*)(RK + row * 64u + kc); ksq[ai][m] = KRSQ[row]; }
        const f32x4 ga0 = *(const f32x4*)(gk + dh), ga1 = *(const f32x4*)(gk + dh + 4);
        float ss[2][4][2];
#pragma unroll
        for (int ai = 0; ai < 2; ++ai)
#pragma unroll
            for (int m = 0; m < 4; ++m) { ss[ai][m][0] = dot4(acc[ai][0][m][0]) + dot4(acc[ai][0][m][1]); ss[ai][m][1] = 0.f; }
        row_half_allreduce(ss, red, wr, wc, fr, fq);
#pragma unroll
        for (int ai = 0; ai < 2; ++ai)
#pragma unroll
            for (int m = 0; m < 4; ++m) { const unsigned row = (unsigned)(row0 + ai * HALF + m * 16); bf16_t* rowp = Kn + row * 3072u + u.pn * 192;
                float st0, st1; row_half_read(red, ai, m, wr, fr, st0, st1);
                const float rstd = __builtin_amdgcn_rsqf((st0 + ksq[ai][m]) * (1.0f / 192.0f) + NORM_EPS);
                *(u32x4*)(rowp + dh) = pack8(acc[ai][0][m][0] * rstd * ga0, acc[ai][0][m][1] * rstd * ga1);
                *(u32x4*)(Vn + row * 2048u + u.pn * 128 + dh) = pack8(acc[ai][1][m][0], acc[ai][1][m][1]);
                const f32x4 y = rk[ai][m] * rstd; u32x2v w; w.x = cvt_pk_bf16(y[0], y[1]); w.y = cvt_pk_bf16(y[2], y[3]);
                *(u32x2v*)(rowp + 128 + kc) = w; }
    }
};
struct EpiY {
    static constexpr bool PERM = true, AFTER_DRAIN = false;
    bf16_t* Y; const float* gate;
    __device__ __forceinline__ void operator()(const f32x4 (&acc)[2][2][4][2], const Unit& u, int wr, int wc, int fr_in, int fq_in) const {
        (void)fr_in; (void)fq_in; const int lane_e = lane_id_fresh(), fr = lane_e & 15, fq = lane_e >> 4;
        const int row0 = u.pm * BM + wr * 64 + fr, col0 = u.pn * BM + wc * 32 + 8 * fq;
        const float* g = gate + (unsigned)cond_of_pm(u.pm) * 12288u + col0;
        f32x4 gv[2][2];
#pragma unroll
        for (int bj = 0; bj < 2; ++bj)
#pragma unroll
            for (int n = 0; n < 2; ++n) gv[bj][n] = *(const f32x4*)(g + bj * HALF + n * 4);
#pragma unroll
        for (int ai = 0; ai < 2; ++ai)
#pragma unroll
            for (int m = 0; m < 4; ++m) { bf16_t* rowp = Y + (unsigned)(row0 + ai * HALF + m * 16) * 2048u + col0;
#pragma unroll
                for (int bj = 0; bj < 2; ++bj) *(u32x4*)(rowp + bj * HALF) = pack8(acc[ai][bj][m][0] * gv[bj][0], acc[ai][bj][m][1] * gv[bj][1]); }
    }
};
struct EpiDown {
    static constexpr bool PERM = true, AFTER_DRAIN = false;
    bf16_t* cqn; float* CQP; bf16_t* ckvn; const float* gckv; float* out_ckv; float* out_kr; const float* gkr; float* RK; float* KRSQ; PG8_LAS float* red;
    __device__ __forceinline__ void operator()(const f32x4 (&acc)[2][2][4][2], const Unit& u, int wr, int wc, int fr_in, int fq_in) const {
        (void)fr_in; (void)fq_in; const int lane_e = lane_id_fresh(), fr = lane_e & 15, fq = lane_e >> 4;
        const int row0 = u.pm * BM + wr * 64 + fr, dh = wc * 32 + 8 * fq;
        if (u.pn < 2) {
#pragma unroll
            for (int ai = 0; ai < 2; ++ai)
#pragma unroll
                for (int m = 0; m < 4; ++m) { const unsigned row = (unsigned)(row0 + ai * HALF + m * 16);
                    float s = (dot4(acc[ai][0][m][0]) + dot4(acc[ai][0][m][1])) + (dot4(acc[ai][1][m][0]) + dot4(acc[ai][1][m][1]));
                    s = sum_rows4(s);
                    if (fq == 0) CQP[row * 8u + u.pn * 4 + wc] = s;
#pragma unroll
                    for (int bj = 0; bj < 2; ++bj) *(u32x4*)(cqn + row * 512u + u.pn * 256 + bj * HALF + dh) = pack8(acc[ai][bj][m][0], acc[ai][bj][m][1]); }
        } else if (u.pn == 2) {
            float ss[2][4][2];
#pragma unroll
            for (int ai = 0; ai < 2; ++ai)
#pragma unroll
                for (int m = 0; m < 4; ++m)
#pragma unroll
                    for (int bj = 0; bj < 2; ++bj) ss[ai][m][bj] = dot4(acc[ai][bj][m][0]) + dot4(acc[ai][bj][m][1]);
            row_half_allreduce(ss, red, wr, wc, fr, fq);
            f32x4 g[2][2];
#pragma unroll
            for (int bj = 0; bj < 2; ++bj) { g[bj][0] = *(const f32x4*)(gckv + bj * HALF + dh); g[bj][1] = *(const f32x4*)(gckv + bj * HALF + dh + 4); }
#pragma unroll
            for (int ai = 0; ai < 2; ++ai)
#pragma unroll
                for (int m = 0; m < 4; ++m) { const unsigned row = (unsigned)(row0 + ai * HALF + m * 16);
                    float st0, st1; row_half_read(red, ai, m, wr, fr, st0, st1);
                    const float rstd = __builtin_amdgcn_rsqf((st0 + st1) * (1.0f / 256.0f) + NORM_EPS);
#pragma unroll
                    for (int bj = 0; bj < 2; ++bj) { const f32x4 y0 = acc[ai][bj][m][0] * rstd * g[bj][0], y1 = acc[ai][bj][m][1] * rstd * g[bj][1];
                        *(u32x4*)(ckvn + row * 256u + bj * HALF + dh) = pack8(y0, y1);
                        if (u.pm < 32) { float* dst = out_ckv + ((unsigned)(u.pm * 2) * 256u + (unsigned)(ai * HALF + wr * 64 + m * 16 + fr)) * 256u + bj * HALF + dh; *(f32x4*)dst = y0; *(f32x4*)(dst + 4) = y1; } }
                    asm volatile("" ::: "memory"); }
        } else {
            const bool mine = wc < 2;
            float ss[2][4][2];
#pragma unroll
            for (int ai = 0; ai < 2; ++ai)
#pragma unroll
                for (int m = 0; m < 4; ++m) { ss[ai][m][0] = mine ? dot4(acc[ai][0][m][0]) + dot4(acc[ai][0][m][1]) : 0.f; ss[ai][m][1] = 0.f; }
            row_half_allreduce(ss, red, wr, wc, fr, fq);
            f32x4 g0 = {0.f, 0.f, 0.f, 0.f}, g1 = {0.f, 0.f, 0.f, 0.f};
            if (mine) { g0 = *(const f32x4*)(gkr + dh); g1 = *(const f32x4*)(gkr + dh + 4); }
            const bool lat = u.pm >= 32; const int jf = 8 * (fq & 1); const bool isx2 = (fq >> 1) != 0;
            f32x4 fr0, fr1;
#pragma unroll
            for (int e4 = 0; e4 < 4; ++e4) { fr0[e4] = exp2f(-(float)(jf + e4) * (13.287712379549449f / 16.0f)) * 0.15915494309189535f; fr1[e4] = exp2f(-(float)(jf + 4 + e4) * (13.287712379549449f / 16.0f)) * 0.15915494309189535f; }
#pragma unroll
            for (int ai = 0; ai < 2; ++ai)
#pragma unroll
                for (int m = 0; m < 4; ++m) { const unsigned row = (unsigned)(row0 + ai * HALF + m * 16);
                    float st0, st1; row_half_read(red, ai, m, wr, fr, st0, st1);
                    if (wc == 0 && fq == 0) KRSQ[row] = st0;
                    const f32x4 k0 = acc[ai][0][m][0], k1 = acc[ai][0][m][1];
                    if (mine && u.pm < 32) { float* dst = out_kr + ((unsigned)(u.pm * 2) * 256u + (unsigned)(ai * HALF + wr * 64 + m * 16 + fr)) * 64u + dh; *(f32x4*)dst = k0; *(f32x4*)(dst + 4) = k1; }
                    f32x4 y0 = k0 * g0, y1 = k1 * g1;
                    if (lat && mine) {
                        const int t = ((int)row - 8192) & 2047; const float pos = (float)(wc ? (t & 63) : (t >> 6));
                        f32x4 c0, c1, s0, s1, p0, p1;
#pragma unroll
                        for (int e4 = 0; e4 < 4; ++e4) { c0[e4] = __builtin_amdgcn_cosf(pos * fr0[e4]); s0[e4] = __builtin_amdgcn_sinf(pos * fr0[e4]); c1[e4] = __builtin_amdgcn_cosf(pos * fr1[e4]); s1[e4] = __builtin_amdgcn_sinf(pos * fr1[e4]); }
#pragma unroll
                        for (int e4 = 0; e4 < 4; ++e4) { p0[e4] = xor32(y0[e4], isx2); p1[e4] = xor32(y1[e4], isx2); }
                        if (isx2) { y0 = p0 * s0 + y0 * c0; y1 = p1 * s1 + y1 * c1; } else { y0 = y0 * c0 - p0 * s0; y1 = y1 * c1 - p1 * s1; }
                    }
                    if (mine) { float* dst = RK + row * 64u + dh; *(f32x4*)dst = y0; *(f32x4*)(dst + 4) = y1; }
                    asm volatile("" ::: "memory"); }
        }
    }
};
template <class Epi, class Sched, bool ALIGN_EPI = false, bool SP2 = false>
__device__ __forceinline__ void gemm_phase(PG8_LAS unsigned char* lds, const Gemm g, const Sched& S, const Epi& E, const int wid_in) {
    const int tid_ = wid_in * 64 + lane_id_fresh();
    const int tid = tid_, wid = wid_in, lane = tid & 63, wr = wid >> 2, wc = wid & 3, fr = lane & 15, fq = lane >> 4;
    int K_ = g.K; asm volatile("" : "+s"(K_));
    const int K = K_, nt = K / BK;
    unsigned voffA[2], voffB[2];
#pragma unroll
    for (int i = 0; i < 2; ++i) { int R, C; stage_rc(tid * 16 + i * 8192, R, C); const int Rb = Epi::PERM ? ((R & ~31) + perm32(R & 31)) : R;
        voffA[i] = (unsigned)(R * K + C) * 2u; voffB[i] = (unsigned)(Rb * K + C) * 2u; }
    const size_t kstep = (size_t)(BK * 2);
    const size_t hstep = (size_t)HALF * K * 2;
    const size_t tstep = 2 * hstep;
    const unsigned ldsw = (unsigned)wid * 1024u;
    const int aoff = lds_byte(wr * 64 + fr, fq * 8), boff = lds_byte(wc * 32 + fr, fq * 8);
#define PG8_SA(b, h) (((b) * 2 + (h)) * HTB)
#define PG8_SB(b, h) ((4 + (b) * 2 + (h)) * HTB)
#define PG8_STAGE(bufoff, gbase, voff) do { _Pragma("unroll") for (int _i = 0; _i < 2; ++_i) \
        __builtin_amdgcn_global_load_lds((const unsigned*)((const char*)(gbase) + (voff)[_i]), (PG8_LAS unsigned*)(lds + (bufoff) + ldsw + _i * 8192), 16, 0, 0); } while (0)
#define PG8_LDA(dst, b, h) do { _Pragma("unroll") for (int m = 0; m < 4; ++m) _Pragma("unroll") for (int k = 0; k < 2; ++k) dst[m][k] = *(const PG8_LAS bf16x8*)(lds + PG8_SA(b, h) + aoff + m * 2048 + k * 1024); } while (0)
#define PG8_LDB(dst, b, h) do { _Pragma("unroll") for (int n = 0; n < 2; ++n) _Pragma("unroll") for (int k = 0; k < 2; ++k) dst[n][k] = *(const PG8_LAS bf16x8*)(lds + PG8_SB(b, h) + boff + n * 2048 + k * 1024); } while (0)
#define PG8_MMA(ai, bj, At, Bt) do { __builtin_amdgcn_s_setprio(1); _Pragma("unroll") for (int m = 0; m < 4; ++m) _Pragma("unroll") for (int n = 0; n < 2; ++n) _Pragma("unroll") for (int k = 0; k < 2; ++k) \
        acc[ai][bj][m][n] = __builtin_amdgcn_mfma_f32_16x16x32_bf16(Bt[n][k], At[m][k], acc[ai][bj][m][n], 0, 0, 0); __builtin_amdgcn_s_setprio(0); } while (0)
#define PG8_WAIT_V(n) asm volatile("s_waitcnt vmcnt(" #n ")" ::: "memory")
#define PG8_WAIT_L(n) asm volatile("s_waitcnt lgkmcnt(" #n ")" ::: "memory")
#define PG8_BAR __builtin_amdgcn_s_barrier()
#define PG8_SCHED __builtin_amdgcn_sched_barrier(0)
    Unit cur, nxt; int ui = 0;
    if (!S.next(0, cur)) return;
    f32x4 acc[2][2][4][2];
#pragma unroll
    for (int a = 0; a < 2; ++a)
#pragma unroll
        for (int b = 0; b < 2; ++b)
#pragma unroll
            for (int m = 0; m < 4; ++m)
#pragma unroll
                for (int n = 0; n < 2; ++n) acc[a][b][m][n] = (f32x4){0.f, 0.f, 0.f, 0.f};
    bf16x8 At[4][2], B0[2][2], B1[2][2];
    const char* cA = (const char*)g.A + (size_t)cur.pm * tstep; const char* cB = (const char*)g.Bt + (size_t)cur.pn * tstep;
    S.a_ready(cur);
    if constexpr (SP2) {
        PG8_STAGE(PG8_SB(0, 0), cB, voffB); PG8_STAGE(PG8_SB(0, 1), cB + hstep, voffB); PG8_STAGE(PG8_SA(0, 0), cA, voffA); PG8_STAGE(PG8_SA(0, 1), cA + hstep, voffA);
        if (wr == 1) PG8_BAR;
        PG8_WAIT_V(2); PG8_BAR;
        PG8_STAGE(PG8_SB(1, 0), cB + kstep, voffB); PG8_STAGE(PG8_SA(1, 0), cA + kstep, voffA); PG8_STAGE(PG8_SB(1, 1), cB + hstep + kstep, voffB);
        PG8_WAIT_V(6); PG8_BAR;
    } else {
        PG8_STAGE(PG8_SB(0, 0), cB, voffB); PG8_STAGE(PG8_SA(0, 0), cA, voffA); PG8_STAGE(PG8_SB(0, 1), cB + hstep, voffB); PG8_STAGE(PG8_SA(0, 1), cA + hstep, voffA);
        if (wr == 1) PG8_BAR;
        PG8_WAIT_V(4); PG8_BAR;
        PG8_STAGE(PG8_SB(1, 0), cB + kstep, voffB); PG8_STAGE(PG8_SA(1, 0), cA + kstep, voffA); PG8_STAGE(PG8_SB(1, 1), cB + hstep + kstep, voffB);
        PG8_WAIT_V(6); PG8_BAR;
    }
    for (;;) {
        const bool has_next = S.next(ui + 1, nxt);
        const char* nA = has_next ? (const char*)g.A + (size_t)nxt.pm * tstep : cA; const char* nB = has_next ? (const char*)g.Bt + (size_t)nxt.pn * tstep : cB;
        for (int t = 0; t < nt; t += 2) {
            const bool last = (t == nt - 2);
            const char* a1 = cA + (size_t)(t + 1) * kstep;
            const char* a2 = last ? nA : cA + (size_t)(t + 2) * kstep; const char* b2 = last ? nB : cB + (size_t)(t + 2) * kstep;
            const char* a3 = a2 + kstep; const char* b3 = b2 + kstep;
            if (last && has_next) S.a_ready(nxt);
            if constexpr (SP2) {
            PG8_LDB(B0, 0, 0); PG8_LDB(B1, 0, 1); PG8_SCHED; PG8_LDA(At, 0, 0); PG8_STAGE(PG8_SA(1, 1), a1 + hstep, voffA);
            PG8_WAIT_V(8); PG8_WAIT_L(0); PG8_BAR; PG8_MMA(0, 0, At, B0); PG8_MMA(0, 1, At, B1); PG8_BAR; PG8_SCHED;
            PG8_LDA(At, 0, 1); PG8_STAGE(PG8_SB(0, 0), b2, voffB); PG8_STAGE(PG8_SB(0, 1), b2 + hstep, voffB); PG8_STAGE(PG8_SA(0, 0), a2, voffA);
            PG8_WAIT_V(8); PG8_WAIT_L(0); PG8_BAR; PG8_MMA(1, 0, At, B0); PG8_MMA(1, 1, At, B1); PG8_BAR; PG8_SCHED;
            PG8_LDB(B0, 1, 0); PG8_LDB(B1, 1, 1); PG8_SCHED; PG8_LDA(At, 1, 0); PG8_STAGE(PG8_SA(0, 1), a2 + hstep, voffA);
            PG8_WAIT_V(8); PG8_WAIT_L(0); PG8_BAR; PG8_MMA(0, 0, At, B0); PG8_MMA(0, 1, At, B1); PG8_BAR; PG8_SCHED;
            PG8_LDA(At, 1, 1); PG8_STAGE(PG8_SB(1, 0), b3, voffB); PG8_STAGE(PG8_SB(1, 1), b3 + hstep, voffB); PG8_STAGE(PG8_SA(1, 0), a3, voffA);
            PG8_WAIT_V(8); PG8_WAIT_L(0); PG8_BAR; PG8_MMA(1, 0, At, B0); PG8_MMA(1, 1, At, B1); PG8_BAR; PG8_SCHED;
            } else {
            PG8_LDB(B0, 0, 0); PG8_SCHED; PG8_LDA(At, 0, 0); PG8_STAGE(PG8_SA(1, 1), a1 + hstep, voffA);
            PG8_WAIT_L(8); PG8_BAR; PG8_WAIT_L(0); PG8_MMA(0, 0, At, B0); PG8_BAR; PG8_SCHED;
            PG8_LDB(B1, 0, 1); PG8_STAGE(PG8_SB(0, 0), b2, voffB);
            PG8_BAR; PG8_WAIT_L(0); PG8_MMA(0, 1, At, B1); PG8_BAR;
            PG8_LDA(At, 0, 1); PG8_STAGE(PG8_SA(0, 0), a2, voffA);
            PG8_BAR; PG8_WAIT_L(0); PG8_MMA(1, 0, At, B0); PG8_BAR; PG8_SCHED;
            PG8_STAGE(PG8_SB(0, 1), b2 + hstep, voffB);
            PG8_WAIT_V(6); PG8_BAR; PG8_MMA(1, 1, At, B1); PG8_BAR;
            PG8_LDB(B0, 1, 0); PG8_SCHED; PG8_LDA(At, 1, 0); PG8_STAGE(PG8_SA(0, 1), a2 + hstep, voffA);
            PG8_WAIT_L(8); PG8_BAR; PG8_WAIT_L(0); PG8_MMA(0, 0, At, B0); PG8_BAR; PG8_SCHED;
            PG8_LDB(B1, 1, 1); PG8_STAGE(PG8_SB(1, 0), b3, voffB);
            PG8_BAR; PG8_WAIT_L(0); PG8_MMA(0, 1, At, B1); PG8_BAR;
            PG8_LDA(At, 1, 1); PG8_STAGE(PG8_SA(1, 0), a3, voffA);
            PG8_BAR; PG8_WAIT_L(0); PG8_MMA(1, 0, At, B0); PG8_BAR; PG8_SCHED;
            PG8_STAGE(PG8_SB(1, 1), b3 + hstep, voffB);
            PG8_WAIT_V(6); PG8_BAR; PG8_MMA(1, 1, At, B1); PG8_BAR;
            }
        }
        if constexpr (ALIGN_EPI) { if (wr == 0) PG8_BAR; }
        if constexpr (!Epi::AFTER_DRAIN) { E(acc, cur, wr, wc, fr, fq); S.done(cur); }
        if (!has_next) break;
#pragma unroll
        for (int a = 0; a < 2; ++a)
#pragma unroll
            for (int b = 0; b < 2; ++b)
#pragma unroll
                for (int m = 0; m < 4; ++m)
#pragma unroll
                    for (int n = 0; n < 2; ++n) acc[a][b][m][n] = (f32x4){0.f, 0.f, 0.f, 0.f};
        cur = nxt; cA = nA; cB = nB; ++ui;
        if constexpr (ALIGN_EPI) { if (wr == 1) PG8_BAR; }
    }
    PG8_WAIT_V(0);
    if constexpr (!ALIGN_EPI) { if (wr == 0) PG8_BAR; }
    PG8_BAR;
    if constexpr (Epi::AFTER_DRAIN) { E.fused(acc, cur, wr, wc, fr, fq, lds, wid, lane); S.done(cur); }
#undef PG8_SA
#undef PG8_SB
#undef PG8_STAGE
#undef PG8_LDA
#undef PG8_LDB
#undef PG8_MMA
#undef PG8_WAIT_V
#undef PG8_WAIT_L
#undef PG8_BAR
#undef PG8_SCHED
}
}
#define GAS __attribute__((address_space(1)))
#define LAS __attribute__((address_space(3)))
typedef unsigned short bf16;
typedef unsigned v4u __attribute__((ext_vector_type(4)));
typedef float f32x4 __attribute__((ext_vector_type(4)));
typedef short bf16x8 __attribute__((ext_vector_type(8)));
typedef GAS unsigned gu32;
typedef GAS unsigned long long gu64;
#define RLX_AGENT __ATOMIC_RELAXED, __HIP_MEMORY_SCOPE_AGENT
#define LDS_WAIT() asm volatile("s_waitcnt lgkmcnt(0)" ::: "memory")
#define VM_WAIT() asm volatile("s_waitcnt vmcnt(0)" ::: "memory")
__device__ __forceinline__ unsigned long long rt() { return __builtin_amdgcn_s_memrealtime(); }
__device__ __forceinline__ unsigned f2bf(float f) { unsigned u = __builtin_bit_cast(unsigned, f); return (u + 0x7fffu + ((u >> 16) & 1u)) >> 16; }
__device__ __forceinline__ unsigned pk2(float lo, float hi) { return f2bf(lo) | (f2bf(hi) << 16); }
#define XB_TMO      128
#define XB_XCNT(j)  (256  + 64 * (j))
#define XB_XSUB(j)  (1280 + 64 * (j))
#define XB_XGEN(j)  (2304 + 64 * (j))
#define XB_TOP      3328
#define XB_TOPGEN   3392
#define XCD_BAR_WORDS 3456
#define XB_SPIN_CAP (1u << 18)

__device__ __forceinline__ unsigned xb_ld(unsigned* p)              { return __hip_atomic_load(p, __ATOMIC_RELAXED, __HIP_MEMORY_SCOPE_AGENT); }
__device__ __forceinline__ unsigned xb_add(unsigned* p, unsigned v) { return __hip_atomic_fetch_add(p, v, __ATOMIC_RELAXED, __HIP_MEMORY_SCOPE_AGENT); }
__device__ __forceinline__ unsigned xb_xcc_id() { return (unsigned)__builtin_amdgcn_s_getreg((3 << 11) | 20) & 0xFu; }
#define XB_SPIN(cond, bar) do { unsigned _sp = 0; while (cond) { __builtin_amdgcn_s_sleep(1); \
    if ((++_sp & 255u) == 0u) { if (xb_ld(&(bar)[XB_TMO])) break; if (_sp > XB_SPIN_CAP) { atomicAdd(&(bar)[XB_TMO], 1u); break; } } } } while (0)

struct XcdBarrier {
    unsigned* bar; unsigned x;
    volatile LAS unsigned* st;
};

__device__ __forceinline__ XcdBarrier xcd_barrier_post(unsigned* bar, volatile LAS unsigned* st) {
    XcdBarrier b; b.bar = bar; b.x = xb_xcc_id(); b.st = st;
    if (threadIdx.x == 0) (void)xb_add(&bar[XB_XCNT(b.x)], 1u);
    return b;
}
__device__ __forceinline__ void xcd_barrier_complete(unsigned* bar, unsigned x, unsigned& nloc, unsigned& nx) {
    const unsigned G = gridDim.x * gridDim.y * gridDim.z;
    unsigned sum, cnt, mine, sp = 0u;
    for (;;) {
        sum = 0u; cnt = 0u; mine = 0u;
#pragma unroll
        for (unsigned j = 0; j < 16; ++j) { const unsigned c = xb_ld(&bar[XB_XCNT(j)]); sum += c; cnt += (c > 0u) ? 1u : 0u; mine = (j == x) ? c : mine; }
        if (sum == G) break;
        __builtin_amdgcn_s_sleep(1);
        if ((++sp & 255u) == 0u) { if (xb_ld(&bar[XB_TMO])) break; if (sp > XB_SPIN_CAP) { atomicAdd(&bar[XB_TMO], 1u); break; } }
    }
    nloc = mine > 0u ? mine : 1u; nx = cnt > 0u ? cnt : 1u;
}

__device__ __forceinline__ void xcd_barrier(const XcdBarrier& b) {
    asm volatile("s_waitcnt vmcnt(0)" ::: "memory");
    __syncthreads();
    if (threadIdx.x == 0) {
        unsigned* bar = b.bar;
        __builtin_amdgcn_s_waitcnt(0);
        unsigned nloc = b.st[0], nx = b.st[1];
        if (nloc == 0u) { xcd_barrier_complete(bar, b.x, nloc, nx); b.st[0] = nloc; b.st[1] = nx; }
        const unsigned old = xb_add(&bar[XB_XSUB(b.x)], 1u);
        const unsigned gen = old / nloc;
        if (old + 1u == (gen + 1u) * nloc) {
            __builtin_amdgcn_fence(__ATOMIC_RELEASE, "agent");
            asm volatile("s_waitcnt vmcnt(0)" ::: "memory");
            const unsigned og = xb_add(&bar[XB_TOP], 1u);
            const unsigned tg = og / nx;
            if (og + 1u == (tg + 1u) * nx) xb_add(&bar[XB_TOPGEN], 1u);
            else XB_SPIN(xb_ld(&bar[XB_TOPGEN]) == tg, bar);
            __builtin_amdgcn_fence(__ATOMIC_ACQUIRE, "agent");
            xb_add(&bar[XB_XGEN(b.x)], 1u);
            asm volatile("s_waitcnt vmcnt(0)" ::: "memory");
        } else {
            XB_SPIN(xb_ld(&bar[XB_XGEN(b.x)]) == gen, bar);
            __builtin_amdgcn_fence(__ATOMIC_ACQUIRE, "agent");
            asm volatile("s_waitcnt vmcnt(0)" ::: "memory");
        }
    }
    __syncthreads();
}

namespace att {
struct ProbeT { unsigned long long acc, last; int state; };
#ifdef PROBE_SUB
#define ATT_MARK(k) do { const unsigned long long now_ = __builtin_amdgcn_s_memrealtime(); if (PT.state == PROBE_SUB) PT.acc += now_ - PT.last; PT.last = now_; PT.state = (k); } while (0)
#define ATT_PROBE_PARAM , ProbeT& PT
#else
#define ATT_MARK(k) do { } while (0)
#define ATT_PROBE_PARAM
#endif
typedef unsigned short bf16_t;
using bf16x8 = __attribute__((ext_vector_type(8))) short;
using s16x4  = __attribute__((ext_vector_type(4))) short;
using f32x16 = __attribute__((ext_vector_type(16))) float;
using u32x4  = __attribute__((ext_vector_type(4))) unsigned;
constexpr int NW = 8, QBLK = 32, KVBLK = 64;
constexpr int VBUF = KVBLK * 128 * 2;
#define ATT_SBAR() __builtin_amdgcn_sched_barrier(0)
__device__ __forceinline__ int crow(int r, int hi) { return (r & 3) + 8 * (r >> 2) + 4 * hi; }
__device__ __forceinline__ unsigned cvtpk(float lo, float hi) { unsigned r; asm volatile("v_cvt_pk_bf16_f32 %0, %1, %2" : "=v"(r) : "v"(lo), "v"(hi)); return r; }
template <int DQ> __device__ __forceinline__ int kswz(int row, int colB) { return row * (DQ * 2) + (colB ^ ((row & 7) << 4)); }

__device__ __forceinline__ void partialSM(f32x16& p0, f32x16& p1, float& m_reg, float& mn, float& alpha, const float C, const float thr, const float rs = 1.f) {
  float pmax = p0[0];
#pragma unroll
  for (int r = 1; r < 16; ++r) pmax = fmaxf(pmax, p0[r]);
#pragma unroll
  for (int r = 0; r < 16; ++r) pmax = fmaxf(pmax, p1[r]);
  { auto rr = __builtin_amdgcn_permlane32_swap(__float_as_uint(pmax), __float_as_uint(pmax), false, false);
    pmax = fmaxf(__uint_as_float(rr[0]), __uint_as_float(rr[1])) * rs; }
  if (__builtin_expect(__all(pmax - m_reg <= thr), 1)) { mn = m_reg; alpha = 1.f; }
  else { mn = fmaxf(m_reg, pmax); alpha = __builtin_amdgcn_exp2f((m_reg - mn) * C); m_reg = mn; }
  const float mnC = -mn * C, Cl = C * rs;
#pragma unroll
  for (int r = 0; r < 16; ++r) p0[r] = fmaf(p0[r], Cl, mnC);
#pragma unroll
  for (int r = 0; r < 16; ++r) p1[r] = fmaf(p1[r], Cl, mnC);
#pragma unroll
  for (int r = 0; r < 16; ++r) p0[r] = __builtin_amdgcn_exp2f(p0[r]);
}
__device__ __forceinline__ void finishSM(f32x16& p0, f32x16& p1, float alpha, float& l_reg, bf16x8& pa0, bf16x8& pa1, bf16x8& pa2, bf16x8& pa3) {
#pragma unroll
  for (int r = 0; r < 16; ++r) p1[r] = __builtin_amdgcn_exp2f(p1[r]);
  float ps = 0;
#pragma unroll
  for (int r = 0; r < 16; ++r) ps += p0[r];
#pragma unroll
  for (int r = 0; r < 16; ++r) ps += p1[r];
  { auto rr = __builtin_amdgcn_permlane32_swap(__float_as_uint(ps), __float_as_uint(ps), false, false);
    ps = __uint_as_float(rr[0]) + __uint_as_float(rr[1]); }
  l_reg = l_reg * alpha + ps;
#define ATT_PK4(P, BASE, OUT) do { unsigned a0 = cvtpk(P[BASE + 0], P[BASE + 1]), a1 = cvtpk(P[BASE + 2], P[BASE + 3]);   \
    unsigned b0 = cvtpk(P[BASE + 4], P[BASE + 5]), b1 = cvtpk(P[BASE + 6], P[BASE + 7]);                              \
    auto r0 = __builtin_amdgcn_permlane32_swap(a0, b0, false, false); auto r1 = __builtin_amdgcn_permlane32_swap(a1, b1, false, false); \
    u32x4 w = {r0[0], r1[0], r0[1], r1[1]}; OUT = *reinterpret_cast<bf16x8*>(&w); } while (0)
  ATT_PK4(p0, 0, pa0); ATT_PK4(p0, 8, pa1); ATT_PK4(p1, 0, pa2); ATT_PK4(p1, 8, pa3);
#undef ATT_PK4
}
template <int OFF> __device__ __forceinline__ bf16x8 lds_rd128(unsigned addr) { bf16x8 r; asm volatile("ds_read_b128 %0, %1 offset:%2" : "=&v"(r) : "v"(addr), "i"(OFF) : "memory"); return r; }
template <int N> __device__ __forceinline__ void lgkm_wait() { static_assert(N == 0 || N == 2 || N == 4 || N == 6, "count"); if constexpr (N == 0) asm volatile("s_waitcnt lgkmcnt(0)" ::: "memory"); else if constexpr (N == 2) asm volatile("s_waitcnt lgkmcnt(2)" ::: "memory"); else if constexpr (N == 4) asm volatile("s_waitcnt lgkmcnt(4)" ::: "memory"); else asm volatile("s_waitcnt lgkmcnt(6)" ::: "memory"); }
template <int GS, int G, int S = 0> struct QktLoad {
  static __device__ __forceinline__ void run(unsigned kb, bf16x8 (&f0)[2][GS], bf16x8 (&f1)[2][GS]) {
    f0[G & 1][S] = lds_rd128<(G * GS + S) * 2048>(kb); f1[G & 1][S] = lds_rd128<(G * GS + S) * 2048 + 512>(kb);
    if constexpr (S + 1 < GS) QktLoad<GS, G, S + 1>::run(kb, f0, f1);
  }
};
template <int DQ, int GS, int G = 0> struct QktStep {
  static __device__ __forceinline__ void run(f32x16& p0, f32x16& p1, unsigned kb, const bf16x8* qr, bf16x8 (&f0)[2][GS], bf16x8 (&f1)[2][GS]) {
    constexpr int NG = DQ / 16 / GS;
    if constexpr (G + 1 < NG) { QktLoad<GS, G + 1>::run(kb, f0, f1); lgkm_wait<2 * GS>(); } else lgkm_wait<0>();
    ATT_SBAR();
#pragma unroll
    for (int s_ = 0; s_ < GS; ++s_) { p0 = __builtin_amdgcn_mfma_f32_32x32x16_bf16(f0[G & 1][s_], qr[G * GS + s_], p0, 0, 0, 0); p1 = __builtin_amdgcn_mfma_f32_32x32x16_bf16(f1[G & 1][s_], qr[G * GS + s_], p1, 0, 0, 0); }
    ATT_SBAR();
    if constexpr (G + 1 < NG) QktStep<DQ, GS, G + 1>::run(p0, p1, kb, qr, f0, f1);
  }
};
template <int DQ, int GS> __device__ __forceinline__ void qkt(f32x16& p0, f32x16& p1, const char* Ks, const bf16x8* qr, int r32, int hi) {
  static_assert((DQ / 16) % GS == 0 && GS >= 1 && GS <= 3, "group size");
  p0 = f32x16{}; p1 = f32x16{};
  const unsigned kb = (unsigned)(uintptr_t)Ks + (unsigned)(hi * 1024 + r32 * 16);
  bf16x8 f0[2][GS], f1[2][GS];
  QktLoad<GS, 0>::run(kb, f0, f1);
  QktStep<DQ, GS, 0>::run(p0, p1, kb, qr, f0, f1);
}
__device__ __forceinline__ int v_st(int k, int c) { const int kk = (k & ~0xC) | ((k & 4) << 1) | ((k & 8) >> 1); return ((kk >> 3) * 4 + (c >> 5)) * 512 + ((kk & 7) * 32 + (c & 31)) * 2; }
__device__ __forceinline__ int v_rd_base(int lane) { return ((lane & 3) << 3) | (((lane >> 2) & 3) << 6) | (((lane >> 4) & 1) << 5) | (((lane >> 5) & 1) << 8); }
constexpr int v_rd_off(int d0, int ks, int half) { return d0 * 512 + ks * 4096 + half * 2048; }
template <int OFF> __device__ __forceinline__ s16x4 tr_read(int vb) {
  s16x4 r; asm volatile("ds_read_b64_tr_b16 %0, %1 offset:%2" : "=&v"(r) : "v"(vb), "i"(OFF) : "memory"); return r;
}
template <int HB> __device__ __forceinline__ void pv_rd(s16x4 (&s)[4], int vb) {
  constexpr int D0 = HB >> 1, K0 = 2 * (HB & 1);
  s[0] = tr_read<v_rd_off(D0, K0, 0)>(vb); s[1] = tr_read<v_rd_off(D0, K0, 1)>(vb); s[2] = tr_read<v_rd_off(D0, K0 + 1, 0)>(vb); s[3] = tr_read<v_rd_off(D0, K0 + 1, 1)>(vb);
}
__device__ __forceinline__ void pv_mm(f32x16& od, const s16x4 (&s)[4], bf16x8 pa, bf16x8 pb) {
#define ATT_PK(L, H) (bf16x8){L[0], L[1], L[2], L[3], H[0], H[1], H[2], H[3]}
  od = __builtin_amdgcn_mfma_f32_32x32x16_bf16(pa, ATT_PK(s[0], s[1]), od, 0, 0, 0);
  od = __builtin_amdgcn_mfma_f32_32x32x16_bf16(pb, ATT_PK(s[2], s[3]), od, 0, 0, 0);
#undef ATT_PK
}
template <int H> __device__ __forceinline__ void pv_half(f32x16* o, int vb, bf16x8 pa0, bf16x8 pa1, bf16x8 pa2, bf16x8 pa3) {
  s16x4 s0[4], s1[4], s2[4];
#define ATT_W8() asm volatile("s_waitcnt lgkmcnt(8)" ::: "memory")
#define ATT_W4() asm volatile("s_waitcnt lgkmcnt(4)" ::: "memory")
#define ATT_W0() asm volatile("s_waitcnt lgkmcnt(0)" ::: "memory")
  pv_rd<4 * H + 0>(s0, vb); pv_rd<4 * H + 1>(s1, vb);
  pv_rd<4 * H + 2>(s2, vb); ATT_W8(); ATT_SBAR(); pv_mm(o[2 * H], s0, pa0, pa1); ATT_SBAR();
  pv_rd<4 * H + 3>(s0, vb); ATT_W8(); ATT_SBAR(); pv_mm(o[2 * H], s1, pa2, pa3); ATT_SBAR();
  ATT_W4(); ATT_SBAR(); pv_mm(o[2 * H + 1], s2, pa0, pa1); ATT_SBAR();
  ATT_W0(); ATT_SBAR(); pv_mm(o[2 * H + 1], s0, pa2, pa3); ATT_SBAR();
#undef ATT_W8
#undef ATT_W4
#undef ATT_W0
}

struct AUnit {
  const bf16_t* q; bf16_t* o; const bf16_t *k0, *v0, *k1, *v1;
  int ldq, ldo, ldk0, ldv0, ldk1, ldv1, n0, ntiles; float scale;
  int r0, kr_lo; const float* rpb;
  const float* qsq;
};
constexpr int TBL_FLOATS = 15 * 128;
constexpr int NBUF = 3;
template <int DQ> constexpr int attn_lds_bytes() { return NBUF * VBUF + NBUF * KVBLK * DQ * 2 + NW * 64 * 4 + TBL_FLOATS * 4; }

template <int DQ, bool NAT>
__device__ __forceinline__ void attn_unit(const AUnit& U, char* lds, const int wid_in ATT_PROBE_PARAM) {
  constexpr int KB = KVBLK * DQ * 2, NKC = DQ / 64, CPR = DQ / 8;
  ATT_MARK(0);
  const int tid = wid_in * 64 + lane_id_fresh(), wid = wid_in, lane = tid & 63, r32 = lane & 31, hi = lane >> 5;
  char* V_lds = lds; char* K_lds = lds + NBUF * VBUF;
  float* ws = (float*)(lds + NBUF * VBUF + NBUF * KB) + wid * 64; float* li_l = ws; float* al_l = ws + 32;
  float* tbl = (float*)(lds + NBUF * VBUF + NBUF * KB + NW * 64 * 4);
  const float C = U.scale * 1.4426950408889634f, thr = 8.f / U.scale;
  if constexpr (NAT) {
    const float inv = 1.0f / U.scale;
    for (int idx = tid; idx < TBL_FLOATS; idx += 512) { const int ro = idx >> 7, d = (idx & 127) - 48; tbl[idx] = (d >= 0 && d <= 30) ? U.rpb[ro * 31 + d] * inv : 0.f; }
  }
  float m_reg = -1e30f, l_reg = 0.f; f32x16 o[4] = {}; bf16x8 qr[DQ / 16];
  const bf16_t* Qw = U.q + (long)(wid * QBLK + r32) * U.ldq + hi * 8;
#pragma unroll
  for (int d0 = 0; d0 < DQ / 16; ++d0) qr[d0] = *reinterpret_cast<const bf16x8*>(Qw + d0 * 16);
  float qrs = 1.f;
  if (U.qsq) { typedef float f32x2v __attribute__((ext_vector_type(2))); const float* sp = U.qsq + (long)(wid * QBLK + r32) * 96;
    const f32x2v a = *(const f32x2v*)sp, b = *(const f32x2v*)(sp + 2), c = *(const f32x2v*)(sp + 4); qrs = __builtin_amdgcn_rsqf(((a[0] + a[1]) + (b[0] + b[1]) + (c[0] + c[1])) * (1.0f / 192.0f) + 1e-6f); }
  const int sr = tid >> 4, sc = (tid & 15) * 8, vst0 = v_st(sr, sc), vst1 = v_st(32 + sr, sc);
  const int vb0 = (int)(uintptr_t)V_lds + v_rd_base(lane);
  bf16x8 st[NKC], sv[2];
#define ATT_TILE(j) const int j_ = (j); const bool f_ = j_ < U.n0; const int jj_ = f_ ? j_ : j_ - U.n0; const int ldk_ = f_ ? U.ldk0 : U.ldk1, ldv_ = f_ ? U.ldv0 : U.ldv1; \
    const bf16_t* kp_ = (f_ ? U.k0 : U.k1) + (long)jj_ * KVBLK * ldk_; const bf16_t* vp_ = (f_ ? U.v0 : U.v1) + (long)jj_ * KVBLK * ldv_; (void)kp_; (void)vp_; (void)ldk_; (void)ldv_
#define ATT_KLOAD_TO(dst, j) do { ATT_TILE(j); _Pragma("unroll") for (int i_ = 0; i_ < NKC; ++i_) { const int c_ = tid + 512 * i_, kr_ = c_ & 63, kc_ = c_ >> 6; dst[i_] = *reinterpret_cast<const bf16x8*>(kp_ + (long)kr_ * ldk_ + kc_ * 8); } } while (0)
#define ATT_KLOAD(j) ATT_KLOAD_TO(st, j)
#define ATT_KWRITE_FROM(src, b) do { _Pragma("unroll") for (int i_ = 0; i_ < NKC; ++i_) { const int c_ = tid + 512 * i_; *(bf16x8*)(K_lds + (b) * KB + c_ * 16) = src[i_]; } } while (0)
#define ATT_KWRITE(b) ATT_KWRITE_FROM(st, b)
#define ATT_VLOAD_TO(dst, j) do { ATT_TILE(j); dst[0] = *reinterpret_cast<const bf16x8*>(vp_ + (long)sr * ldv_ + sc); dst[1] = *reinterpret_cast<const bf16x8*>(vp_ + (long)(32 + sr) * ldv_ + sc); } while (0)
#define ATT_VLOAD(j) ATT_VLOAD_TO(sv, j)
#define ATT_VWRITE_FROM(src, b) do { *(bf16x8*)(V_lds + (b) * VBUF + vst0) = src[0]; *(bf16x8*)(V_lds + (b) * VBUF + vst1) = src[1]; } while (0)
#define ATT_VWRITE(b) ATT_VWRITE_FROM(sv, b)
#define ATT_BAR() do { asm volatile("s_waitcnt lgkmcnt(0)" ::: "memory"); __builtin_amdgcn_s_barrier(); asm volatile("" ::: "memory"); } while (0)
  const int NT = U.ntiles;
  const int R = U.r0 + (wid >> 1), rs = min(max(R - 4, 0), 24), qc = (wid & 1) * 32 + r32, cs = min(max(qc - 8, 0), 48);
  { bf16x8 k0_[NKC], k1_[NKC], k2_[NKC], v0_[2], v1_[2], v2_[2];
    ATT_KLOAD_TO(k0_, 0); ATT_VLOAD_TO(v0_, 0); ATT_KLOAD_TO(k1_, 1); ATT_VLOAD_TO(v1_, 1);
    if (2 < NT) { ATT_KLOAD_TO(k2_, 2); ATT_VLOAD_TO(v2_, 2); }
    if (3 < NT) { ATT_KLOAD(3); ATT_VLOAD(3); }
    ATT_KWRITE_FROM(k0_, 0); ATT_VWRITE_FROM(v0_, 0); ATT_KWRITE_FROM(k1_, 1); ATT_VWRITE_FROM(v1_, 1);
    if (2 < NT) { ATT_KWRITE_FROM(k2_, 2); ATT_VWRITE_FROM(v2_, 2); } }
  ATT_BAR();
  if (wid >= 4) { ATT_BAR(); __builtin_amdgcn_s_setprio(1); }
  ATT_MARK(1);
  int b = 0, bn = 1, bp = 2;
  bool act_prev = false; bf16x8 pa0, pa1, pa2, pa3; f32x16 p0, p1;
  for (int j = 0; j <= NT; ++j) {
    bool act = j < NT; int kr = 0;
    if constexpr (NAT) { if (j >= U.n0 && j < NT) { kr = U.kr_lo + (j - U.n0); act = (kr >= rs) && (kr <= rs + 7); } }
    if (j >= 2 && j + 1 < NT) { ATT_KWRITE(bn); if (j + 2 < NT) ATT_KLOAD(j + 2); }
    if (act) {
      qkt<DQ, 2>(p0, p1, K_lds + b * KB, qr, r32, hi);
      if constexpr (NAT) { if (j >= U.n0) {
        const int ro = kr - R + 7; const float* tb = tbl + ro * 128 + 63 - qc + 4 * hi; const int t0 = 4 * hi - cs; const float NEG = -INFINITY;
#pragma unroll
        for (int r = 0; r < 16; ++r) { const int kc = (r & 3) + 8 * (r >> 2);
          p0[r] = ((unsigned)(t0 + kc) < 16u) ? p0[r] + tb[kc] : NEG;
          p1[r] = ((unsigned)(t0 + kc + 32) < 16u) ? p1[r] + tb[kc + 32] : NEG; } } }
    }
    if (act_prev) pv_half<1>(o, vb0 + bp * VBUF, pa0, pa1, pa2, pa3);
    if (j == NT) break;
    ATT_MARK(2); ATT_BAR(); ATT_MARK(3);
    if (j >= 2 && j + 1 < NT) { ATT_VWRITE(bn); if (j + 2 < NT) ATT_VLOAD(j + 2); }
    if (act) {
      float mn, alpha;
      partialSM(p0, p1, m_reg, mn, alpha, C, thr, qrs);
      if (__any(alpha < 1.f)) { if (hi == 0) al_l[r32] = alpha; asm volatile("s_waitcnt lgkmcnt(0)" ::: "memory");
#pragma unroll
        for (int d = 0; d < 4; ++d)
#pragma unroll
          for (int r = 0; r < 16; ++r) o[d][r] *= al_l[crow(r, hi)]; }
      finishSM(p0, p1, alpha, l_reg, pa0, pa1, pa2, pa3); ATT_SBAR();
      pv_half<0>(o, vb0 + b * VBUF, pa0, pa1, pa2, pa3);
    }
    ATT_MARK(4); ATT_BAR(); ATT_MARK(1);
    act_prev = act; bp = b; b = bn; bn = (bn == NBUF - 1) ? 0 : bn + 1;
  }
  ATT_MARK(5);
  ATT_BAR();
  if (wid < 4) ATT_BAR();
  __builtin_amdgcn_s_setprio(0);
  if (hi == 0) li_l[r32] = l_reg; asm volatile("s_waitcnt lgkmcnt(0)" ::: "memory");
  float rli[16];
#pragma unroll
  for (int r = 0; r < 16; ++r) rli[r] = __builtin_amdgcn_rcpf(li_l[crow(r, hi)]);
  bf16_t* Ow = U.o + (long)(wid * QBLK) * U.ldo;
#pragma unroll
  for (int r = 0; r < 16; ++r) { const int orow = crow(r, hi);
#pragma unroll
    for (int d0 = 0; d0 < 4; ++d0) { const float v = o[d0][r] * rli[r]; unsigned u = __float_as_uint(v); u = (u + 0x7fffu + ((u >> 16) & 1u)) >> 16; Ow[(long)orow * U.ldo + d0 * 32 + r32] = (bf16_t)u; } }
  ATT_MARK(6);
#undef ATT_TILE
#undef ATT_KLOAD
#undef ATT_KWRITE
#undef ATT_VLOAD
#undef ATT_VWRITE
#undef ATT_KLOAD_TO
#undef ATT_KWRITE_FROM
#undef ATT_VLOAD_TO
#undef ATT_VWRITE_FROM
#undef ATT_BAR
}
}

constexpr int D = 2048, NTOK = 16384, NCTX = 8192, DEPTH = 4;
constexpr int IN_AB = 6144, DFF = 5632, NDOWN = 832, NDOWN_P = 1024, QL = 512, KVL = 256, ROPE_D = 64;
constexpr int NKVROWS = NTOK + 1024;
constexpr float EPS = 1e-6f;
constexpr int NWAVES = 8;
constexpr size_t O_X = 0, O_NATK = (size_t)NTOK * D, O_NATV = O_NATK + 16777216, O_CKV = O_NATV + 16777216, O_KR = O_CKV + 4194304, O_END = O_KR + 1048576;
constexpr size_t MiB = 1u << 20;
constexpr size_t WS_CTL = 0, CTL_ZERO_BYTES = 1 * MiB;
constexpr size_t WS_MOD = 1 * MiB;
constexpr size_t WS_W = 2 * MiB;
constexpr size_t SZ_FFN_IN = (size_t)2 * DFF * D * 2, SZ_FFN_OUT = (size_t)D * DFF * 2, SZ_IN_AB = (size_t)IN_AB * D * 2, SZ_DD = (size_t)D * D * 2;
constexpr size_t SZ_DOWN = (size_t)NDOWN_P * D * 2, SZ_UQ = (size_t)3072 * QL * 2, SZ_UKV = (size_t)4096 * KVL * 2;
constexpr size_t W_FFN_IN = WS_W, W_FFN_OUT = W_FFN_IN + 4 * SZ_FFN_IN, W_IN_AB = W_FFN_OUT + 4 * SZ_FFN_OUT, W_OUT_AB = W_IN_AB + 2 * SZ_IN_AB;
constexpr size_t W_DOWN = W_OUT_AB + 2 * SZ_DD, W_UQ = W_DOWN + 2 * SZ_DOWN, W_UKV = W_UQ + 2 * SZ_UQ, W_O = W_UKV + 2 * SZ_UKV, W_END = W_O + 2 * SZ_DD;
constexpr size_t WS_H = 384 * MiB;
constexpr size_t WS_C = WS_H + 64 * MiB;
constexpr size_t WS_SM = WS_C + 64 * MiB;
constexpr size_t SZ_CKVN = 9 * MiB, SZ_KR = 5 * MiB, SZ_KRSQ = 128 * 1024;
constexpr size_t SM_CQN = WS_SM, SM_CKVN = SM_CQN + (size_t)NTOK * QL * 2, SM_KR = SM_CKVN + 2 * SZ_CKVN, SM_CK = SM_KR + 2 * SZ_KR, SM_CV = SM_CK + 4 * MiB, SM_KRSQ = SM_CV + 4 * MiB, SM_CQP = SM_KRSQ + 1 * MiB, SM_QSQ = SM_CQP + 1 * MiB, SM_END = SM_QSQ + 7 * MiB;
static_assert((size_t)NKVROWS * KVL * 2 <= SZ_CKVN && (size_t)NKVROWS * 64 * 4 <= SZ_KR && (size_t)NKVROWS * 4 <= SZ_KRSQ && (size_t)NTOK * 8 * 4 <= 1 * MiB, "latent buffers");
constexpr size_t WS_BIG = WS_SM + 64 * MiB;
constexpr size_t B_P = WS_BIG;
constexpr size_t B_L = WS_BIG, B_QC = B_L + 64 * MiB, B_KV = B_QC + 96 * MiB, B_KN = B_KV + 136 * MiB;
constexpr size_t WS_CS = WS_MOD + 983040;
constexpr size_t B_F = WS_BIG;
constexpr size_t WS_X16 = WS_BIG + 512 * MiB;
constexpr size_t WS_END = WS_X16 + 64 * MiB;
static_assert(W_END <= WS_H && SM_END <= WS_BIG && B_KN + (size_t)NKVROWS * 3072 * 2 <= WS_X16 && B_F + (size_t)NTOK * DFF * 2 <= WS_END, "d_ws map");
constexpr int CW_BAR = 4096;
constexpr int RING_BYTES = 131072, LDSCTL_OFF = RING_BYTES, LDS_BYTES = 147456;

typedef unsigned short bf16;
typedef float f32x2 __attribute__((ext_vector_type(2)));
typedef unsigned u32x2 __attribute__((ext_vector_type(2)));
typedef _Float16 h16x4 __attribute__((ext_vector_type(4)));

__device__ __forceinline__ float wave_sum(float v) {
    v += __int_as_float(__builtin_amdgcn_ds_swizzle(__float_as_int(v), 0x041F));
    v += __int_as_float(__builtin_amdgcn_ds_swizzle(__float_as_int(v), 0x081F));
    v += __int_as_float(__builtin_amdgcn_ds_swizzle(__float_as_int(v), 0x101F));
    v += __int_as_float(__builtin_amdgcn_ds_swizzle(__float_as_int(v), 0x201F));
    v += __int_as_float(__builtin_amdgcn_ds_swizzle(__float_as_int(v), 0x401F));
    const auto b = __builtin_amdgcn_permlane32_swap(__float_as_uint(v), __float_as_uint(v), false, false);
    return __uint_as_float(b[0]) + __uint_as_float(b[1]);
}
__device__ __forceinline__ float bf2f(unsigned short b) { return __uint_as_float(((unsigned)b) << 16); }
__device__ __forceinline__ float bflo(unsigned w) { return __uint_as_float(w << 16); }
__device__ __forceinline__ float bfhi(unsigned w) { return __uint_as_float(w & 0xffff0000u); }

struct Frame {
    LAS unsigned char* lds; char* ldsg;
    int tid, lane, wave, G, vcu, gw, NGW;
    GAS float* out; GAS unsigned char* ws; int l;
};
__device__ __forceinline__ const float* kin(int k) { asm volatile("" : "+s"(k)); return (const float*)((GAS const float* const __attribute__((address_space(4)))*)__builtin_amdgcn_kernarg_segment_ptr())[k]; }

__device__ __forceinline__ bool fresh(Frame& F) {
    F.lane = lane_id_fresh(); F.tid = F.wave * 64 + F.lane;
    { GAS unsigned char* w = F.ws; GAS float* o = F.out; int l = F.l; asm volatile("" : "+s"(w), "+s"(o), "+s"(l)); F.ws = w; F.out = o; F.l = l; }
    return true;
}
__device__ __forceinline__ void p0_transpose_item(const float* W, int K, int N, bf16* WT, int k0, int n0, int drow0, LAS float* scr, int lane, const float* ksc) {
    { const int r = lane >> 3, n4 = (lane & 7) * 4; f32x4 w[8];
#pragma unroll
      for (int i = 0; i < 8; ++i) w[i] = *(const f32x4*)(W + (size_t)(k0 + r + 8 * i) * N + n0 + n4);
#pragma unroll
      for (int i = 0; i < 8; ++i) { LAS float* d = scr + (r + 8 * i) * 33 + n4; d[0] = w[i][0]; d[1] = w[i][1]; d[2] = w[i][2]; d[3] = w[i][3]; } }
    LDS_WAIT(); asm volatile("" ::: "memory");
    const int c = lane & 7;
    f32x4 sa = {1.f, 1.f, 1.f, 1.f}, sb = {1.f, 1.f, 1.f, 1.f};
    if (ksc) { sa = *(const f32x4*)(ksc + k0 + 8 * c); sb = *(const f32x4*)(ksc + k0 + 8 * c + 4); }
#pragma unroll
    for (int j = 0; j < 4; ++j) { const int n = (lane >> 3) + 8 * j; const LAS float* s = scr + (8 * c) * 33 + n;
        v4u o; o.x = pk2(s[0 * 33] * sa[0], s[1 * 33] * sa[1]); o.y = pk2(s[2 * 33] * sa[2], s[3 * 33] * sa[3]); o.z = pk2(s[4 * 33] * sb[0], s[5 * 33] * sb[1]); o.w = pk2(s[6 * 33] * sb[2], s[7 * 33] * sb[3]);
        *(GAS v4u*)(WT + (size_t)(drow0 + n) * K + k0 + 8 * c) = o; }
    LDS_WAIT(); asm volatile("" ::: "memory");
}
__device__ __forceinline__ void p0_do_matrix(const float* W, int K, int N, bf16* WT, int item, int ffn_map, LAS float* scr, int lane, const float* ksc = nullptr) {
    const int nblk = N / 32, kb = item / nblk, nb = item % nblk, k0 = 64 * kb, n0 = 32 * nb;
    int drow0 = n0;
    if (ffn_map == 1) { const int up = n0 >= DFF ? 1 : 0, j = n0 - up * DFF; drow0 = (j >> 7) * 256 + up * 128 + (j & 127); }
    if (ffn_map == 2) { drow0 = (n0 / 192) * 256 + (n0 % 192); }
    p0_transpose_item(W, K, N, WT, k0, n0, drow0, scr, lane, ksc);
}
__device__ __forceinline__ void phase_prologue(Frame& F) {
    {
        LAS float* sil = (LAS float*)F.lds;
        LAS float* red = sil + 5 * 2048;
        const float* c = kin(6); const float* cctx = kin(7);
        for (int i = F.tid; i < 5 * 2048; i += 512) { const int cc = i >> 11, k = i & 2047; const float x = cc == 0 ? cctx[k] : c[(cc - 1) * 2048 + k]; sil[i] = x / (1.0f + __expf(-x)); }
        __syncthreads();
        const float* w_ada = kin(10); const float* b_ada = kin(11); float* mod = (float*)(F.ws + WS_MOD);
        for (int task = F.vcu; task < 4 * 192; task += F.G) {
            const int l = task / 192, n = (task % 192) * 64 + F.lane;
            const float* wp = w_ada + ((size_t)l * 2048 + F.wave * 256) * 12288 + n;
            float a0 = 0.f, a1 = 0.f, a2 = 0.f, a3 = 0.f, a4 = 0.f;
            for (int k = 0; k < 256; k += 16) {
                float w[16];
#pragma unroll
                for (int u = 0; u < 16; ++u) w[u] = wp[(size_t)(k + u) * 12288];
#pragma unroll
                for (int u = 0; u < 16; ++u) { const int kk = F.wave * 256 + k + u; a0 += sil[kk] * w[u]; a1 += sil[2048 + kk] * w[u]; a2 += sil[4096 + kk] * w[u]; a3 += sil[6144 + kk] * w[u]; a4 += sil[8192 + kk] * w[u]; }
            }
            red[(F.wave * 5 + 0) * 64 + F.lane] = a0; red[(F.wave * 5 + 1) * 64 + F.lane] = a1; red[(F.wave * 5 + 2) * 64 + F.lane] = a2; red[(F.wave * 5 + 3) * 64 + F.lane] = a3; red[(F.wave * 5 + 4) * 64 + F.lane] = a4;
            __syncthreads();
            if (F.tid < 320) { const int cc = F.tid >> 6, ln = F.tid & 63; float s = 0.f;
#pragma unroll
                for (int w8 = 0; w8 < 8; ++w8) s += red[(w8 * 5 + cc) * 64 + ln];
                const int nn = (task % 192) * 64 + ln; mod[((size_t)l * 5 + cc) * 12288 + nn] = s + b_ada[(size_t)l * 12288 + nn]; }
            __syncthreads();
        }
    }
    {
        LAS float* scr = (LAS float*)(F.lds + F.wave * 16384);
        constexpr int I_FI = 32 * 352, I_FO = 88 * 64, I_IA = 32 * 192, I_DD = 32 * 64, I_DN = 32 * 26, I_UQ = 8 * 96, I_UK = 4 * 128;
        constexpr int NITEMS = 4 * I_FI + 4 * I_FO + 2 * I_IA + 2 * I_DD + 2 * I_DN + 2 * I_UQ + 2 * I_UK + 2 * I_DD;
        unsigned char* ws = (unsigned char*)F.ws;
        for (int it = F.gw; it < NITEMS; it += F.NGW) {
            int r = it;
            if (r < 4 * I_FI) { const int l = r / I_FI; p0_do_matrix(kin(26) + (size_t)l * D * 2 * DFF, D, 2 * DFF, (bf16*)(ws + W_FFN_IN + l * SZ_FFN_IN), r % I_FI, 1, scr, F.lane); continue; } r -= 4 * I_FI;
            if (r < 4 * I_FO) { const int l = r / I_FO; p0_do_matrix(kin(27) + (size_t)l * DFF * D, DFF, D, (bf16*)(ws + W_FFN_OUT + l * SZ_FFN_OUT), r % I_FO, 0, scr, F.lane); continue; } r -= 4 * I_FO;
            if (r < 2 * I_IA) { const int l = r / I_IA; p0_do_matrix(kin(12) + (size_t)l * D * IN_AB, D, IN_AB, (bf16*)(ws + W_IN_AB + l * SZ_IN_AB), r % I_IA, 0, scr, F.lane); continue; } r -= 2 * I_IA;
            if (r < 2 * I_DD) { const int l = r / I_DD; p0_do_matrix(kin(17) + (size_t)l * D * D, D, D, (bf16*)(ws + W_OUT_AB + l * SZ_DD), r % I_DD, 0, scr, F.lane); continue; } r -= 2 * I_DD;
            if (r < 2 * I_DN) { const int l = r / I_DN; p0_do_matrix(kin(18) + (size_t)l * D * NDOWN, D, NDOWN, (bf16*)(ws + W_DOWN + l * SZ_DOWN), r % I_DN, 0, scr, F.lane); continue; } r -= 2 * I_DN;
            if (r < 2 * I_UQ) { const int l = r / I_UQ; p0_do_matrix(kin(21) + (size_t)l * QL * 3072, QL, 3072, (bf16*)(ws + W_UQ + l * SZ_UQ), r % I_UQ, 0, scr, F.lane, kin(19) + l * QL); continue; } r -= 2 * I_UQ;
            if (r < 2 * I_UK) { const int l = r / I_UK; p0_do_matrix(kin(22) + (size_t)l * KVL * 4096, KVL, 4096, (bf16*)(ws + W_UKV + l * SZ_UKV), r % I_UK, 0, scr, F.lane); continue; } r -= 2 * I_UK;
            { const int l = r / I_DD; p0_do_matrix(kin(25) + (size_t)l * D * D, D, D, (bf16*)(ws + W_O + l * SZ_DD), r % I_DD, 0, scr, F.lane); }
        }
        const int gt = F.vcu * 512 + F.tid, NT = F.G * 512;
        for (int i = gt; i < 2 * (NDOWN_P - NDOWN) * D / 8; i += NT) { const int l = i / ((NDOWN_P - NDOWN) * D / 8), e = i % ((NDOWN_P - NDOWN) * D / 8);
            *(v4u*)(ws + W_DOWN + l * SZ_DOWN + (size_t)NDOWN * D * 2 + (size_t)e * 16) = (v4u){0u, 0u, 0u, 0u}; }
        if (gt < 1024) { const int pos = gt >> 4, j = gt & 15; const float ang = (float)pos * exp2f(-(float)j * (13.287712379549449f / 16.0f));
            ((float*)(ws + WS_CS))[gt] = __cosf(ang); ((float*)(ws + WS_CS))[1024 + gt] = __sinf(ang); }
        for (int rr = F.gw; rr < 2 * 1024; rr += F.NGW) { const int i = rr >> 10, cr = rr & 1023, b = cr >> 8, t = cr & 255; const size_t row = (size_t)NTOK + cr;
            const f32x4 y = *(const f32x4*)(kin(4) + (((size_t)b * 2 + i) * 256 + t) * 256 + F.lane * 4);
            u32x2 w; w.x = pk2(y[0], y[1]); w.y = pk2(y[2], y[3]); *(u32x2*)((bf16*)(ws + SM_CKVN + i * SZ_CKVN) + row * KVL + F.lane * 4) = w;
            const float krv = kin(5)[(((size_t)b * 2 + i) * 256 + t) * 64 + F.lane];
            ((float*)(ws + SM_KR + i * SZ_KR))[row * 64 + F.lane] = krv * (kin(24) + i * 192)[128 + F.lane];
            const float q2 = wave_sum(krv * krv); if (F.lane == 0) ((float*)(ws + SM_KRSQ + i * SZ_KRSQ))[row] = q2; }
        const float* ck = kin(2); const float* cv = kin(3);
        for (int i = gt; i < 2 * 262144; i += NT) { const bool isk = i < 262144; const int e = isk ? i : i - 262144; const float* s = (isk ? ck : cv) + (size_t)e * 8;
            const f32x4 a = *(const f32x4*)s, b = *(const f32x4*)(s + 4); v4u o; o.x = pk2(a[0], a[1]); o.y = pk2(a[2], a[3]); o.z = pk2(b[0], b[1]); o.w = pk2(b[2], b[3]);
            *(v4u*)(ws + (isk ? SM_CK : SM_CV) + (size_t)e * 16) = o; }
    }
}

__device__ __forceinline__ void phase_mod(Frame& F, const float* xc32, const float* xs32, _Float16* X16, const bf16* Y, const float* g, const float* mod_l, int chunk, bf16* Hb) {
    for (int rbx = F.gw; rbx < NTOK / 8; rbx += F.NGW) {
        const int pnl = rbx >> 5, rb = ((((pnl & 1) << 5) | (pnl >> 1)) << 5) | (rbx & 31);
        const int row0 = rb * 8, cond = row0 < NCTX ? 0 : 1 + ((row0 - NCTX) >> 11);
        const float* sh = mod_l + (size_t)cond * 12288 + chunk * 2048; const float* scl = sh + 2048;
        f32x4 a[8], b[8];
#pragma unroll
        for (int j = 0; j < 8; ++j) { const int c = 4 * (64 * j + F.lane); const f32x4 gv = *(const f32x4*)(g + c), sv = *(const f32x4*)(scl + c); a[j] = gv * (sv + 1.0f); b[j] = *(const f32x4*)(sh + c); }
        for (int rr = 0; rr < 8; rr += 2) {
            f32x4 v[2][8]; u32x2 yw[2][8];
#pragma unroll
            for (int q = 0; q < 2; ++q) {
                const int row = row0 + rr + q; const _Float16* xh = X16 + (size_t)row * D;
                if (xc32) { const float* xr = (row < NCTX ? xc32 : xs32) + (size_t)row * D;
#pragma unroll
                    for (int j = 0; j < 8; ++j) v[q][j] = *(const f32x4*)(xr + 4 * (64 * j + F.lane)); }
                else {
#pragma unroll
                    for (int j = 0; j < 8; ++j) v[q][j] = __builtin_convertvector(*(const h16x4*)(xh + 4 * (64 * j + F.lane)), f32x4); }
                if (Y) { const bf16* yr = Y + (size_t)row * D;
#pragma unroll
                    for (int j = 0; j < 8; ++j) yw[q][j] = *(const u32x2*)(yr + 4 * (64 * j + F.lane)); }
            }
#pragma unroll
            for (int q = 0; q < 2; ++q) {
                const int row = row0 + rr + q; _Float16* xh = X16 + (size_t)row * D; float ss = 0.f;
                if (Y) {
#pragma unroll
                    for (int j = 0; j < 8; ++j) { const u32x2 w = yw[q][j]; v[q][j] += (f32x4){bflo(w.x), bfhi(w.x), bflo(w.y), bfhi(w.y)};
                        const h16x4 hv = __builtin_convertvector(v[q][j], h16x4); *(h16x4*)(xh + 4 * (64 * j + F.lane)) = hv; v[q][j] = __builtin_convertvector(hv, f32x4); }
                }
#pragma unroll
                for (int j = 0; j < 8; ++j) ss += (v[q][j][0] * v[q][j][0] + v[q][j][1] * v[q][j][1]) + (v[q][j][2] * v[q][j][2] + v[q][j][3] * v[q][j][3]);
                const float rstd = 1.0f / sqrtf(wave_sum(ss) * (1.0f / D) + EPS);
                bf16* orow = Hb + (size_t)row * D;
#pragma unroll
                for (int j = 0; j < 8; ++j) { const f32x4 y = v[q][j] * rstd * a[j] + b[j]; u32x2 w; w.x = pk2(y[0], y[1]); w.y = pk2(y[2], y[3]); *(u32x2*)(orow + 4 * (64 * j + F.lane)) = w; }
            }
        }
    }
}

__device__ __forceinline__ void phase_even_conv(Frame& F, int i, const bf16* P, bf16* Cb) {
    const float* cw = kin(16) + (size_t)i * 3 * 1024;
    const int gt = F.vcu * 512 + F.tid, NT = F.G * 512;
    for (int idx = gt; idx < (NTOK / 8) * 128; idx += NT) {
        const int row0 = (idx >> 7) * 8, c = (idx & 127) * 8;
        int t0, L; if (row0 < NCTX) { t0 = row0 & 255; L = 256; } else { t0 = (row0 - NCTX) & 2047; L = 2048; }
        const bf16* pr = P + (size_t)row0 * IN_AB;
        v4u gcv[10], uv[10], gbv[8];
#pragma unroll
        for (int r = 0; r < 10; ++r) { const int tt = t0 + r - 1; const bool ok = tt >= 0 && tt < L; const bf16* p2 = pr + (ptrdiff_t)(r - 1) * IN_AB;
            gcv[r] = ok ? *(const v4u*)(p2 + 4096 + c) : (v4u){0u, 0u, 0u, 0u}; uv[r] = ok ? *(const v4u*)(p2 + 5120 + c) : (v4u){0u, 0u, 0u, 0u}; }
#pragma unroll
        for (int r = 0; r < 8; ++r) gbv[r] = *(const v4u*)(pr + (size_t)r * IN_AB + 3072 + c);
        f32x4 w[3][2];
#pragma unroll
        for (int j = 0; j < 3; ++j) { w[j][0] = *(const f32x4*)(cw + j * 1024 + c); w[j][1] = *(const f32x4*)(cw + j * 1024 + c + 4); }
        f32x4 pa[3][2];
#define CONV_PROD(dst, r) do { const v4u g_ = gcv[r], u_ = uv[r]; dst[0] = (f32x4){bflo(g_.x) * bflo(u_.x), bfhi(g_.x) * bfhi(u_.x), bflo(g_.y) * bflo(u_.y), bfhi(g_.y) * bfhi(u_.y)}; \
            dst[1] = (f32x4){bflo(g_.z) * bflo(u_.z), bfhi(g_.z) * bfhi(u_.z), bflo(g_.w) * bflo(u_.w), bfhi(g_.w) * bfhi(u_.w)}; } while (0)
        CONV_PROD(pa[0], 0); CONV_PROD(pa[1], 1);
#pragma unroll
        for (int r = 0; r < 8; ++r) {
            CONV_PROD(pa[(r + 2) % 3], r + 2);
            const f32x4 a0 = w[0][0] * pa[r % 3][0] + w[1][0] * pa[(r + 1) % 3][0] + w[2][0] * pa[(r + 2) % 3][0];
            const f32x4 a1 = w[0][1] * pa[r % 3][1] + w[1][1] * pa[(r + 1) % 3][1] + w[2][1] * pa[(r + 2) % 3][1];
            const v4u gb = gbv[r];
            v4u o; o.x = pk2(bflo(gb.x) * a0[0], bfhi(gb.x) * a0[1]); o.y = pk2(bflo(gb.y) * a0[2], bfhi(gb.y) * a0[3]); o.z = pk2(bflo(gb.z) * a1[0], bfhi(gb.z) * a1[1]); o.w = pk2(bflo(gb.w) * a1[2], bfhi(gb.w) * a1[3]);
            *(v4u*)(Cb + (size_t)(row0 + r) * D + 1024 + c) = o;
        }
#undef CONV_PROD
    }
}

#ifdef PROBE_SUB
#define PT_ARG , PT
#define PT_PARAM , att::ProbeT& PT
#else
#define PT_ARG
#define PT_PARAM
#endif
__device__ __forceinline__ void phase_even_attn(Frame& F, int i, const bf16* P, bf16* Cb PT_PARAM) {
    const bf16* CK = (const bf16*)(F.ws + SM_CK); const bf16* CV = (const bf16*)(F.ws + SM_CV);
    for (int u = F.vcu; u < 512; u += F.G) {
        att::AUnit U;
        U.scale = 0.08838834764831845f; U.ldq = IN_AB; U.ldo = D; U.r0 = 0; U.kr_lo = 0; U.rpb = nullptr; U.qsq = nullptr;
        if (u < 256) {
            const int b = u >> 3, h = u & 7; const size_t r0 = (size_t)b * 256;
            U.q = P + r0 * IN_AB + h * 128; U.o = Cb + r0 * D + h * 128;
            U.k0 = P + r0 * IN_AB + 1024 + h * 128; U.v0 = P + r0 * IN_AB + 2048 + h * 128; U.ldk0 = IN_AB; U.ldv0 = IN_AB; U.n0 = 4; U.ntiles = 4;
            U.k1 = U.k0; U.v1 = U.v0; U.ldk1 = IN_AB; U.ldv1 = IN_AB;
            att::attn_unit<128, false>(U, F.ldsg, F.wave PT_ARG);
        } else {
            const int n = u - 256, b = n >> 6, h = (n >> 3) & 7, rb = n & 7, r0 = 4 * rb;
            const size_t row0 = (size_t)NCTX + (size_t)b * 2048 + (size_t)r0 * 64;
            U.q = P + row0 * IN_AB + h * 128; U.o = Cb + row0 * D + h * 128;
            const size_t coff = ((((size_t)b * 2 + i) * 8 + h) * 256) * 128;
            U.k0 = CK + coff; U.v0 = CV + coff; U.ldk0 = 128; U.ldv0 = 128; U.n0 = 4;
            const int kr_lo = min(max(r0 - 4, 0), 24), kr_hi = min(max(r0 - 1, 0), 24) + 7;
            const size_t krow0 = (size_t)NCTX + (size_t)b * 2048 + (size_t)kr_lo * 64;
            U.k1 = P + krow0 * IN_AB + 1024 + h * 128; U.v1 = P + krow0 * IN_AB + 2048 + h * 128; U.ldk1 = IN_AB; U.ldv1 = IN_AB;
            U.ntiles = 4 + (kr_hi - kr_lo + 1); U.r0 = r0; U.kr_lo = kr_lo; U.rpb = kin(15) + ((size_t)i * 8 + h) * 15 * 31;
            att::attn_unit<128, true>(U, F.ldsg, F.wave PT_ARG);
        }
    }
}
#ifndef PROBE_NT
#define PROBE_NT 36
#endif
__device__ __forceinline__ void phase_odd_attn(Frame& F, const bf16* Qn, const bf16* Kn, const bf16* Vn, bf16* Ob, int probe PT_PARAM) {
    for (int u = F.vcu; u < 1024; u += F.G) {
        att::AUnit U;
        U.scale = 0.07216878364870323f; U.ldq = 3072; U.ldo = D; U.r0 = 0; U.kr_lo = 0; U.rpb = nullptr;
        U.ldk0 = 3072; U.ldv0 = 2048; U.ldk1 = 3072; U.ldv1 = 2048;
        if (u < 512) {
            const int b = u >> 4, h = u & 15; const size_t r0 = (size_t)b * 256;
            U.q = Qn + r0 * 3072 + h * 192; U.o = Ob + r0 * D + h * 128; U.qsq = (const float*)(F.ws + SM_QSQ) + r0 * 96 + 6 * h;
            U.k0 = Kn + r0 * 3072 + h * 192; U.v0 = Vn + r0 * 2048 + h * 128; U.n0 = 4; U.ntiles = 4; U.k1 = U.k0; U.v1 = U.v0;
        } else {
            const int n = u - 512, b = n >> 7, h = (n >> 3) & 15, qb = n & 7;
            const size_t row0 = (size_t)NCTX + (size_t)b * 2048 + (size_t)qb * 256, kc0 = (size_t)NTOK + (size_t)b * 256, kl0 = (size_t)NCTX + (size_t)b * 2048;
            U.q = Qn + row0 * 3072 + h * 192; U.o = Ob + row0 * D + h * 128; U.qsq = (const float*)(F.ws + SM_QSQ) + row0 * 96 + 6 * h;
            U.k0 = Kn + kc0 * 3072 + h * 192; U.v0 = Vn + kc0 * 2048 + h * 128; U.n0 = 4;
            U.k1 = Kn + kl0 * 3072 + h * 192; U.v1 = Vn + kl0 * 2048 + h * 128; U.ntiles = probe ? PROBE_NT : 36;
        }
        att::attn_unit<192, false>(U, F.ldsg, F.wave PT_ARG);
    }
}

struct Args { const float* in[28]; float* out; unsigned char* ws; int ph_lo, ph_hi; };
constexpr int PH_END = 1 + DEPTH * 10;
__host__ __device__ constexpr int pid(int l, int s) { return 1 + l * 10 + s; }

__global__ void __launch_bounds__(NWAVES * 64, 2) fwd_kernel(Args args) {
    extern __shared__ __attribute__((aligned(16))) unsigned char lds[];
    Frame F;
    F.lds = (LAS unsigned char*)lds; F.ldsg = (char*)lds;
    F.tid = threadIdx.x; F.lane = F.tid & 63; F.wave = __builtin_amdgcn_readfirstlane(F.tid >> 6);
    F.G = gridDim.x; { const int bx = blockIdx.x; F.vcu = (F.G % 8 == 0) ? (bx % 8) * (F.G / 8) + bx / 8 : bx; }
    F.gw = F.vcu * NWAVES + F.wave; F.NGW = F.G * NWAVES;
    F.out = (GAS float*)args.out; F.ws = (GAS unsigned char*)args.ws; F.l = 0;
    unsigned char* ws = args.ws;
    for (int u = F.tid; u < (LDS_BYTES - LDSCTL_OFF) / 4; u += NWAVES * 64) ((LAS unsigned*)(F.lds + LDSCTL_OFF))[u] = 0u;
    __syncthreads();
    const int lo = args.ph_lo, hi = args.ph_hi;
    XcdBarrier bar; bar.bar = (unsigned*)(ws + WS_CTL) + CW_BAR; bar.x = 0; bar.st = nullptr;
    if (hi - lo > 1) bar = xcd_barrier_post((unsigned*)(ws + WS_CTL) + CW_BAR, (volatile LAS unsigned*)(F.lds + LDSCTL_OFF) + 8);
#ifndef PH_MASK
#define PH_MASK 0xFFFF
#endif
#define EN(k) ((PH_MASK >> (k)) & 1)
#ifndef REP_MASK
#define REP_MASK 0
#endif
#define REPS(k) for (int rep_ = 0; rep_ < 1 + ((REP_MASK >> (k)) & 1); ++rep_)
#define RUN(p) (lo <= (p) && (p) < hi && fresh(F))
#ifdef PROBE_SUB
    att::ProbeT PT; PT.acc = 0; PT.last = 0; PT.state = -1;
#ifdef PROBE_SUB_EVEN
#define PT_ARG_E , PT
#else
#define PT_ARG_E , PTdummy
    att::ProbeT PTdummy; PTdummy.acc = 0; PTdummy.last = 0; PTdummy.state = -1;
#endif
#else
#define PT_ARG_E
#endif
#ifdef PROBE_SLOT
#ifndef PROBE_MULT
#define PROBE_MULT 4
#endif
    unsigned long long t_last_ = rt(), t_acc_ = 0;
#define STAMP(p) do { const unsigned long long now_ = rt(); const int s_ = (p) == 0 ? 99 : (((p) - 1) % 10) + 10 * ((((p) - 1) / 10) & 1); if (s_ == PROBE_SLOT || (PROBE_SLOT >= 100 && (s_ % 10) == (PROBE_SLOT - 100) && s_ != 99)) t_acc_ += now_ - t_last_; t_last_ = now_; } while (0)
#else
#define STAMP(p) do { } while (0)
#endif
#define SEAM(p) do { if ((p) + 1 < hi) xcd_barrier(bar); STAMP(p); } while (0)

#define WSP (F.ws)
#define XP ((float*)(F.out + O_X))
#define MODL ((const float*)(WSP + WS_MOD) + (size_t)F.l * 5 * 12288)
#define HB ((bf16*)(WSP + WS_H))
#define CB ((bf16*)(WSP + WS_C))
#define FB ((bf16*)(WSP + B_F))
#define X16P ((_Float16*)(WSP + WS_X16))
#define YB ((bf16*)(WSP + WS_BIG + 256 * MiB))
#define REDP ((PG8_LAS float*)(F.lds + LDSCTL_OFF + 1024))

    REPS(0) if (EN(0) && RUN(0)) { phase_prologue(F); SEAM(0); }

    for (int l = 0; l < DEPTH; ++l) {
        F.l = l;
        if (EN(1) && RUN(pid(l, 0))) {
            const float* xc = F.l == 0 ? kin(0) : (const float*)nullptr; const float* xs = F.l == 0 ? kin(1) - (size_t)NCTX * D : (const float*)nullptr;
            phase_mod(F, xc, xs, X16P, F.l == 0 ? (const bf16*)nullptr : YB, kin(8) + (size_t)F.l * D, MODL, 0, HB); SEAM(pid(l, 0)); }
        if ((l & 1) == 0) {
            REPS(2) if (EN(2) && RUN(pid(l, 1))) {
                const int i = F.l >> 1; bf16* P = (bf16*)(WSP + B_P);
                pg8::Gemm g{HB, (const bf16*)(WSP + W_IN_AB + i * SZ_IN_AB), NTOK, IN_AB, D}; pg8::StaticOrder S; S.init(NTOK, IN_AB, F.G, (int)blockIdx.x);
                pg8::EpiInAB E{P, kin(13) + i * 128, kin(14) + i * 128, (float*)(F.out + O_NATK + (size_t)i * 8 * 32768), (float*)(F.out + O_NATV + (size_t)i * 8 * 32768), REDP};
                pg8::gemm_phase<pg8::EpiInAB, pg8::StaticOrder, true, true>(F.lds, g, S, E, F.wave);
                SEAM(pid(l, 1));
            }
            REPS(4) if (EN(4) && RUN(pid(l, 5))) { const int i = F.l >> 1; bf16* P = (bf16*)(WSP + B_P); phase_even_attn(F, i, P, CB PT_ARG_E); fresh(F); phase_even_conv(F, i, P, CB); SEAM(pid(l, 5)); }
        } else {
            REPS(5) if (EN(5) && RUN(pid(l, 1))) {
                const int i = F.l >> 1;
                pg8::Gemm g{HB, (const bf16*)(WSP + W_DOWN + i * SZ_DOWN), NTOK, NDOWN_P, D}; pg8::StaticOrder S; S.init(NTOK, NDOWN_P, F.G, (int)blockIdx.x);
                pg8::EpiDown E{(bf16*)(WSP + SM_CQN), (float*)(WSP + SM_CQP), (bf16*)(WSP + SM_CKVN + i * SZ_CKVN), kin(20) + i * KVL, (float*)(F.out + O_CKV + (size_t)i * 65536), (float*)(F.out + O_KR + (size_t)i * 16384),
                               kin(24) + i * 192 + 128, (float*)(WSP + SM_KR + i * SZ_KR), (float*)(WSP + SM_KRSQ + i * SZ_KRSQ), REDP};
                pg8::gemm_phase<pg8::EpiDown, pg8::StaticOrder, true, true>(F.lds, g, S, E, F.wave);
                SEAM(pid(l, 1));
            }
            REPS(7) if (EN(7) && RUN(pid(l, 3))) {
                { const int i = F.l >> 1;
                  pg8::Gemm g{(const bf16*)(WSP + SM_CQN), (const bf16*)(WSP + W_UQ + i * SZ_UQ), NTOK, 3072, QL}; pg8::StaticOrder S; S.init(NTOK, 3072, F.G, (int)blockIdx.x);
                  pg8::EpiUQ E{(bf16*)(WSP + B_QC), kin(23) + i * 192, (const float*)(WSP + SM_CQP), (float*)(WSP + SM_QSQ)};
#ifndef NO_UQ
                  pg8::gemm_phase<pg8::EpiUQ, pg8::StaticOrder, true, true>(F.lds, g, S, E, F.wave);
#endif
                }
                fresh(F);
                { const int i = F.l >> 1;
                  pg8::Gemm g{(const bf16*)(WSP + SM_CKVN + i * SZ_CKVN), (const bf16*)(WSP + W_UKV + i * SZ_UKV), NKVROWS, 4096, KVL}; pg8::StaticOrder S; S.init(NKVROWS, 4096, F.G, (int)blockIdx.x);
                  pg8::EpiUKV E{(bf16*)(WSP + B_KN), (bf16*)(WSP + B_KV), kin(24) + i * 192, (const float*)(WSP + SM_KR + i * SZ_KR), (const float*)(WSP + SM_KRSQ + i * SZ_KRSQ), REDP};
#ifndef NO_UKV
                  pg8::gemm_phase<pg8::EpiUKV, pg8::StaticOrder, true, true>(F.lds, g, S, E, F.wave);
#endif
                }
                SEAM(pid(l, 3));
            }
            REPS(9) if (EN(9) && RUN(pid(l, 5))) { phase_odd_attn(F, (const bf16*)(WSP + B_QC), (const bf16*)(WSP + B_KN), (const bf16*)(WSP + B_KV), rep_ == 0 ? CB : (bf16*)(WSP + WS_BIG + 420 * MiB), rep_ PT_ARG); SEAM(pid(l, 5)); }
        }
        REPS(10) if (EN(10) && RUN(pid(l, 6))) {
            const int i = F.l >> 1;
            const bf16* Wt = (F.l & 1) ? (const bf16*)(WSP + W_O + i * SZ_DD) : (const bf16*)(WSP + W_OUT_AB + i * SZ_DD);
            pg8::Gemm g{CB, Wt, NTOK, D, D}; pg8::StaticOrder S; S.init(NTOK, D, F.G, (int)blockIdx.x);
            pg8::EpiY E{rep_ == 0 ? YB : (bf16*)(WSP + WS_BIG + 320 * MiB), MODL + 2 * 2048};
            pg8::gemm_phase<pg8::EpiY, pg8::StaticOrder, true, true>(F.lds, g, S, E, F.wave);
            SEAM(pid(l, 6));
        }
        REPS(11) if (EN(11) && RUN(pid(l, 7))) {
            const float* xc = F.l == 0 ? kin(0) : (const float*)nullptr; const float* xs = F.l == 0 ? kin(1) - (size_t)NCTX * D : (const float*)nullptr;
            phase_mod(F, xc, xs, X16P, YB, kin(9) + (size_t)F.l * D, MODL, 3, HB); SEAM(pid(l, 7)); }
        REPS(12) if (EN(12) && RUN(pid(l, 8))) {
            pg8::Gemm g{HB, (const bf16*)(WSP + W_FFN_IN + F.l * SZ_FFN_IN), NTOK, 2 * DFF, D}; pg8::StaticOrder S; S.init(NTOK, 2 * DFF, F.G, (int)blockIdx.x);
            pg8::EpiSwiGLU E{FB, DFF};
            pg8::gemm_phase<pg8::EpiSwiGLU, pg8::StaticOrder, true, true>(F.lds, g, S, E, F.wave);
            SEAM(pid(l, 8));
        }
        if (EN(13) && RUN(pid(l, 9))) {
            pg8::Gemm g{FB, (const bf16*)(WSP + W_FFN_OUT + F.l * SZ_FFN_OUT), NTOK, D, DFF}; pg8::StaticOrder S; S.init(NTOK, D, F.G, (int)blockIdx.x);
            if (F.l == DEPTH - 1) { pg8::EpiRes E{X16P, XP, MODL + 5 * 2048};
                pg8::gemm_phase<pg8::EpiRes, pg8::StaticOrder, true, true>(F.lds, g, S, E, F.wave); }
            else { pg8::EpiY E{YB, MODL + 5 * 2048};
                pg8::gemm_phase<pg8::EpiY, pg8::StaticOrder, true, true>(F.lds, g, S, E, F.wave); }
            SEAM(pid(l, 9));
        }
    }
#ifdef PROBE_SUB
    if (blockIdx.x == 0) { const unsigned long long t0_ = rt(); while (rt() - t0_ < 4ull * PT.acc) __builtin_amdgcn_s_sleep(8); }
#endif
#ifdef PROBE_SLOT
    if (blockIdx.x == 0) { const unsigned long long t0_ = rt(); while (rt() - t0_ < (unsigned long long)PROBE_MULT * t_acc_) __builtin_amdgcn_s_sleep(8); }
#endif
#undef RUN
#undef SEAM
}

#ifndef MK_ONE_LAUNCH
#define MK_ONE_LAUNCH 1
#endif
extern "C" void kernel_launch(void* const* d_in, const int* in_sizes, int n_in, void* d_out, int out_size, void* d_ws, size_t ws_size, hipStream_t stream) {
    static int grid = 0;
    if (grid == 0) {
        if (n_in != 28 || (size_t)out_size != O_END || ws_size < WS_END) { fprintf(stderr, "kernel_launch: unexpected shapes: n_in %d out %d ws %zu (need %zu)\n", n_in, out_size, ws_size, (size_t)WS_END); grid = -1; return; }
        int dev = 0, cus = 0, per_cu = 0;
        if (hipGetDevice(&dev) != hipSuccess || hipDeviceGetAttribute(&cus, hipDeviceAttributeMultiprocessorCount, dev) != hipSuccess) { grid = -1; return; }
        if (hipFuncSetAttribute((const void*)fwd_kernel, hipFuncAttributeMaxDynamicSharedMemorySize, LDS_BYTES) != hipSuccess) { fprintf(stderr, "kernel_launch: hipFuncSetAttribute failed\n"); grid = -1; return; }
        if (hipOccupancyMaxActiveBlocksPerMultiprocessor(&per_cu, (const void*)fwd_kernel, NWAVES * 64, LDS_BYTES) != hipSuccess || per_cu < 1) { fprintf(stderr, "kernel_launch: occupancy query says %d blocks per CU\n", per_cu); }
        (void)hipGetLastError();
        grid = cus;
    }
    if (grid < 0) return;
    (void)in_sizes;
    if (hipMemsetAsync((char*)d_ws + WS_CTL, 0, CTL_ZERO_BYTES, stream) != hipSuccess) { fprintf(stderr, "kernel_launch: memset failed\n"); return; }
    Args a{};
    for (int k = 0; k < 28; ++k) a.in[k] = (const float*)d_in[k];
    a.out = (float*)d_out; a.ws = (unsigned char*)d_ws;
#if MK_ONE_LAUNCH
    a.ph_lo = 0; a.ph_hi = PH_END;
    hipLaunchKernelGGL(fwd_kernel, dim3(grid), dim3(NWAVES * 64), LDS_BYTES, stream, a);
#else
    for (int p = 0; p < PH_END; ++p) {
        if (p > 0) { const int l = (p - 1) / 10, s = (p - 1) % 10; if ((l & 1) == 0 && (s == 2 || s == 3 || s == 4)) continue; if ((l & 1) == 1 && (s == 2 || s == 4)) continue; }
        a.ph_lo = p; a.ph_hi = p + 1;
        hipLaunchKernelGGL(fwd_kernel, dim3(grid), dim3(NWAVES * 64), LDS_BYTES, stream, a);
    }
#endif
    const hipError_t le = hipPeekAtLastError();
    if (le != hipSuccess) fprintf(stderr, "kernel_launch: launch failed: %s\n", hipGetErrorName(le));
}
```

```cpp
#include <hip/hip_runtime.h>
#include <cstdio>
#include <cstdint>
#include <cstddef>
__device__ __forceinline__ int lane_id_fresh() { int l = (int)__builtin_amdgcn_mbcnt_hi(~0u, __builtin_amdgcn_mbcnt_lo(~0u, 0u)); asm volatile("" : "+v"(l)); return l; }
namespace pg8 {
#define PG8_LAS __attribute__((address_space(3)))
typedef unsigned short bf16_t;
typedef short bf16x8 __attribute__((ext_vector_type(8)));
typedef float f32x4 __attribute__((ext_vector_type(4)));
typedef unsigned u32x4 __attribute__((ext_vector_type(4)));
constexpr int BM = 256, BK = 64, HALF = 128, HTB = HALF * BK * 2  , STAGE_BYTES = 8 * HTB, NXCD = 8, WGM = 8;

__host__ __device__ __forceinline__ int lds_byte(int r, int c) { const int st = (r >> 4) * 2 + (c >> 5), rr = r & 15, cc = c & 31, ob = rr * 64 + cc * 2; return st * 1024 + (ob ^ (((ob >> 9) & 1) << 5)); }
__host__ __device__ __forceinline__ void stage_rc(int b, int& R, int& C) { const int st = b / 1024, sb = b % 1024, swz = sb ^ (((sb >> 9) & 1) << 5); R = (st >> 1) * 16 + swz / 64; C = (st & 1) * 32 + (swz % 64) / 2; }
__host__ __device__ __forceinline__ int perm32(int rho) { const int n = rho >> 4, i = rho & 15; return 8 * (i >> 2) + 4 * n + (i & 3); }

struct Unit { int pm, pn; };
struct Gemm { const bf16_t* A; const bf16_t* Bt; int M, N, K; };

struct StaticOrder {
    int nM, nN, nwg, G, c;
    __host__ __device__ void init(int M, int N, int G_, int c_) { nM = M / BM; nN = N / BM; nwg = nM * nN; G = G_; c = c_; }
    __host__ __device__ bool next(int i, Unit& u) const {
        const long L = (long)i * G + c; if (L >= nwg) return false;
        int wgid = (int)L; { const int q = nwg / NXCD, r = nwg % NXCD, xcd = wgid % NXCD, off = wgid / NXCD; wgid = (xcd < r ? xcd * (q + 1) : r * (q + 1) + (xcd - r) * q) + off; }
        const int nig = WGM * nN, gid = wgid / nig, fm = gid * WGM, gsz = (nM - fm) < WGM ? (nM - fm) : WGM;
        u.pm = fm + ((wgid % nig) % gsz); u.pn = (wgid % nig) / gsz; return true;
    }
    __device__ __forceinline__ void a_ready(const Unit&) const {}
    __device__ __forceinline__ void done(const Unit&) const {}
};
__device__ __forceinline__ unsigned cvt_pk_bf16(float lo, float hi) { unsigned r; asm volatile("v_cvt_pk_bf16_f32 %0, %1, %2" : "=v"(r) : "v"(lo), "v"(hi)); return r; }

__device__ __forceinline__ int cond_of_pm(int pm) { return pm < 32 ? 0 : 1 + ((pm - 32) >> 3); }

struct EpiBf16P {
    static constexpr bool PERM = true, AFTER_DRAIN = false;
    bf16_t* O; int ldc;
    __device__ __forceinline__ void operator()(const f32x4 (&acc)[2][2][4][2], const Unit& u, int wr, int wc, int fr_in, int fq_in) const {
        (void)fr_in; (void)fq_in; const int lane_e = lane_id_fresh(), fr = lane_e & 15, fq = lane_e >> 4;
        const int row0 = u.pm * BM + wr * 64 + fr, col0 = u.pn * BM + wc * 32 + 8 * fq;
#pragma unroll
        for (int ai = 0; ai < 2; ++ai)
#pragma unroll
            for (int m = 0; m < 4; ++m) { bf16_t* rowp = O + (unsigned)(row0 + ai * HALF + m * 16) * (unsigned)ldc + col0;
#pragma unroll
                for (int bj = 0; bj < 2; ++bj) { const f32x4 v0 = acc[ai][bj][m][0], v1 = acc[ai][bj][m][1];
                    u32x4 w; w.x = cvt_pk_bf16(v0[0], v0[1]); w.y = cvt_pk_bf16(v0[2], v0[3]); w.z = cvt_pk_bf16(v1[0], v1[1]); w.w = cvt_pk_bf16(v1[2], v1[3]);
                    *(u32x4*)(rowp + bj * HALF) = w; } }
    }
};
struct EpiF32P {
    static constexpr bool PERM = false, AFTER_DRAIN = false;
    float* C; int ldc;
    __device__ __forceinline__ void operator()(const f32x4 (&acc)[2][2][4][2], const Unit& u, int wr, int wc, int fr_in, int fq_in) const {
        (void)fr_in; (void)fq_in; const int lane_e = lane_id_fresh(), fr = lane_e & 15, fq = lane_e >> 4;
        const int row0 = u.pm * BM + wr * 64 + fr, col0 = u.pn * BM + wc * 32 + 4 * fq;
#pragma unroll
        for (int ai = 0; ai < 2; ++ai)
#pragma unroll
            for (int m = 0; m < 4; ++m) { float* rowp = C + (unsigned)(row0 + ai * HALF + m * 16) * (unsigned)ldc + col0;
#pragma unroll
                for (int bj = 0; bj < 2; ++bj)
#pragma unroll
                    for (int n = 0; n < 2; ++n) *(f32x4*)(rowp + bj * HALF + n * 16) = acc[ai][bj][m][n]; }
    }
};
struct EpiRes {
    static constexpr bool PERM = false, AFTER_DRAIN = false;
    const _Float16* base; float* out; const float* gate;
    __device__ __forceinline__ void operator()(const f32x4 (&acc)[2][2][4][2], const Unit& u, int wr, int wc, int fr_in, int fq_in) const {
        typedef _Float16 h16x4 __attribute__((ext_vector_type(4)));
        (void)fr_in; (void)fq_in; const int lane_e = lane_id_fresh(), fr = lane_e & 15, fq = lane_e >> 4;
        const int row0 = u.pm * BM + wr * 64 + fr, col0 = u.pn * BM + wc * 32 + 4 * fq;
        const float* g = gate + (unsigned)cond_of_pm(u.pm) * 12288u + col0;
        f32x4 gv[2][2];
#pragma unroll
        for (int bj = 0; bj < 2; ++bj)
#pragma unroll
            for (int n = 0; n < 2; ++n) gv[bj][n] = *(const f32x4*)(g + bj * HALF + n * 16);
#pragma unroll
        for (int ai = 0; ai < 2; ++ai)
#pragma unroll
            for (int m = 0; m < 4; ++m) { const unsigned off = (unsigned)(row0 + ai * HALF + m * 16) * 2048u + col0;
#pragma unroll
                for (int bj = 0; bj < 2; ++bj)
#pragma unroll
                    for (int n = 0; n < 2; ++n) { const f32x4 bs = __builtin_convertvector(*(const h16x4*)(base + off + bj * HALF + n * 16), f32x4);
                        *(f32x4*)(out + off + bj * HALF + n * 16) = bs + gv[bj][n] * acc[ai][bj][m][n]; }
                if (m & 1) asm volatile("" ::: "memory"); }
    }
};
__device__ __forceinline__ float silu_f(float x) { return x * __builtin_amdgcn_rcpf(1.0f + __builtin_amdgcn_exp2f(-1.4426950408889634f * x)); }
__device__ __forceinline__ f32x4 swiglu4(const f32x4 g, const f32x4 u) {
    const f32x4 t = g * (-1.4426950408889634f);
    f32x4 d; d[0] = __builtin_amdgcn_exp2f(t[0]); d[1] = __builtin_amdgcn_exp2f(t[1]); d[2] = __builtin_amdgcn_exp2f(t[2]); d[3] = __builtin_amdgcn_exp2f(t[3]);
    d = d + 1.0f;
    f32x4 r; r[0] = __builtin_amdgcn_rcpf(d[0]); r[1] = __builtin_amdgcn_rcpf(d[1]); r[2] = __builtin_amdgcn_rcpf(d[2]); r[3] = __builtin_amdgcn_rcpf(d[3]);
    return (g * u) * r;
}
struct EpiSwiGLU {
    static constexpr bool PERM = true, AFTER_DRAIN = false;
    bf16_t* O; int ldc;
    __device__ __forceinline__ void operator()(const f32x4 (&acc)[2][2][4][2], const Unit& u, int wr, int wc, int fr_in, int fq_in) const {
        (void)fr_in; (void)fq_in; const int lane_e = lane_id_fresh(), fr = lane_e & 15, fq = lane_e >> 4;
        const int row0 = u.pm * BM + wr * 64 + fr, col0 = u.pn * HALF + wc * 32 + 8 * fq;
#pragma unroll
        for (int ai = 0; ai < 2; ++ai)
#pragma unroll
            for (int m = 0; m < 4; ++m) { bf16_t* rowp = O + (unsigned)(row0 + ai * HALF + m * 16) * (unsigned)ldc + col0;
                const f32x4 g0 = acc[ai][0][m][0], g1 = acc[ai][0][m][1], u0 = acc[ai][1][m][0], u1 = acc[ai][1][m][1];
                const f32x4 h0 = swiglu4(g0, u0), h1 = swiglu4(g1, u1);
                u32x4 w; w.x = cvt_pk_bf16(h0[0], h0[1]); w.y = cvt_pk_bf16(h0[2], h0[3]); w.z = cvt_pk_bf16(h1[0], h1[1]); w.w = cvt_pk_bf16(h1[2], h1[3]);
                *(u32x4*)rowp = w; }
    }
};

constexpr float NORM_EPS = 1e-6f;
__device__ __forceinline__ float sum_rows4(float s) {
    const auto a = __builtin_amdgcn_permlane16_swap(__float_as_uint(s), __float_as_uint(s), false, false); s = __uint_as_float(a[0]) + __uint_as_float(a[1]);
    const auto b = __builtin_amdgcn_permlane32_swap(__float_as_uint(s), __float_as_uint(s), false, false); return __uint_as_float(b[0]) + __uint_as_float(b[1]);
}
__device__ __forceinline__ float xor32(float y, bool upper) { const auto b = __builtin_amdgcn_permlane32_swap(__float_as_uint(y), __float_as_uint(y), false, false); return __uint_as_float(upper ? b[0] : b[1]); }
__device__ __forceinline__ void row_half_allreduce(float (&ss)[2][4][2], PG8_LAS float* red, int wr, int wc, int fr, int fq) {
#pragma unroll
    for (int ai = 0; ai < 2; ++ai)
#pragma unroll
        for (int m = 0; m < 4; ++m)
#pragma unroll
            for (int bj = 0; bj < 2; ++bj) ss[ai][m][bj] = sum_rows4(ss[ai][m][bj]);
    if (fq == 0) {
#pragma unroll
        for (int ai = 0; ai < 2; ++ai)
#pragma unroll
            for (int m = 0; m < 4; ++m)
#pragma unroll
                for (int bj = 0; bj < 2; ++bj) red[((ai * HALF + wr * 64 + m * 16 + fr) * 2 + bj) * 4 + wc] = ss[ai][m][bj];
    }
    asm volatile("s_waitcnt lgkmcnt(0)" ::: "memory"); __builtin_amdgcn_s_barrier(); asm volatile("" ::: "memory");
}
__device__ __forceinline__ void row_half_read(const PG8_LAS float* red, int ai, int m, int wr, int fr, float& s0, float& s1) {
    const PG8_LAS f32x4* p = (const PG8_LAS f32x4*)(red + (ai * HALF + wr * 64 + m * 16 + fr) * 8);
    const f32x4 a = p[0], b = p[1]; s0 = (a[0] + a[1]) + (a[2] + a[3]); s1 = (b[0] + b[1]) + (b[2] + b[3]);
}
__device__ __forceinline__ float dot4(const f32x4 a) { return (a[0] * a[0] + a[1] * a[1]) + (a[2] * a[2] + a[3] * a[3]); }
__device__ __forceinline__ u32x4 pack8(const f32x4 a, const f32x4 b) { u32x4 w; w.x = cvt_pk_bf16(a[0], a[1]); w.y = cvt_pk_bf16(a[2], a[3]); w.z = cvt_pk_bf16(b[0], b[1]); w.w = cvt_pk_bf16(b[2], b[3]); return w; }

struct EpiInAB {
    static constexpr bool PERM = true, AFTER_DRAIN = false;
    bf16_t* P; const float* gq; const float* gk; float* natk; float* natv; PG8_LAS float* red;
    __device__ __forceinline__ void operator()(const f32x4 (&acc)[2][2][4][2], const Unit& u, int wr, int wc, int fr_in, int fq_in) const {
        (void)fr_in; (void)fq_in; const int lane_e = lane_id_fresh(), fr = lane_e & 15, fq = lane_e >> 4;
        const int row0 = u.pm * BM + wr * 64 + fr, col0 = u.pn * BM + wc * 32 + 8 * fq, dh = wc * 32 + 8 * fq;
        if (u.pn < 8) {
            float ss[2][4][2];
#pragma unroll
            for (int ai = 0; ai < 2; ++ai)
#pragma unroll
                for (int m = 0; m < 4; ++m)
#pragma unroll
                    for (int bj = 0; bj < 2; ++bj) ss[ai][m][bj] = dot4(acc[ai][bj][m][0]) + dot4(acc[ai][bj][m][1]);
            row_half_allreduce(ss, red, wr, wc, fr, fq);
            const float* g = (u.pn < 4 ? gq : gk) + dh; const f32x4 g0 = *(const f32x4*)g, g1 = *(const f32x4*)(g + 4);
            const bool emit = u.pn >= 4 && u.pm < 32;
#pragma unroll
            for (int ai = 0; ai < 2; ++ai)
#pragma unroll
                for (int m = 0; m < 4; ++m) { bf16_t* rowp = P + (unsigned)(row0 + ai * HALF + m * 16) * 6144u + col0;
                    float st[2]; row_half_read(red, ai, m, wr, fr, st[0], st[1]);
#pragma unroll
                    for (int bj = 0; bj < 2; ++bj) { const float rstd = __builtin_amdgcn_rsqf(st[bj] * (1.0f / 128.0f) + NORM_EPS);
                        const f32x4 y0 = acc[ai][bj][m][0] * rstd * g0, y1 = acc[ai][bj][m][1] * rstd * g1;
                        *(u32x4*)(rowp + bj * HALF) = pack8(y0, y1);
                        if (emit) { const int h = (u.pn - 4) * 2 + bj, t = ai * HALF + wr * 64 + m * 16 + fr; float* dst = natk + ((unsigned)(u.pm * 16 + h) * 256u + (unsigned)t) * 128u + dh;
                            *(f32x4*)dst = y0; *(f32x4*)(dst + 4) = y1; } }
                    asm volatile("" ::: "memory"); }
        } else {
            const bool emit = u.pn < 12 && u.pm < 32;
#pragma unroll
            for (int ai = 0; ai < 2; ++ai)
#pragma unroll
                for (int m = 0; m < 4; ++m) { bf16_t* rowp = P + (unsigned)(row0 + ai * HALF + m * 16) * 6144u + col0;
#pragma unroll
                    for (int bj = 0; bj < 2; ++bj) { const f32x4 y0 = acc[ai][bj][m][0], y1 = acc[ai][bj][m][1];
                        *(u32x4*)(rowp + bj * HALF) = pack8(y0, y1);
                        if (emit) { const int h = (u.pn - 8) * 2 + bj, t = ai * HALF + wr * 64 + m * 16 + fr; float* dst = natv + ((unsigned)(u.pm * 16 + h) * 256u + (unsigned)t) * 128u + dh;
                            *(f32x4*)dst = y0; *(f32x4*)(dst + 4) = y1; } } }
        }
    }
};
struct EpiUQ {
    static constexpr bool PERM = true, AFTER_DRAIN = false;
    bf16_t* Qn; const float* gq; const float* CQP; float* QSQ;
    __device__ __forceinline__ void operator()(const f32x4 (&acc)[2][2][4][2], const Unit& u, int wr, int wc, int fr_in, int fq_in) const {
        (void)fr_in; (void)fq_in; const int lane_e = lane_id_fresh(), fr = lane_e & 15, fq = lane_e >> 4;
        const int row0 = u.pm * BM + wr * 64 + fr;
        float rq[2][4];
#pragma unroll
        for (int ai = 0; ai < 2; ++ai)
#pragma unroll
            for (int m = 0; m < 4; ++m) { const float* cp = CQP + (unsigned)(row0 + ai * HALF + m * 16) * 8u; const f32x4 a = *(const f32x4*)cp, b = *(const f32x4*)(cp + 4);
                rq[ai][m] = __builtin_amdgcn_rsqf((((a[0] + a[1]) + (a[2] + a[3])) + ((b[0] + b[1]) + (b[2] + b[3]))) * (1.0f / 512.0f) + NORM_EPS); }
        const bool lat = u.pm >= 32; const int jf = 8 * (fq & 1); const bool isx2 = (fq >> 1) != 0;
        f32x4 fr0, fr1;
#pragma unroll
        for (int e4 = 0; e4 < 4; ++e4) { fr0[e4] = exp2f(-(float)(jf + e4) * (13.287712379549449f / 16.0f)) * 0.15915494309189535f; fr1[e4] = exp2f(-(float)(jf + 4 + e4) * (13.287712379549449f / 16.0f)) * 0.15915494309189535f; }
#pragma unroll
        for (int bj = 0; bj < 2; ++bj) {
            const int blk = 4 * u.pn + 2 * bj + (wc >> 1), hd = blk / 3, part = blk - 3 * hd;
            const int dh = part * 64 + (wc & 1) * 32 + 8 * fq;
            const f32x4 g0 = *(const f32x4*)(gq + dh), g1 = *(const f32x4*)(gq + dh + 4);
            const bool rope = part == 2 && lat;
#pragma unroll
            for (int ai = 0; ai < 2; ++ai)
#pragma unroll
                for (int m = 0; m < 4; ++m) { const unsigned row = (unsigned)(row0 + ai * HALF + m * 16);
                    const f32x4 q0 = acc[ai][bj][m][0] * rq[ai][m], q1 = acc[ai][bj][m][1] * rq[ai][m];
                    const float s = sum_rows4(dot4(q0) + dot4(q1));
                    if (fq == 0) QSQ[row * 96u + 2 * blk + (wc & 1)] = s;
                    f32x4 y0 = q0 * g0, y1 = q1 * g1;
                    if (rope) {
                        const int t = ((int)row - 8192) & 2047; const float pos = (float)((wc & 1) ? (t & 63) : (t >> 6));
                        f32x4 c0, c1, s0, s1, p0, p1;
#pragma unroll
                        for (int e4 = 0; e4 < 4; ++e4) { c0[e4] = __builtin_amdgcn_cosf(pos * fr0[e4]); s0[e4] = __builtin_amdgcn_sinf(pos * fr0[e4]); c1[e4] = __builtin_amdgcn_cosf(pos * fr1[e4]); s1[e4] = __builtin_amdgcn_sinf(pos * fr1[e4]); }
#pragma unroll
                        for (int e4 = 0; e4 < 4; ++e4) { p0[e4] = xor32(y0[e4], isx2); p1[e4] = xor32(y1[e4], isx2); }
                        if (isx2) { y0 = p0 * s0 + y0 * c0; y1 = p1 * s1 + y1 * c1; } else { y0 = y0 * c0 - p0 * s0; y1 = y1 * c1 - p1 * s1; }
                    }
                    *(u32x4*)(Qn + row * 3072u + u.pn * BM + bj * HALF + wc * 32 + 8 * fq) = pack8(y0, y1);
                    asm volatile("" ::: "memory"); }
        }
    }
};
struct EpiUKV {
    static constexpr bool PERM = true, AFTER_DRAIN = false;
    bf16_t* Kn; bf16_t* Vn; const float* gk; const float* RK; const float* KRSQ; PG8_LAS float* red;
    __device__ __forceinline__ void operator()(const f32x4 (&acc)[2][2][4][2], const Unit& u, int wr, int wc, int fr_in, int fq_in) const {
        typedef unsigned u32x2v __attribute__((ext_vector_type(2)));
        (void)fr_in; (void)fq_in; const int lane_e = lane_id_fresh(), fr = lane_e & 15, fq = lane_e >> 4;
        const int row0 = u.pm * BM + wr * 64 + fr, dh = wc * 32 + 8 * fq, kc = wc * 16 + 4 * fq;
        f32x4 rk[2][4]; float ksq[2][4];
#pragma unroll
        for (int ai = 0; ai < 2; ++ai)
#pragma unroll
            for (int m = 0; m < 4; ++m) { const unsigned row = (unsigned)(row0 + ai * HALF + m * 16); rk[ai][m] = *(const f32x4*)(RK + row * 64u + kc); ksq[ai][m] = KRSQ[row]; }
        const f32x4 ga0 = *(const f32x4*)(gk + dh), ga1 = *(const f32x4*)(gk + dh + 4);
        float ss[2][4][2];
#pragma unroll
        for (int ai = 0; ai < 2; ++ai)
#pragma unroll
            for (int m = 0; m < 4; ++m) { ss[ai][m][0] = dot4(acc[ai][0][m][0]) + dot4(acc[ai][0][m][1]); ss[ai][m][1] = 0.f; }
        row_half_allreduce(ss, red, wr, wc, fr, fq);
#pragma unroll
        for (int ai = 0; ai < 2; ++ai)
#pragma unroll
            for (int m = 0; m < 4; ++m) { const unsigned row = (unsigned)(row0 + ai * HALF + m * 16); bf16_t* rowp = Kn + row * 3072u + u.pn * 192;
                float st0, st1; row_half_read(red, ai, m, wr, fr, st0, st1);
                const float rstd = __builtin_amdgcn_rsqf((st0 + ksq[ai][m]) * (1.0f / 192.0f) + NORM_EPS);
                *(u32x4*)(rowp + dh) = pack8(acc[ai][0][m][0] * rstd * ga0, acc[ai][0][m][1] * rstd * ga1);
                *(u32x4*)(Vn + row * 2048u + u.pn * 128 + dh) = pack8(acc[ai][1][m][0], acc[ai][1][m][1]);
                const f32x4 y = rk[ai][m] * rstd; u32x2v w; w.x = cvt_pk_bf16(y[0], y[1]); w.y = cvt_pk_bf16(y[2], y[3]);
                *(u32x2v*)(rowp + 128 + kc) = w; }
    }
};
struct EpiYX {
    static constexpr bool PERM = true, AFTER_DRAIN = false;
    _Float16* X; const float* gate;
    __device__ __forceinline__ void operator()(const f32x4 (&acc)[2][2][4][2], const Unit& u, int wr, int wc, int fr_in, int fq_in) const {
        typedef _Float16 h16x4 __attribute__((ext_vector_type(4)));
        typedef _Float16 h16x8 __attribute__((ext_vector_type(8)));
        (void)fr_in; (void)fq_in; const int lane_e = lane_id_fresh(), fr = lane_e & 15, fq = lane_e >> 4;
        const int row0 = u.pm * BM + wr * 64 + fr, col0 = u.pn * BM + wc * 32 + 8 * fq;
        const float* g = gate + (unsigned)cond_of_pm(u.pm) * 12288u + col0;
        _Float16* xb = X + (unsigned)row0 * 2048u + col0;
#pragma unroll
        for (int ai = 0; ai < 2; ++ai) {
            h16x8 xr[4][2];
#pragma unroll
            for (int m = 0; m < 4; ++m)
#pragma unroll
                for (int bj = 0; bj < 2; ++bj) xr[m][bj] = *(const h16x8*)(xb + (unsigned)(ai * HALF + m * 16) * 2048u + bj * HALF);
            f32x4 gv[2][2];
#pragma unroll
            for (int bj = 0; bj < 2; ++bj)
#pragma unroll
                for (int n = 0; n < 2; ++n) gv[bj][n] = *(const f32x4*)(g + bj * HALF + n * 4);
#pragma unroll
            for (int m = 0; m < 4; ++m)
#pragma unroll
                for (int bj = 0; bj < 2; ++bj) {
                    const f32x4 x0 = __builtin_convertvector(__builtin_shufflevector(xr[m][bj], xr[m][bj], 0, 1, 2, 3), f32x4) + acc[ai][bj][m][0] * gv[bj][0];
                    const f32x4 x1 = __builtin_convertvector(__builtin_shufflevector(xr[m][bj], xr[m][bj], 4, 5, 6, 7), f32x4) + acc[ai][bj][m][1] * gv[bj][1];
                    const h16x4 h0 = __builtin_convertvector(x0, h16x4), h1 = __builtin_convertvector(x1, h16x4);
                    *(h16x8*)(xb + (unsigned)(ai * HALF + m * 16) * 2048u + bj * HALF) = __builtin_shufflevector(h0, h1, 0, 1, 2, 3, 4, 5, 6, 7); }
        }
    }
};
struct EpiDown {
    static constexpr bool PERM = true, AFTER_DRAIN = false;
    bf16_t* cqn; float* CQP; bf16_t* ckvn; const float* gckv; float* out_ckv; float* out_kr; const float* gkr; float* RK; float* KRSQ; PG8_LAS float* red;
    __device__ __forceinline__ void operator()(const f32x4 (&acc)[2][2][4][2], const Unit& u, int wr, int wc, int fr_in, int fq_in) const {
        (void)fr_in; (void)fq_in; const int lane_e = lane_id_fresh(), fr = lane_e & 15, fq = lane_e >> 4;
        const int row0 = u.pm * BM + wr * 64 + fr, dh = wc * 32 + 8 * fq;
        if (u.pn < 2) {
#pragma unroll
            for (int ai = 0; ai < 2; ++ai)
#pragma unroll
                for (int m = 0; m < 4; ++m) { const unsigned row = (unsigned)(row0 + ai * HALF + m * 16);
                    float s = (dot4(acc[ai][0][m][0]) + dot4(acc[ai][0][m][1])) + (dot4(acc[ai][1][m][0]) + dot4(acc[ai][1][m][1]));
                    s = sum_rows4(s);
                    if (fq == 0) CQP[row * 8u + u.pn * 4 + wc] = s;
#pragma unroll
                    for (int bj = 0; bj < 2; ++bj) *(u32x4*)(cqn + row * 512u + u.pn * 256 + bj * HALF + dh) = pack8(acc[ai][bj][m][0], acc[ai][bj][m][1]); }
        } else if (u.pn == 2) {
            float ss[2][4][2];
#pragma unroll
            for (int ai = 0; ai < 2; ++ai)
#pragma unroll
                for (int m = 0; m < 4; ++m)
#pragma unroll
                    for (int bj = 0; bj < 2; ++bj) ss[ai][m][bj] = dot4(acc[ai][bj][m][0]) + dot4(acc[ai][bj][m][1]);
            row_half_allreduce(ss, red, wr, wc, fr, fq);
            f32x4 g[2][2];
#pragma unroll
            for (int bj = 0; bj < 2; ++bj) { g[bj][0] = *(const f32x4*)(gckv + bj * HALF + dh); g[bj][1] = *(const f32x4*)(gckv + bj * HALF + dh + 4); }
#pragma unroll
            for (int ai = 0; ai < 2; ++ai)
#pragma unroll
                for (int m = 0; m < 4; ++m) { const unsigned row = (unsigned)(row0 + ai * HALF + m * 16);
                    float st0, st1; row_half_read(red, ai, m, wr, fr, st0, st1);
                    const float rstd = __builtin_amdgcn_rsqf((st0 + st1) * (1.0f / 256.0f) + NORM_EPS);
#pragma unroll
                    for (int bj = 0; bj < 2; ++bj) { const f32x4 y0 = acc[ai][bj][m][0] * rstd * g[bj][0], y1 = acc[ai][bj][m][1] * rstd * g[bj][1];
                        *(u32x4*)(ckvn + row * 256u + bj * HALF + dh) = pack8(y0, y1);
                        if (u.pm < 32) { float* dst = out_ckv + ((unsigned)(u.pm * 2) * 256u + (unsigned)(ai * HALF + wr * 64 + m * 16 + fr)) * 256u + bj * HALF + dh; *(f32x4*)dst = y0; *(f32x4*)(dst + 4) = y1; } }
                    asm volatile("" ::: "memory"); }
        } else {
            const bool mine = wc < 2;
            float ss[2][4][2];
#pragma unroll
            for (int ai = 0; ai < 2; ++ai)
#pragma unroll
                for (int m = 0; m < 4; ++m) { ss[ai][m][0] = mine ? dot4(acc[ai][0][m][0]) + dot4(acc[ai][0][m][1]) : 0.f; ss[ai][m][1] = 0.f; }
            row_half_allreduce(ss, red, wr, wc, fr, fq);
            f32x4 g0 = {0.f, 0.f, 0.f, 0.f}, g1 = {0.f, 0.f, 0.f, 0.f};
            if (mine) { g0 = *(const f32x4*)(gkr + dh); g1 = *(const f32x4*)(gkr + dh + 4); }
            const bool lat = u.pm >= 32; const int jf = 8 * (fq & 1); const bool isx2 = (fq >> 1) != 0;
            f32x4 fr0, fr1;
#pragma unroll
            for (int e4 = 0; e4 < 4; ++e4) { fr0[e4] = exp2f(-(float)(jf + e4) * (13.287712379549449f / 16.0f)) * 0.15915494309189535f; fr1[e4] = exp2f(-(float)(jf + 4 + e4) * (13.287712379549449f / 16.0f)) * 0.15915494309189535f; }
#pragma unroll
            for (int ai = 0; ai < 2; ++ai)
#pragma unroll
                for (int m = 0; m < 4; ++m) { const unsigned row = (unsigned)(row0 + ai * HALF + m * 16);
                    float st0, st1; row_half_read(red, ai, m, wr, fr, st0, st1);
                    if (wc == 0 && fq == 0) KRSQ[row] = st0;
                    const f32x4 k0 = acc[ai][0][m][0], k1 = acc[ai][0][m][1];
                    if (mine && u.pm < 32) { float* dst = out_kr + ((unsigned)(u.pm * 2) * 256u + (unsigned)(ai * HALF + wr * 64 + m * 16 + fr)) * 64u + dh; *(f32x4*)dst = k0; *(f32x4*)(dst + 4) = k1; }
                    f32x4 y0 = k0 * g0, y1 = k1 * g1;
                    if (lat && mine) {
                        const int t = ((int)row - 8192) & 2047; const float pos = (float)(wc ? (t & 63) : (t >> 6));
                        f32x4 c0, c1, s0, s1, p0, p1;
#pragma unroll
                        for (int e4 = 0; e4 < 4; ++e4) { c0[e4] = __builtin_amdgcn_cosf(pos * fr0[e4]); s0[e4] = __builtin_amdgcn_sinf(pos * fr0[e4]); c1[e4] = __builtin_amdgcn_cosf(pos * fr1[e4]); s1[e4] = __builtin_amdgcn_sinf(pos * fr1[e4]); }
#pragma unroll
                        for (int e4 = 0; e4 < 4; ++e4) { p0[e4] = xor32(y0[e4], isx2); p1[e4] = xor32(y1[e4], isx2); }
                        if (isx2) { y0 = p0 * s0 + y0 * c0; y1 = p1 * s1 + y1 * c1; } else { y0 = y0 * c0 - p0 * s0; y1 = y1 * c1 - p1 * s1; }
                    }
                    if (mine) { float* dst = RK + row * 64u + dh; *(f32x4*)dst = y0; *(f32x4*)(dst + 4) = y1; }
                    asm volatile("" ::: "memory"); }
        }
    }
};
template <class Epi, class Sched, bool ALIGN_EPI = false, bool SP2 = false>
__device__ __forceinline__ void gemm_phase(PG8_LAS unsigned char* lds, const Gemm g, const Sched& S, const Epi& E, const int wid_in) {
    const int tid_ = wid_in * 64 + lane_id_fresh();
    const int tid = tid_, wid = wid_in, lane = tid & 63, wr = wid >> 2, wc = wid & 3, fr = lane & 15, fq = lane >> 4;
    int K_ = g.K; asm volatile("" : "+s"(K_));
    const int K = K_, nt = K / BK;
    unsigned voffA[2], voffB[2];
#pragma unroll
    for (int i = 0; i < 2; ++i) { int R, C; stage_rc(tid * 16 + i * 8192, R, C); const int Rb = Epi::PERM ? ((R & ~31) + perm32(R & 31)) : R;
        voffA[i] = (unsigned)(R * K + C) * 2u; voffB[i] = (unsigned)(Rb * K + C) * 2u; }
    const size_t kstep = (size_t)(BK * 2);
    const size_t hstep = (size_t)HALF * K * 2;
    const size_t tstep = 2 * hstep;
    const unsigned ldsw = (unsigned)wid * 1024u;
    const int aoff = lds_byte(wr * 64 + fr, fq * 8), boff = lds_byte(wc * 32 + fr, fq * 8);
#define PG8_SA(b, h) (((b) * 2 + (h)) * HTB)
#define PG8_SB(b, h) ((4 + (b) * 2 + (h)) * HTB)
#define PG8_STAGE(bufoff, gbase, voff) do { _Pragma("unroll") for (int _i = 0; _i < 2; ++_i) \
        __builtin_amdgcn_global_load_lds((const unsigned*)((const char*)(gbase) + (voff)[_i]), (PG8_LAS unsigned*)(lds + (bufoff) + ldsw + _i * 8192), 16, 0, 0); } while (0)
#define PG8_LDA(dst, b, h) do { _Pragma("unroll") for (int m = 0; m < 4; ++m) _Pragma("unroll") for (int k = 0; k < 2; ++k) dst[m][k] = *(const PG8_LAS bf16x8*)(lds + PG8_SA(b, h) + aoff + m * 2048 + k * 1024); } while (0)
#define PG8_LDB(dst, b, h) do { _Pragma("unroll") for (int n = 0; n < 2; ++n) _Pragma("unroll") for (int k = 0; k < 2; ++k) dst[n][k] = *(const PG8_LAS bf16x8*)(lds + PG8_SB(b, h) + boff + n * 2048 + k * 1024); } while (0)
#define PG8_MMA(ai, bj, At, Bt) do { __builtin_amdgcn_s_setprio(1); _Pragma("unroll") for (int m = 0; m < 4; ++m) _Pragma("unroll") for (int n = 0; n < 2; ++n) _Pragma("unroll") for (int k = 0; k < 2; ++k) \
        acc[ai][bj][m][n] = __builtin_amdgcn_mfma_f32_16x16x32_bf16(Bt[n][k], At[m][k], acc[ai][bj][m][n], 0, 0, 0); __builtin_amdgcn_s_setprio(0); } while (0)
#define PG8_WAIT_V(n) asm volatile("s_waitcnt vmcnt(" #n ")" ::: "memory")
#define PG8_WAIT_L(n) asm volatile("s_waitcnt lgkmcnt(" #n ")" ::: "memory")
#define PG8_BAR __builtin_amdgcn_s_barrier()
#define PG8_SCHED __builtin_amdgcn_sched_barrier(0)
    Unit cur, nxt; int ui = 0;
    if (!S.next(0, cur)) return;
    f32x4 acc[2][2][4][2];
#pragma unroll
    for (int a = 0; a < 2; ++a)
#pragma unroll
        for (int b = 0; b < 2; ++b)
#pragma unroll
            for (int m = 0; m < 4; ++m)
#pragma unroll
                for (int n = 0; n < 2; ++n) acc[a][b][m][n] = (f32x4){0.f, 0.f, 0.f, 0.f};
    bf16x8 At[4][2], B0[2][2], B1[2][2];
    const char* cA = (const char*)g.A + (size_t)cur.pm * tstep; const char* cB = (const char*)g.Bt + (size_t)cur.pn * tstep;
    S.a_ready(cur);
    if constexpr (SP2) {
        PG8_STAGE(PG8_SB(0, 0), cB, voffB); PG8_STAGE(PG8_SB(0, 1), cB + hstep, voffB); PG8_STAGE(PG8_SA(0, 0), cA, voffA); PG8_STAGE(PG8_SA(0, 1), cA + hstep, voffA);
        if (wr == 1) PG8_BAR;
        PG8_WAIT_V(2); PG8_BAR;
        PG8_STAGE(PG8_SB(1, 0), cB + kstep, voffB); PG8_STAGE(PG8_SA(1, 0), cA + kstep, voffA); PG8_STAGE(PG8_SB(1, 1), cB + hstep + kstep, voffB);
        PG8_WAIT_V(6); PG8_BAR;
    } else {
        PG8_STAGE(PG8_SB(0, 0), cB, voffB); PG8_STAGE(PG8_SA(0, 0), cA, voffA); PG8_STAGE(PG8_SB(0, 1), cB + hstep, voffB); PG8_STAGE(PG8_SA(0, 1), cA + hstep, voffA);
        if (wr == 1) PG8_BAR;
        PG8_WAIT_V(4); PG8_BAR;
        PG8_STAGE(PG8_SB(1, 0), cB + kstep, voffB); PG8_STAGE(PG8_SA(1, 0), cA + kstep, voffA); PG8_STAGE(PG8_SB(1, 1), cB + hstep + kstep, voffB);
        PG8_WAIT_V(6); PG8_BAR;
    }
    for (;;) {
        const bool has_next = S.next(ui + 1, nxt);
        const char* nA = has_next ? (const char*)g.A + (size_t)nxt.pm * tstep : cA; const char* nB = has_next ? (const char*)g.Bt + (size_t)nxt.pn * tstep : cB;
        for (int t = 0; t < nt; t += 2) {
            const bool last = (t == nt - 2);
            const char* a1 = cA + (size_t)(t + 1) * kstep;
            const char* a2 = last ? nA : cA + (size_t)(t + 2) * kstep; const char* b2 = last ? nB : cB + (size_t)(t + 2) * kstep;
            const char* a3 = a2 + kstep; const char* b3 = b2 + kstep;
            if (last && has_next) S.a_ready(nxt);
            if constexpr (SP2) {
            PG8_LDB(B0, 0, 0); PG8_LDB(B1, 0, 1); PG8_SCHED; PG8_LDA(At, 0, 0); PG8_STAGE(PG8_SA(1, 1), a1 + hstep, voffA);
            PG8_WAIT_V(8); PG8_WAIT_L(0); PG8_BAR; PG8_MMA(0, 0, At, B0); PG8_MMA(0, 1, At, B1); PG8_BAR; PG8_SCHED;
            PG8_LDA(At, 0, 1); PG8_STAGE(PG8_SB(0, 0), b2, voffB); PG8_STAGE(PG8_SB(0, 1), b2 + hstep, voffB); PG8_STAGE(PG8_SA(0, 0), a2, voffA);
            PG8_WAIT_V(8); PG8_WAIT_L(0); PG8_BAR; PG8_MMA(1, 0, At, B0); PG8_MMA(1, 1, At, B1); PG8_BAR; PG8_SCHED;
            PG8_LDB(B0, 1, 0); PG8_LDB(B1, 1, 1); PG8_SCHED; PG8_LDA(At, 1, 0); PG8_STAGE(PG8_SA(0, 1), a2 + hstep, voffA);
            PG8_WAIT_V(8); PG8_WAIT_L(0); PG8_BAR; PG8_MMA(0, 0, At, B0); PG8_MMA(0, 1, At, B1); PG8_BAR; PG8_SCHED;
            PG8_LDA(At, 1, 1); PG8_STAGE(PG8_SB(1, 0), b3, voffB); PG8_STAGE(PG8_SB(1, 1), b3 + hstep, voffB); PG8_STAGE(PG8_SA(1, 0), a3, voffA);
            PG8_WAIT_V(8); PG8_WAIT_L(0); PG8_BAR; PG8_MMA(1, 0, At, B0); PG8_MMA(1, 1, At, B1); PG8_BAR; PG8_SCHED;
            } else {
            PG8_LDB(B0, 0, 0); PG8_SCHED; PG8_LDA(At, 0, 0); PG8_STAGE(PG8_SA(1, 1), a1 + hstep, voffA);
            PG8_WAIT_L(8); PG8_BAR; PG8_WAIT_L(0); PG8_MMA(0, 0, At, B0); PG8_BAR; PG8_SCHED;
            PG8_LDB(B1, 0, 1); PG8_STAGE(PG8_SB(0, 0), b2, voffB);
            PG8_BAR; PG8_WAIT_L(0); PG8_MMA(0, 1, At, B1); PG8_BAR;
            PG8_LDA(At, 0, 1); PG8_STAGE(PG8_SA(0, 0), a2, voffA);
            PG8_BAR; PG8_WAIT_L(0); PG8_MMA(1, 0, At, B0); PG8_BAR; PG8_SCHED;
            PG8_STAGE(PG8_SB(0, 1), b2 + hstep, voffB);
            PG8_WAIT_V(6); PG8_BAR; PG8_MMA(1, 1, At, B1); PG8_BAR;
            PG8_LDB(B0, 1, 0); PG8_SCHED; PG8_LDA(At, 1, 0); PG8_STAGE(PG8_SA(0, 1), a2 + hstep, voffA);
            PG8_WAIT_L(8); PG8_BAR; PG8_WAIT_L(0); PG8_MMA(0, 0, At, B0); PG8_BAR; PG8_SCHED;
            PG8_LDB(B1, 1, 1); PG8_STAGE(PG8_SB(1, 0), b3, voffB);
            PG8_BAR; PG8_WAIT_L(0); PG8_MMA(0, 1, At, B1); PG8_BAR;
            PG8_LDA(At, 1, 1); PG8_STAGE(PG8_SA(1, 0), a3, voffA);
            PG8_BAR; PG8_WAIT_L(0); PG8_MMA(1, 0, At, B0); PG8_BAR; PG8_SCHED;
            PG8_STAGE(PG8_SB(1, 1), b3 + hstep, voffB);
            PG8_WAIT_V(6); PG8_BAR; PG8_MMA(1, 1, At, B1); PG8_BAR;
            }
        }
        if constexpr (ALIGN_EPI) { if (wr == 0) PG8_BAR; }
        if constexpr (!Epi::AFTER_DRAIN) { E(acc, cur, wr, wc, fr, fq); S.done(cur); }
        if (!has_next) break;
#pragma unroll
        for (int a = 0; a < 2; ++a)
#pragma unroll
            for (int b = 0; b < 2; ++b)
#pragma unroll
                for (int m = 0; m < 4; ++m)
#pragma unroll
                    for (int n = 0; n < 2; ++n) acc[a][b][m][n] = (f32x4){0.f, 0.f, 0.f, 0.f};
        cur = nxt; cA = nA; cB = nB; ++ui;
        if constexpr (ALIGN_EPI) { if (wr == 1) PG8_BAR; }
    }
    PG8_WAIT_V(0);
    if constexpr (!ALIGN_EPI) { if (wr == 0) PG8_BAR; }
    PG8_BAR;
    if constexpr (Epi::AFTER_DRAIN) { E.fused(acc, cur, wr, wc, fr, fq, lds, wid, lane); S.done(cur); }
#undef PG8_SA
#undef PG8_SB
#undef PG8_STAGE
#undef PG8_LDA
#undef PG8_LDB
#undef PG8_MMA
#undef PG8_WAIT_V
#undef PG8_WAIT_L
#undef PG8_BAR
#undef PG8_SCHED
}
}
#define GAS __attribute__((address_space(1)))
#define LAS __attribute__((address_space(3)))
typedef unsigned short bf16;
typedef unsigned v4u __attribute__((ext_vector_type(4)));
typedef float f32x4 __attribute__((ext_vector_type(4)));
typedef short bf16x8 __attribute__((ext_vector_type(8)));
typedef GAS unsigned gu32;
typedef GAS unsigned long long gu64;
#define RLX_AGENT __ATOMIC_RELAXED, __HIP_MEMORY_SCOPE_AGENT
#define LDS_WAIT() asm volatile("s_waitcnt lgkmcnt(0)" ::: "memory")
#define VM_WAIT() asm volatile("s_waitcnt vmcnt(0)" ::: "memory")
__device__ __forceinline__ unsigned long long rt() { return __builtin_amdgcn_s_memrealtime(); }
__device__ __forceinline__ unsigned f2bf(float f) { unsigned u = __builtin_bit_cast(unsigned, f); return (u + 0x7fffu + ((u >> 16) & 1u)) >> 16; }
__device__ __forceinline__ unsigned pk2(float lo, float hi) { return f2bf(lo) | (f2bf(hi) << 16); }
#define XB_TMO      128
#define XB_XCNT(j)  (256  + 64 * (j))
#define XB_XSUB(j)  (1280 + 64 * (j))
#define XB_XGEN(j)  (2304 + 64 * (j))
#define XB_TOP      3328
#define XB_TOPGEN   3392
#define XCD_BAR_WORDS 3456
#define XB_SPIN_CAP (1u << 18)

__device__ __forceinline__ unsigned xb_ld(unsigned* p)              { return __hip_atomic_load(p, __ATOMIC_RELAXED, __HIP_MEMORY_SCOPE_AGENT); }
__device__ __forceinline__ unsigned xb_add(unsigned* p, unsigned v) { return __hip_atomic_fetch_add(p, v, __ATOMIC_RELAXED, __HIP_MEMORY_SCOPE_AGENT); }
__device__ __forceinline__ unsigned xb_xcc_id() { return (unsigned)__builtin_amdgcn_s_getreg((3 << 11) | 20) & 0xFu; }
#define XB_SPIN(cond, bar) do { unsigned _sp = 0; while (cond) { __builtin_amdgcn_s_sleep(1); \
    if ((++_sp & 255u) == 0u) { if (xb_ld(&(bar)[XB_TMO])) break; if (_sp > XB_SPIN_CAP) { atomicAdd(&(bar)[XB_TMO], 1u); break; } } } } while (0)

struct XcdBarrier {
    unsigned* bar; unsigned x;
    volatile LAS unsigned* st;
};

__device__ __forceinline__ XcdBarrier xcd_barrier_post(unsigned* bar, volatile LAS unsigned* st) {
    XcdBarrier b; b.bar = bar; b.x = xb_xcc_id(); b.st = st;
    if (threadIdx.x == 0) (void)xb_add(&bar[XB_XCNT(b.x)], 1u);
    return b;
}
__device__ __forceinline__ void xcd_barrier_complete(unsigned* bar, unsigned x, unsigned& nloc, unsigned& nx) {
    const unsigned G = gridDim.x * gridDim.y * gridDim.z;
    unsigned sum, cnt, mine, sp = 0u;
    for (;;) {
        sum = 0u; cnt = 0u; mine = 0u;
#pragma unroll
        for (unsigned j = 0; j < 16; ++j) { const unsigned c = xb_ld(&bar[XB_XCNT(j)]); sum += c; cnt += (c > 0u) ? 1u : 0u; mine = (j == x) ? c : mine; }
        if (sum == G) break;
        __builtin_amdgcn_s_sleep(1);
        if ((++sp & 255u) == 0u) { if (xb_ld(&bar[XB_TMO])) break; if (sp > XB_SPIN_CAP) { atomicAdd(&bar[XB_TMO], 1u); break; } }
    }
    nloc = mine > 0u ? mine : 1u; nx = cnt > 0u ? cnt : 1u;
}

__device__ __forceinline__ void xcd_barrier(const XcdBarrier& b) {
    asm volatile("s_waitcnt vmcnt(0)" ::: "memory");
    __syncthreads();
    if (threadIdx.x == 0) {
        unsigned* bar = b.bar;
        __builtin_amdgcn_s_waitcnt(0);
        unsigned nloc = b.st[0], nx = b.st[1];
        if (nloc == 0u) { xcd_barrier_complete(bar, b.x, nloc, nx); b.st[0] = nloc; b.st[1] = nx; }
        const unsigned old = xb_add(&bar[XB_XSUB(b.x)], 1u);
        const unsigned gen = old / nloc;
        if (old + 1u == (gen + 1u) * nloc) {
            __builtin_amdgcn_fence(__ATOMIC_RELEASE, "agent");
            asm volatile("s_waitcnt vmcnt(0)" ::: "memory");
            const unsigned og = xb_add(&bar[XB_TOP], 1u);
            const unsigned tg = og / nx;
            if (og + 1u == (tg + 1u) * nx) xb_add(&bar[XB_TOPGEN], 1u);
            else XB_SPIN(xb_ld(&bar[XB_TOPGEN]) == tg, bar);
            __builtin_amdgcn_fence(__ATOMIC_ACQUIRE, "agent");
            xb_add(&bar[XB_XGEN(b.x)], 1u);
            asm volatile("s_waitcnt vmcnt(0)" ::: "memory");
        } else {
            XB_SPIN(xb_ld(&bar[XB_XGEN(b.x)]) == gen, bar);
            __builtin_amdgcn_fence(__ATOMIC_ACQUIRE, "agent");
            asm volatile("s_waitcnt vmcnt(0)" ::: "memory");
        }
    }
    __syncthreads();
}

namespace att {
struct ProbeT { unsigned long long acc, last; int state; };
#ifdef PROBE_SUB
#define ATT_MARK(k) do { const unsigned long long now_ = __builtin_amdgcn_s_memrealtime(); if (PT.state == PROBE_SUB) PT.acc += now_ - PT.last; PT.last = now_; PT.state = (k); } while (0)
#define ATT_PROBE_PARAM , ProbeT& PT
#else
#define ATT_MARK(k) do { } while (0)
#define ATT_PROBE_PARAM
#endif
typedef unsigned short bf16_t;
using bf16x8 = __attribute__((ext_vector_type(8))) short;
using s16x4  = __attribute__((ext_vector_type(4))) short;
using f32x16 = __attribute__((ext_vector_type(16))) float;
using u32x4  = __attribute__((ext_vector_type(4))) unsigned;
constexpr int NW = 8, QBLK = 32, KVBLK = 64;
constexpr int VBUF = KVBLK * 128 * 2;
#define ATT_SBAR() __builtin_amdgcn_sched_barrier(0)
__device__ __forceinline__ int crow(int r, int hi) { return (r & 3) + 8 * (r >> 2) + 4 * hi; }
__device__ __forceinline__ unsigned cvtpk(float lo, float hi) { unsigned r; asm volatile("v_cvt_pk_bf16_f32 %0, %1, %2" : "=v"(r) : "v"(lo), "v"(hi)); return r; }
template <int DQ> __device__ __forceinline__ int kswz(int row, int colB) { return row * (DQ * 2) + (colB ^ ((row & 7) << 4)); }

__device__ __forceinline__ void partialSM(f32x16& p0, f32x16& p1, float& m_reg, float& mn, float& alpha, const float C, const float thr, const float rs = 1.f) {
  float pmax = p0[0];
#pragma unroll
  for (int r = 1; r < 16; ++r) pmax = fmaxf(pmax, p0[r]);
#pragma unroll
  for (int r = 0; r < 16; ++r) pmax = fmaxf(pmax, p1[r]);
  { auto rr = __builtin_amdgcn_permlane32_swap(__float_as_uint(pmax), __float_as_uint(pmax), false, false);
    pmax = fmaxf(__uint_as_float(rr[0]), __uint_as_float(rr[1])) * rs; }
  if (__builtin_expect(__all(pmax - m_reg <= thr), 1)) { mn = m_reg; alpha = 1.f; }
  else { mn = fmaxf(m_reg, pmax); alpha = __builtin_amdgcn_exp2f((m_reg - mn) * C); m_reg = mn; }
  const float mnC = -mn * C, Cl = C * rs;
#pragma unroll
  for (int r = 0; r < 16; ++r) p0[r] = fmaf(p0[r], Cl, mnC);
#pragma unroll
  for (int r = 0; r < 16; ++r) p1[r] = fmaf(p1[r], Cl, mnC);
#pragma unroll
  for (int r = 0; r < 16; ++r) p0[r] = __builtin_amdgcn_exp2f(p0[r]);
}
__device__ __forceinline__ void finishSM(f32x16& p0, f32x16& p1, float alpha, float& l_reg, bf16x8& pa0, bf16x8& pa1, bf16x8& pa2, bf16x8& pa3) {
#pragma unroll
  for (int r = 0; r < 16; ++r) p1[r] = __builtin_amdgcn_exp2f(p1[r]);
  float ps = 0;
#pragma unroll
  for (int r = 0; r < 16; ++r) ps += p0[r];
#pragma unroll
  for (int r = 0; r < 16; ++r) ps += p1[r];
  { auto rr = __builtin_amdgcn_permlane32_swap(__float_as_uint(ps), __float_as_uint(ps), false, false);
    ps = __uint_as_float(rr[0]) + __uint_as_float(rr[1]); }
  l_reg = l_reg * alpha + ps;
#define ATT_PK4(P, BASE, OUT) do { unsigned a0 = cvtpk(P[BASE + 0], P[BASE + 1]), a1 = cvtpk(P[BASE + 2], P[BASE + 3]);   \
    unsigned b0 = cvtpk(P[BASE + 4], P[BASE + 5]), b1 = cvtpk(P[BASE + 6], P[BASE + 7]);                              \
    auto r0 = __builtin_amdgcn_permlane32_swap(a0, b0, false, false); auto r1 = __builtin_amdgcn_permlane32_swap(a1, b1, false, false); \
    u32x4 w = {r0[0], r1[0], r0[1], r1[1]}; OUT = *reinterpret_cast<bf16x8*>(&w); } while (0)
  ATT_PK4(p0, 0, pa0); ATT_PK4(p0, 8, pa1); ATT_PK4(p1, 0, pa2); ATT_PK4(p1, 8, pa3);
#undef ATT_PK4
}
template <int OFF> __device__ __forceinline__ bf16x8 lds_rd128(unsigned addr) { bf16x8 r; asm volatile("ds_read_b128 %0, %1 offset:%2" : "=&v"(r) : "v"(addr), "i"(OFF) : "memory"); return r; }
template <int N> __device__ __forceinline__ void lgkm_wait() { static_assert(N == 0 || N == 2 || N == 4 || N == 6, "count"); if constexpr (N == 0) asm volatile("s_waitcnt lgkmcnt(0)" ::: "memory"); else if constexpr (N == 2) asm volatile("s_waitcnt lgkmcnt(2)" ::: "memory"); else if constexpr (N == 4) asm volatile("s_waitcnt lgkmcnt(4)" ::: "memory"); else asm volatile("s_waitcnt lgkmcnt(6)" ::: "memory"); }
template <int GS, int G, int S = 0> struct QktLoad {
  static __device__ __forceinline__ void run(unsigned kb, bf16x8 (&f0)[2][GS], bf16x8 (&f1)[2][GS]) {
    f0[G & 1][S] = lds_rd128<(G * GS + S) * 2048>(kb); f1[G & 1][S] = lds_rd128<(G * GS + S) * 2048 + 512>(kb);
    if constexpr (S + 1 < GS) QktLoad<GS, G, S + 1>::run(kb, f0, f1);
  }
};
template <int DQ, int GS, int G = 0> struct QktStep {
  static __device__ __forceinline__ void run(f32x16& p0, f32x16& p1, unsigned kb, const bf16x8* qr, bf16x8 (&f0)[2][GS], bf16x8 (&f1)[2][GS]) {
    constexpr int NG = DQ / 16 / GS;
    if constexpr (G + 1 < NG) { QktLoad<GS, G + 1>::run(kb, f0, f1); lgkm_wait<2 * GS>(); } else lgkm_wait<0>();
    ATT_SBAR();
#pragma unroll
    for (int s_ = 0; s_ < GS; ++s_) { p0 = __builtin_amdgcn_mfma_f32_32x32x16_bf16(f0[G & 1][s_], qr[G * GS + s_], p0, 0, 0, 0); p1 = __builtin_amdgcn_mfma_f32_32x32x16_bf16(f1[G & 1][s_], qr[G * GS + s_], p1, 0, 0, 0); }
    ATT_SBAR();
    if constexpr (G + 1 < NG) QktStep<DQ, GS, G + 1>::run(p0, p1, kb, qr, f0, f1);
  }
};
template <int DQ, int GS> __device__ __forceinline__ void qkt(f32x16& p0, f32x16& p1, const char* Ks, const bf16x8* qr, int r32, int hi) {
  static_assert((DQ / 16) % GS == 0 && GS >= 1 && GS <= 3, "group size");
  p0 = f32x16{}; p1 = f32x16{};
  const unsigned kb = (unsigned)(uintptr_t)Ks + (unsigned)(hi * 1024 + r32 * 16);
  bf16x8 f0[2][GS], f1[2][GS];
  QktLoad<GS, 0>::run(kb, f0, f1);
  QktStep<DQ, GS, 0>::run(p0, p1, kb, qr, f0, f1);
}
__device__ __forceinline__ int v_st(int k, int c) { const int kk = (k & ~0xC) | ((k & 4) << 1) | ((k & 8) >> 1); return ((kk >> 3) * 4 + (c >> 5)) * 512 + ((kk & 7) * 32 + (c & 31)) * 2; }
__device__ __forceinline__ int v_rd_base(int lane) { return ((lane & 3) << 3) | (((lane >> 2) & 3) << 6) | (((lane >> 4) & 1) << 5) | (((lane >> 5) & 1) << 8); }
constexpr int v_rd_off(int d0, int ks, int half) { return d0 * 512 + ks * 4096 + half * 2048; }
template <int OFF> __device__ __forceinline__ s16x4 tr_read(int vb) {
  s16x4 r; asm volatile("ds_read_b64_tr_b16 %0, %1 offset:%2" : "=&v"(r) : "v"(vb), "i"(OFF) : "memory"); return r;
}
template <int HB> __device__ __forceinline__ void pv_rd(s16x4 (&s)[4], int vb) {
  constexpr int D0 = HB >> 1, K0 = 2 * (HB & 1);
  s[0] = tr_read<v_rd_off(D0, K0, 0)>(vb); s[1] = tr_read<v_rd_off(D0, K0, 1)>(vb); s[2] = tr_read<v_rd_off(D0, K0 + 1, 0)>(vb); s[3] = tr_read<v_rd_off(D0, K0 + 1, 1)>(vb);
}
__device__ __forceinline__ void pv_mm(f32x16& od, const s16x4 (&s)[4], bf16x8 pa, bf16x8 pb) {
#define ATT_PK(L, H) (bf16x8){L[0], L[1], L[2], L[3], H[0], H[1], H[2], H[3]}
  od = __builtin_amdgcn_mfma_f32_32x32x16_bf16(pa, ATT_PK(s[0], s[1]), od, 0, 0, 0);
  od = __builtin_amdgcn_mfma_f32_32x32x16_bf16(pb, ATT_PK(s[2], s[3]), od, 0, 0, 0);
#undef ATT_PK
}
template <int H> __device__ __forceinline__ void pv_half(f32x16* o, int vb, bf16x8 pa0, bf16x8 pa1, bf16x8 pa2, bf16x8 pa3) {
  s16x4 s0[4], s1[4], s2[4];
#define ATT_W8() asm volatile("s_waitcnt lgkmcnt(8)" ::: "memory")
#define ATT_W4() asm volatile("s_waitcnt lgkmcnt(4)" ::: "memory")
#define ATT_W0() asm volatile("s_waitcnt lgkmcnt(0)" ::: "memory")
  pv_rd<4 * H + 0>(s0, vb); pv_rd<4 * H + 1>(s1, vb);
  pv_rd<4 * H + 2>(s2, vb); ATT_W8(); ATT_SBAR(); pv_mm(o[2 * H], s0, pa0, pa1); ATT_SBAR();
  pv_rd<4 * H + 3>(s0, vb); ATT_W8(); ATT_SBAR(); pv_mm(o[2 * H], s1, pa2, pa3); ATT_SBAR();
  ATT_W4(); ATT_SBAR(); pv_mm(o[2 * H + 1], s2, pa0, pa1); ATT_SBAR();
  ATT_W0(); ATT_SBAR(); pv_mm(o[2 * H + 1], s0, pa2, pa3); ATT_SBAR();
#undef ATT_W8
#undef ATT_W4
#undef ATT_W0
}

struct AUnit {
  const bf16_t* q; bf16_t* o; const bf16_t *k0, *v0, *k1, *v1;
  int ldq, ldo, ldk0, ldv0, ldk1, ldv1, n0, ntiles; float scale;
  int r0, kr_lo; const float* rpb;
  const float* qsq;
};
constexpr int TBL_FLOATS = 15 * 128;
constexpr int NBUF = 3;
template <int DQ> constexpr int attn_lds_bytes() { return NBUF * VBUF + NBUF * KVBLK * DQ * 2 + NW * 64 * 4 + TBL_FLOATS * 4; }

template <int DQ, bool NAT>
__device__ __forceinline__ void attn_unit(const AUnit& U, char* lds, const int wid_in ATT_PROBE_PARAM) {
  constexpr int KB = KVBLK * DQ * 2, NKC = DQ / 64, CPR = DQ / 8;
  ATT_MARK(0);
  const int tid = wid_in * 64 + lane_id_fresh(), wid = wid_in, lane = tid & 63, r32 = lane & 31, hi = lane >> 5;
  char* V_lds = lds; char* K_lds = lds + NBUF * VBUF;
  float* ws = (float*)(lds + NBUF * VBUF + NBUF * KB) + wid * 64; float* li_l = ws; float* al_l = ws + 32;
  float* tbl = (float*)(lds + NBUF * VBUF + NBUF * KB + NW * 64 * 4);
  const float C = U.scale * 1.4426950408889634f, thr = 8.f / U.scale;
  if constexpr (NAT) {
    const float inv = 1.0f / U.scale;
    for (int idx = tid; idx < TBL_FLOATS; idx += 512) { const int ro = idx >> 7, d = (idx & 127) - 48; tbl[idx] = (d >= 0 && d <= 30) ? U.rpb[ro * 31 + d] * inv : 0.f; }
  }
  float m_reg = -1e30f, l_reg = 0.f; f32x16 o[4] = {}; bf16x8 qr[DQ / 16];
  const bf16_t* Qw = U.q + (long)(wid * QBLK + r32) * U.ldq + hi * 8;
#pragma unroll
  for (int d0 = 0; d0 < DQ / 16; ++d0) qr[d0] = *reinterpret_cast<const bf16x8*>(Qw + d0 * 16);
  float qrs = 1.f;
  if (U.qsq) { typedef float f32x2v __attribute__((ext_vector_type(2))); const float* sp = U.qsq + (long)(wid * QBLK + r32) * 96;
    const f32x2v a = *(const f32x2v*)sp, b = *(const f32x2v*)(sp + 2), c = *(const f32x2v*)(sp + 4); qrs = __builtin_amdgcn_rsqf(((a[0] + a[1]) + (b[0] + b[1]) + (c[0] + c[1])) * (1.0f / 192.0f) + 1e-6f); }
  const int sr = tid >> 4, sc = (tid & 15) * 8, vst0 = v_st(sr, sc), vst1 = v_st(32 + sr, sc);
  const int vb0 = (int)(uintptr_t)V_lds + v_rd_base(lane);
  bf16x8 st[NKC], sv[2];
#define ATT_TILE(j) const int j_ = (j); const bool f_ = j_ < U.n0; const int jj_ = f_ ? j_ : j_ - U.n0; const int ldk_ = f_ ? U.ldk0 : U.ldk1, ldv_ = f_ ? U.ldv0 : U.ldv1; \
    const bf16_t* kp_ = (f_ ? U.k0 : U.k1) + (long)jj_ * KVBLK * ldk_; const bf16_t* vp_ = (f_ ? U.v0 : U.v1) + (long)jj_ * KVBLK * ldv_; (void)kp_; (void)vp_; (void)ldk_; (void)ldv_
#define ATT_KLOAD_TO(dst, j) do { ATT_TILE(j); _Pragma("unroll") for (int i_ = 0; i_ < NKC; ++i_) { const int c_ = tid + 512 * i_, kr_ = c_ & 63, kc_ = c_ >> 6; dst[i_] = *reinterpret_cast<const bf16x8*>(kp_ + (long)kr_ * ldk_ + kc_ * 8); } } while (0)
#define ATT_KLOAD(j) ATT_KLOAD_TO(st, j)
#define ATT_KWRITE_FROM(src, b) do { _Pragma("unroll") for (int i_ = 0; i_ < NKC; ++i_) { const int c_ = tid + 512 * i_; *(bf16x8*)(K_lds + (b) * KB + c_ * 16) = src[i_]; } } while (0)
#define ATT_KWRITE(b) ATT_KWRITE_FROM(st, b)
#define ATT_VLOAD_TO(dst, j) do { ATT_TILE(j); dst[0] = *reinterpret_cast<const bf16x8*>(vp_ + (long)sr * ldv_ + sc); dst[1] = *reinterpret_cast<const bf16x8*>(vp_ + (long)(32 + sr) * ldv_ + sc); } while (0)
#define ATT_VLOAD(j) ATT_VLOAD_TO(sv, j)
#define ATT_VWRITE_FROM(src, b) do { *(bf16x8*)(V_lds + (b) * VBUF + vst0) = src[0]; *(bf16x8*)(V_lds + (b) * VBUF + vst1) = src[1]; } while (0)
#define ATT_VWRITE(b) ATT_VWRITE_FROM(sv, b)
#define ATT_BAR() do { asm volatile("s_waitcnt lgkmcnt(0)" ::: "memory"); __builtin_amdgcn_s_barrier(); asm volatile("" ::: "memory"); } while (0)
  const int NT = U.ntiles;
  const int R = U.r0 + (wid >> 1), rs = min(max(R - 4, 0), 24), qc = (wid & 1) * 32 + r32, cs = min(max(qc - 8, 0), 48);
  { bf16x8 k0_[NKC], k1_[NKC], k2_[NKC], v0_[2], v1_[2], v2_[2];
    ATT_KLOAD_TO(k0_, 0); ATT_VLOAD_TO(v0_, 0); ATT_KLOAD_TO(k1_, 1); ATT_VLOAD_TO(v1_, 1);
    if (2 < NT) { ATT_KLOAD_TO(k2_, 2); ATT_VLOAD_TO(v2_, 2); }
    if (3 < NT) { ATT_KLOAD(3); ATT_VLOAD(3); }
    ATT_KWRITE_FROM(k0_, 0); ATT_VWRITE_FROM(v0_, 0); ATT_KWRITE_FROM(k1_, 1); ATT_VWRITE_FROM(v1_, 1);
    if (2 < NT) { ATT_KWRITE_FROM(k2_, 2); ATT_VWRITE_FROM(v2_, 2); } }
  ATT_BAR();
  if (wid >= 4) { ATT_BAR(); __builtin_amdgcn_s_setprio(1); }
  ATT_MARK(1);
  int b = 0, bn = 1, bp = 2;
  bool act_prev = false; bf16x8 pa0, pa1, pa2, pa3; f32x16 p0, p1;
  for (int j = 0; j <= NT; ++j) {
    bool act = j < NT; int kr = 0;
    if constexpr (NAT) { if (j >= U.n0 && j < NT) { kr = U.kr_lo + (j - U.n0); act = (kr >= rs) && (kr <= rs + 7); } }
    if (j >= 2 && j + 1 < NT) { ATT_KWRITE(bn); if (j + 2 < NT) ATT_KLOAD(j + 2); }
    if (act) {
      qkt<DQ, 2>(p0, p1, K_lds + b * KB, qr, r32, hi);
      if constexpr (NAT) { if (j >= U.n0) {
        const int ro = kr - R + 7; const float* tb = tbl + ro * 128 + 63 - qc + 4 * hi; const int t0 = 4 * hi - cs; const float NEG = -INFINITY;
#pragma unroll
        for (int r = 0; r < 16; ++r) { const int kc = (r & 3) + 8 * (r >> 2);
          p0[r] = ((unsigned)(t0 + kc) < 16u) ? p0[r] + tb[kc] : NEG;
          p1[r] = ((unsigned)(t0 + kc + 32) < 16u) ? p1[r] + tb[kc + 32] : NEG; } } }
    }
    if (act_prev) pv_half<1>(o, vb0 + bp * VBUF, pa0, pa1, pa2, pa3);
    if (j == NT) break;
    ATT_MARK(2); ATT_BAR(); ATT_MARK(3);
    if (j >= 2 && j + 1 < NT) { ATT_VWRITE(bn); if (j + 2 < NT) ATT_VLOAD(j + 2); }
    if (act) {
      float mn, alpha;
      partialSM(p0, p1, m_reg, mn, alpha, C, thr, qrs);
      if (__any(alpha < 1.f)) { if (hi == 0) al_l[r32] = alpha; asm volatile("s_waitcnt lgkmcnt(0)" ::: "memory");
#pragma unroll
        for (int d = 0; d < 4; ++d)
#pragma unroll
          for (int r = 0; r < 16; ++r) o[d][r] *= al_l[crow(r, hi)]; }
      finishSM(p0, p1, alpha, l_reg, pa0, pa1, pa2, pa3); ATT_SBAR();
      pv_half<0>(o, vb0 + b * VBUF, pa0, pa1, pa2, pa3);
    }
    ATT_MARK(4); ATT_BAR(); ATT_MARK(1);
    act_prev = act; bp = b; b = bn; bn = (bn == NBUF - 1) ? 0 : bn + 1;
  }
  ATT_MARK(5);
  ATT_BAR();
  if (wid < 4) ATT_BAR();
  __builtin_amdgcn_s_setprio(0);
  if (hi == 0) li_l[r32] = l_reg; asm volatile("s_waitcnt lgkmcnt(0)" ::: "memory");
  float rli[16];
#pragma unroll
  for (int r = 0; r < 16; ++r) rli[r] = __builtin_amdgcn_rcpf(li_l[crow(r, hi)]);
  bf16_t* Ow = U.o + (long)(wid * QBLK) * U.ldo;
#pragma unroll
  for (int r = 0; r < 16; ++r) { const int orow = crow(r, hi);
#pragma unroll
    for (int d0 = 0; d0 < 4; ++d0) { const float v = o[d0][r] * rli[r]; unsigned u = __float_as_uint(v); u = (u + 0x7fffu + ((u >> 16) & 1u)) >> 16; Ow[(long)orow * U.ldo + d0 * 32 + r32] = (bf16_t)u; } }
  ATT_MARK(6);
#undef ATT_TILE
#undef ATT_KLOAD
#undef ATT_KWRITE
#undef ATT_VLOAD
#undef ATT_VWRITE
#undef ATT_KLOAD_TO
#undef ATT_KWRITE_FROM
#undef ATT_VLOAD_TO
#undef ATT_VWRITE_FROM
#undef ATT_BAR
}
}

constexpr int D = 2048, NTOK = 16384, NCTX = 8192, DEPTH = 4;
constexpr int IN_AB = 6144, DFF = 5632, NDOWN = 832, NDOWN_P = 1024, QL = 512, KVL = 256, ROPE_D = 64;
constexpr int NKVROWS = NTOK + 1024;
constexpr float EPS = 1e-6f;
constexpr int NWAVES = 8;
constexpr size_t O_X = 0, O_NATK = (size_t)NTOK * D, O_NATV = O_NATK + 16777216, O_CKV = O_NATV + 16777216, O_KR = O_CKV + 4194304, O_END = O_KR + 1048576;
constexpr size_t MiB = 1u << 20;
constexpr size_t WS_CTL = 0, CTL_ZERO_BYTES = 1 * MiB;
constexpr size_t WS_MOD = 1 * MiB;
constexpr size_t WS_W = 2 * MiB;
constexpr size_t SZ_FFN_IN = (size_t)2 * DFF * D * 2, SZ_FFN_OUT = (size_t)D * DFF * 2, SZ_IN_AB = (size_t)IN_AB * D * 2, SZ_DD = (size_t)D * D * 2;
constexpr size_t SZ_DOWN = (size_t)NDOWN_P * D * 2, SZ_UQ = (size_t)3072 * QL * 2, SZ_UKV = (size_t)4096 * KVL * 2;
constexpr size_t W_FFN_IN = WS_W, W_FFN_OUT = W_FFN_IN + 4 * SZ_FFN_IN, W_IN_AB = W_FFN_OUT + 4 * SZ_FFN_OUT, W_OUT_AB = W_IN_AB + 2 * SZ_IN_AB;
constexpr size_t W_DOWN = W_OUT_AB + 2 * SZ_DD, W_UQ = W_DOWN + 2 * SZ_DOWN, W_UKV = W_UQ + 2 * SZ_UQ, W_O = W_UKV + 2 * SZ_UKV, W_END = W_O + 2 * SZ_DD;
constexpr size_t WS_H = 384 * MiB;
constexpr size_t WS_C = WS_H + 64 * MiB;
constexpr size_t WS_SM = WS_C + 64 * MiB;
constexpr size_t SZ_CKVN = 9 * MiB, SZ_KR = 5 * MiB, SZ_KRSQ = 128 * 1024;
constexpr size_t SM_CQN = WS_SM, SM_CKVN = SM_CQN + (size_t)NTOK * QL * 2, SM_KR = SM_CKVN + 2 * SZ_CKVN, SM_CK = SM_KR + 2 * SZ_KR, SM_CV = SM_CK + 4 * MiB, SM_KRSQ = SM_CV + 4 * MiB, SM_CQP = SM_KRSQ + 1 * MiB, SM_QSQ = SM_CQP + 1 * MiB, SM_END = SM_QSQ + 7 * MiB;
static_assert((size_t)NKVROWS * KVL * 2 <= SZ_CKVN && (size_t)NKVROWS * 64 * 4 <= SZ_KR && (size_t)NKVROWS * 4 <= SZ_KRSQ && (size_t)NTOK * 8 * 4 <= 1 * MiB, "latent buffers");
constexpr size_t WS_BIG = WS_SM + 64 * MiB;
constexpr size_t B_P = WS_BIG;
constexpr size_t B_L = WS_BIG, B_QC = B_L + 64 * MiB, B_KV = B_QC + 96 * MiB, B_KN = B_KV + 136 * MiB;
constexpr size_t WS_CS = WS_MOD + 983040;
constexpr size_t B_F = WS_BIG;
constexpr size_t WS_X16 = WS_BIG + 512 * MiB;
constexpr size_t WS_END = WS_X16 + 64 * MiB;
static_assert(W_END <= WS_H && SM_END <= WS_BIG && B_KN + (size_t)NKVROWS * 3072 * 2 <= WS_X16 && B_F + (size_t)NTOK * DFF * 2 <= WS_END, "d_ws map");
constexpr int CW_BAR = 4096;
constexpr int RING_BYTES = 131072, LDSCTL_OFF = RING_BYTES, LDS_BYTES = 147456;

typedef unsigned short bf16;
typedef float f32x2 __attribute__((ext_vector_type(2)));
typedef unsigned u32x2 __attribute__((ext_vector_type(2)));
typedef _Float16 h16x4 __attribute__((ext_vector_type(4)));

__device__ __forceinline__ float wave_sum(float v) {
    v += __int_as_float(__builtin_amdgcn_ds_swizzle(__float_as_int(v), 0x041F));
    v += __int_as_float(__builtin_amdgcn_ds_swizzle(__float_as_int(v), 0x081F));
    v += __int_as_float(__builtin_amdgcn_ds_swizzle(__float_as_int(v), 0x101F));
    v += __int_as_float(__builtin_amdgcn_ds_swizzle(__float_as_int(v), 0x201F));
    v += __int_as_float(__builtin_amdgcn_ds_swizzle(__float_as_int(v), 0x401F));
    const auto b = __builtin_amdgcn_permlane32_swap(__float_as_uint(v), __float_as_uint(v), false, false);
    return __uint_as_float(b[0]) + __uint_as_float(b[1]);
}
__device__ __forceinline__ float bf2f(unsigned short b) { return __uint_as_float(((unsigned)b) << 16); }
__device__ __forceinline__ float bflo(unsigned w) { return __uint_as_float(w << 16); }
__device__ __forceinline__ float bfhi(unsigned w) { return __uint_as_float(w & 0xffff0000u); }

struct Frame {
    LAS unsigned char* lds; char* ldsg;
    int tid, lane, wave, G, vcu, gw, NGW;
    GAS float* out; GAS unsigned char* ws; int l;
};
__device__ __forceinline__ const float* kin(int k) { asm volatile("" : "+s"(k)); return (const float*)((GAS const float* const __attribute__((address_space(4)))*)__builtin_amdgcn_kernarg_segment_ptr())[k]; }

__device__ __forceinline__ bool fresh(Frame& F) {
    F.lane = lane_id_fresh(); F.tid = F.wave * 64 + F.lane;
    { GAS unsigned char* w = F.ws; GAS float* o = F.out; int l = F.l; asm volatile("" : "+s"(w), "+s"(o), "+s"(l)); F.ws = w; F.out = o; F.l = l; }
    return true;
}
__device__ __forceinline__ void p0_transpose_item(const float* W, int K, int N, bf16* WT, int k0, int n0, int drow0, LAS float* scr, int lane, const float* ksc) {
    { const int r = lane >> 3, n4 = (lane & 7) * 4; f32x4 w[8];
#pragma unroll
      for (int i = 0; i < 8; ++i) w[i] = *(const f32x4*)(W + (size_t)(k0 + r + 8 * i) * N + n0 + n4);
#pragma unroll
      for (int i = 0; i < 8; ++i) { LAS float* d = scr + (r + 8 * i) * 33 + n4; d[0] = w[i][0]; d[1] = w[i][1]; d[2] = w[i][2]; d[3] = w[i][3]; } }
    LDS_WAIT(); asm volatile("" ::: "memory");
    const int c = lane & 7;
    f32x4 sa = {1.f, 1.f, 1.f, 1.f}, sb = {1.f, 1.f, 1.f, 1.f};
    if (ksc) { sa = *(const f32x4*)(ksc + k0 + 8 * c); sb = *(const f32x4*)(ksc + k0 + 8 * c + 4); }
#pragma unroll
    for (int j = 0; j < 4; ++j) { const int n = (lane >> 3) + 8 * j; const LAS float* s = scr + (8 * c) * 33 + n;
        v4u o; o.x = pk2(s[0 * 33] * sa[0], s[1 * 33] * sa[1]); o.y = pk2(s[2 * 33] * sa[2], s[3 * 33] * sa[3]); o.z = pk2(s[4 * 33] * sb[0], s[5 * 33] * sb[1]); o.w = pk2(s[6 * 33] * sb[2], s[7 * 33] * sb[3]);
        *(GAS v4u*)(WT + (size_t)(drow0 + n) * K + k0 + 8 * c) = o; }
    LDS_WAIT(); asm volatile("" ::: "memory");
}
__device__ __forceinline__ void p0_do_matrix(const float* W, int K, int N, bf16* WT, int item, int ffn_map, LAS float* scr, int lane, const float* ksc = nullptr) {
    const int nblk = N / 32, kb = item / nblk, nb = item % nblk, k0 = 64 * kb, n0 = 32 * nb;
    int drow0 = n0;
    if (ffn_map == 1) { const int up = n0 >= DFF ? 1 : 0, j = n0 - up * DFF; drow0 = (j >> 7) * 256 + up * 128 + (j & 127); }
    if (ffn_map == 2) { drow0 = (n0 / 192) * 256 + (n0 % 192); }
    p0_transpose_item(W, K, N, WT, k0, n0, drow0, scr, lane, ksc);
}
__device__ __forceinline__ void phase_prologue(Frame& F) {
    {
        LAS float* sil = (LAS float*)F.lds;
        LAS float* red = sil + 5 * 2048;
        const float* c = kin(6); const float* cctx = kin(7);
        for (int i = F.tid; i < 5 * 2048; i += 512) { const int cc = i >> 11, k = i & 2047; const float x = cc == 0 ? cctx[k] : c[(cc - 1) * 2048 + k]; sil[i] = x / (1.0f + __expf(-x)); }
        __syncthreads();
        const float* w_ada = kin(10); const float* b_ada = kin(11); float* mod = (float*)(F.ws + WS_MOD);
        for (int task = F.vcu; task < 4 * 192; task += F.G) {
            const int l = task / 192, n = (task % 192) * 64 + F.lane;
            const float* wp = w_ada + ((size_t)l * 2048 + F.wave * 256) * 12288 + n;
            float a0 = 0.f, a1 = 0.f, a2 = 0.f, a3 = 0.f, a4 = 0.f;
            for (int k = 0; k < 256; k += 16) {
                float w[16];
#pragma unroll
                for (int u = 0; u < 16; ++u) w[u] = wp[(size_t)(k + u) * 12288];
#pragma unroll
                for (int u = 0; u < 16; ++u) { const int kk = F.wave * 256 + k + u; a0 += sil[kk] * w[u]; a1 += sil[2048 + kk] * w[u]; a2 += sil[4096 + kk] * w[u]; a3 += sil[6144 + kk] * w[u]; a4 += sil[8192 + kk] * w[u]; }
            }
            red[(F.wave * 5 + 0) * 64 + F.lane] = a0; red[(F.wave * 5 + 1) * 64 + F.lane] = a1; red[(F.wave * 5 + 2) * 64 + F.lane] = a2; red[(F.wave * 5 + 3) * 64 + F.lane] = a3; red[(F.wave * 5 + 4) * 64 + F.lane] = a4;
            __syncthreads();
            if (F.tid < 320) { const int cc = F.tid >> 6, ln = F.tid & 63; float s = 0.f;
#pragma unroll
                for (int w8 = 0; w8 < 8; ++w8) s += red[(w8 * 5 + cc) * 64 + ln];
                const int nn = (task % 192) * 64 + ln; mod[((size_t)l * 5 + cc) * 12288 + nn] = s + b_ada[(size_t)l * 12288 + nn]; }
            __syncthreads();
        }
    }
    {
        LAS float* scr = (LAS float*)(F.lds + F.wave * 16384);
        constexpr int I_FI = 32 * 352, I_FO = 88 * 64, I_IA = 32 * 192, I_DD = 32 * 64, I_DN = 32 * 26, I_UQ = 8 * 96, I_UK = 4 * 128;
        constexpr int NITEMS = 4 * I_FI + 4 * I_FO + 2 * I_IA + 2 * I_DD + 2 * I_DN + 2 * I_UQ + 2 * I_UK + 2 * I_DD;
        unsigned char* ws = (unsigned char*)F.ws;
        for (int it = F.gw; it < NITEMS; it += F.NGW) {
            int r = it;
            if (r < 4 * I_FI) { const int l = r / I_FI; p0_do_matrix(kin(26) + (size_t)l * D * 2 * DFF, D, 2 * DFF, (bf16*)(ws + W_FFN_IN + l * SZ_FFN_IN), r % I_FI, 1, scr, F.lane); continue; } r -= 4 * I_FI;
            if (r < 4 * I_FO) { const int l = r / I_FO; p0_do_matrix(kin(27) + (size_t)l * DFF * D, DFF, D, (bf16*)(ws + W_FFN_OUT + l * SZ_FFN_OUT), r % I_FO, 0, scr, F.lane); continue; } r -= 4 * I_FO;
            if (r < 2 * I_IA) { const int l = r / I_IA; p0_do_matrix(kin(12) + (size_t)l * D * IN_AB, D, IN_AB, (bf16*)(ws + W_IN_AB + l * SZ_IN_AB), r % I_IA, 0, scr, F.lane); continue; } r -= 2 * I_IA;
            if (r < 2 * I_DD) { const int l = r / I_DD; p0_do_matrix(kin(17) + (size_t)l * D * D, D, D, (bf16*)(ws + W_OUT_AB + l * SZ_DD), r % I_DD, 0, scr, F.lane); continue; } r -= 2 * I_DD;
            if (r < 2 * I_DN) { const int l = r / I_DN; p0_do_matrix(kin(18) + (size_t)l * D * NDOWN, D, NDOWN, (bf16*)(ws + W_DOWN + l * SZ_DOWN), r % I_DN, 0, scr, F.lane); continue; } r -= 2 * I_DN;
            if (r < 2 * I_UQ) { const int l = r / I_UQ; p0_do_matrix(kin(21) + (size_t)l * QL * 3072, QL, 3072, (bf16*)(ws + W_UQ + l * SZ_UQ), r % I_UQ, 0, scr, F.lane, kin(19) + l * QL); continue; } r -= 2 * I_UQ;
            if (r < 2 * I_UK) { const int l = r / I_UK; p0_do_matrix(kin(22) + (size_t)l * KVL * 4096, KVL, 4096, (bf16*)(ws + W_UKV + l * SZ_UKV), r % I_UK, 0, scr, F.lane); continue; } r -= 2 * I_UK;
            { const int l = r / I_DD; p0_do_matrix(kin(25) + (size_t)l * D * D, D, D, (bf16*)(ws + W_O + l * SZ_DD), r % I_DD, 0, scr, F.lane); }
        }
        const int gt = F.vcu * 512 + F.tid, NT = F.G * 512;
        for (int i = gt; i < 2 * (NDOWN_P - NDOWN) * D / 8; i += NT) { const int l = i / ((NDOWN_P - NDOWN) * D / 8), e = i % ((NDOWN_P - NDOWN) * D / 8);
            *(v4u*)(ws + W_DOWN + l * SZ_DOWN + (size_t)NDOWN * D * 2 + (size_t)e * 16) = (v4u){0u, 0u, 0u, 0u}; }
        if (gt < 1024) { const int pos = gt >> 4, j = gt & 15; const float ang = (float)pos * exp2f(-(float)j * (13.287712379549449f / 16.0f));
            ((float*)(ws + WS_CS))[gt] = __cosf(ang); ((float*)(ws + WS_CS))[1024 + gt] = __sinf(ang); }
        for (int rr = F.gw; rr < 2 * 1024; rr += F.NGW) { const int i = rr >> 10, cr = rr & 1023, b = cr >> 8, t = cr & 255; const size_t row = (size_t)NTOK + cr;
            const f32x4 y = *(const f32x4*)(kin(4) + (((size_t)b * 2 + i) * 256 + t) * 256 + F.lane * 4);
            u32x2 w; w.x = pk2(y[0], y[1]); w.y = pk2(y[2], y[3]); *(u32x2*)((bf16*)(ws + SM_CKVN + i * SZ_CKVN) + row * KVL + F.lane * 4) = w;
            const float krv = kin(5)[(((size_t)b * 2 + i) * 256 + t) * 64 + F.lane];
            ((float*)(ws + SM_KR + i * SZ_KR))[row * 64 + F.lane] = krv * (kin(24) + i * 192)[128 + F.lane];
            const float q2 = wave_sum(krv * krv); if (F.lane == 0) ((float*)(ws + SM_KRSQ + i * SZ_KRSQ))[row] = q2; }
        const float* ck = kin(2); const float* cv = kin(3);
        for (int i = gt; i < 2 * 262144; i += NT) { const bool isk = i < 262144; const int e = isk ? i : i - 262144; const float* s = (isk ? ck : cv) + (size_t)e * 8;
            const f32x4 a = *(const f32x4*)s, b = *(const f32x4*)(s + 4); v4u o; o.x = pk2(a[0], a[1]); o.y = pk2(a[2], a[3]); o.z = pk2(b[0], b[1]); o.w = pk2(b[2], b[3]);
            *(v4u*)(ws + (isk ? SM_CK : SM_CV) + (size_t)e * 16) = o; }
    }
}

#ifndef MOD_ROWS
#define MOD_ROWS 4
#endif
__device__ __forceinline__ void phase_mod(Frame& F, const float* xc32, const float* xs32, _Float16* X16, const float* g, const float* mod_l, int chunk, bf16* Hb) {
    for (int rb = F.gw; rb < NTOK / 8; rb += F.NGW) {
        const int row0 = rb * 8, cond = row0 < NCTX ? 0 : 1 + ((row0 - NCTX) >> 11);
        const float* sh = mod_l + (size_t)cond * 12288 + chunk * 2048; const float* scl = sh + 2048;
        f32x4 a[8], b[8];
#pragma unroll
        for (int j = 0; j < 8; ++j) { const int c = 4 * (64 * j + F.lane); const f32x4 gv = *(const f32x4*)(g + c), sv = *(const f32x4*)(scl + c); a[j] = gv * (sv + 1.0f); b[j] = *(const f32x4*)(sh + c); }
        if (xc32) {
            for (int rr = 0; rr < 8; rr += 2) {
                f32x4 v[2][8];
#pragma unroll
                for (int q = 0; q < 2; ++q) { const int row = row0 + rr + q; const float* xr = (row < NCTX ? xc32 : xs32) + (size_t)row * D;
#pragma unroll
                    for (int j = 0; j < 8; ++j) v[q][j] = *(const f32x4*)(xr + 4 * (64 * j + F.lane)); }
#pragma unroll
                for (int q = 0; q < 2; ++q) {
                    const int row = row0 + rr + q; _Float16* xh = X16 + (size_t)row * D; float ss = 0.f;
#pragma unroll
                    for (int j = 0; j < 8; ++j) { const h16x4 hv = __builtin_convertvector(v[q][j], h16x4); *(h16x4*)(xh + 4 * (64 * j + F.lane)) = hv; v[q][j] = __builtin_convertvector(hv, f32x4); }
#pragma unroll
                    for (int j = 0; j < 8; ++j) ss += (v[q][j][0] * v[q][j][0] + v[q][j][1] * v[q][j][1]) + (v[q][j][2] * v[q][j][2] + v[q][j][3] * v[q][j][3]);
                    const float rstd = 1.0f / sqrtf(wave_sum(ss) * (1.0f / D) + EPS);
                    bf16* orow = Hb + (size_t)row * D;
#pragma unroll
                    for (int j = 0; j < 8; ++j) { const f32x4 y = v[q][j] * rstd * a[j] + b[j]; u32x2 w; w.x = pk2(y[0], y[1]); w.y = pk2(y[2], y[3]); *(u32x2*)(orow + 4 * (64 * j + F.lane)) = w; }
                }
            }
        } else {
            for (int rr = 0; rr < 8; rr += MOD_ROWS) {
                h16x4 xr[MOD_ROWS][8];
#pragma unroll
                for (int q = 0; q < MOD_ROWS; ++q) { const _Float16* xh = X16 + (size_t)(row0 + rr + q) * D;
#pragma unroll
                    for (int j = 0; j < 8; ++j) xr[q][j] = *(const h16x4*)(xh + 4 * (64 * j + F.lane)); }
#pragma unroll
                for (int q = 0; q < MOD_ROWS; ++q) {
                    f32x4 v[8]; float ss = 0.f;
#pragma unroll
                    for (int j = 0; j < 8; ++j) { v[j] = __builtin_convertvector(xr[q][j], f32x4); ss += (v[j][0] * v[j][0] + v[j][1] * v[j][1]) + (v[j][2] * v[j][2] + v[j][3] * v[j][3]); }
                    const float rstd = 1.0f / sqrtf(wave_sum(ss) * (1.0f / D) + EPS);
                    bf16* orow = Hb + (size_t)(row0 + rr + q) * D;
#pragma unroll
                    for (int j = 0; j < 8; ++j) { const f32x4 y = v[j] * rstd * a[j] + b[j]; u32x2 w; w.x = pk2(y[0], y[1]); w.y = pk2(y[2], y[3]); *(u32x2*)(orow + 4 * (64 * j + F.lane)) = w; }
                }
            }
        }
    }
}

__device__ __forceinline__ void phase_even_conv(Frame& F, int i, const bf16* P, bf16* Cb) {
    const float* cw = kin(16) + (size_t)i * 3 * 1024;
    const int gt = F.vcu * 512 + F.tid, NT = F.G * 512;
    for (int idx = gt; idx < (NTOK / 8) * 128; idx += NT) {
        const int row0 = (idx >> 7) * 8, c = (idx & 127) * 8;
        int t0, L; if (row0 < NCTX) { t0 = row0 & 255; L = 256; } else { t0 = (row0 - NCTX) & 2047; L = 2048; }
        const bf16* pr = P + (size_t)row0 * IN_AB;
        v4u gcv[10], uv[10], gbv[8];
#pragma unroll
        for (int r = 0; r < 10; ++r) { const int tt = t0 + r - 1; const bool ok = tt >= 0 && tt < L; const bf16* p2 = pr + (ptrdiff_t)(r - 1) * IN_AB;
            gcv[r] = ok ? *(const v4u*)(p2 + 4096 + c) : (v4u){0u, 0u, 0u, 0u}; uv[r] = ok ? *(const v4u*)(p2 + 5120 + c) : (v4u){0u, 0u, 0u, 0u}; }
#pragma unroll
        for (int r = 0; r < 8; ++r) gbv[r] = *(const v4u*)(pr + (size_t)r * IN_AB + 3072 + c);
        f32x4 w[3][2];
#pragma unroll
        for (int j = 0; j < 3; ++j) { w[j][0] = *(const f32x4*)(cw + j * 1024 + c); w[j][1] = *(const f32x4*)(cw + j * 1024 + c + 4); }
        f32x4 pa[3][2];
#define CONV_PROD(dst, r) do { const v4u g_ = gcv[r], u_ = uv[r]; dst[0] = (f32x4){bflo(g_.x) * bflo(u_.x), bfhi(g_.x) * bfhi(u_.x), bflo(g_.y) * bflo(u_.y), bfhi(g_.y) * bfhi(u_.y)}; \
            dst[1] = (f32x4){bflo(g_.z) * bflo(u_.z), bfhi(g_.z) * bfhi(u_.z), bflo(g_.w) * bflo(u_.w), bfhi(g_.w) * bfhi(u_.w)}; } while (0)
        CONV_PROD(pa[0], 0); CONV_PROD(pa[1], 1);
#pragma unroll
        for (int r = 0; r < 8; ++r) {
            CONV_PROD(pa[(r + 2) % 3], r + 2);
            const f32x4 a0 = w[0][0] * pa[r % 3][0] + w[1][0] * pa[(r + 1) % 3][0] + w[2][0] * pa[(r + 2) % 3][0];
            const f32x4 a1 = w[0][1] * pa[r % 3][1] + w[1][1] * pa[(r + 1) % 3][1] + w[2][1] * pa[(r + 2) % 3][1];
            const v4u gb = gbv[r];
            v4u o; o.x = pk2(bflo(gb.x) * a0[0], bfhi(gb.x) * a0[1]); o.y = pk2(bflo(gb.y) * a0[2], bfhi(gb.y) * a0[3]); o.z = pk2(bflo(gb.z) * a1[0], bfhi(gb.z) * a1[1]); o.w = pk2(bflo(gb.w) * a1[2], bfhi(gb.w) * a1[3]);
            *(v4u*)(Cb + (size_t)(row0 + r) * D + 1024 + c) = o;
        }
#undef CONV_PROD
    }
}

#ifdef PROBE_SUB
#define PT_ARG , PT
#define PT_PARAM , att::ProbeT& PT
#else
#define PT_ARG
#define PT_PARAM
#endif
__device__ __forceinline__ void phase_even_attn(Frame& F, int i, const bf16* P, bf16* Cb PT_PARAM) {
    const bf16* CK = (const bf16*)(F.ws + SM_CK); const bf16* CV = (const bf16*)(F.ws + SM_CV);
    for (int u = F.vcu; u < 512; u += F.G) {
        att::AUnit U;
        U.scale = 0.08838834764831845f; U.ldq = IN_AB; U.ldo = D; U.r0 = 0; U.kr_lo = 0; U.rpb = nullptr; U.qsq = nullptr;
        if (u < 256) {
            const int b = u >> 3, h = u & 7; const size_t r0 = (size_t)b * 256;
            U.q = P + r0 * IN_AB + h * 128; U.o = Cb + r0 * D + h * 128;
            U.k0 = P + r0 * IN_AB + 1024 + h * 128; U.v0 = P + r0 * IN_AB + 2048 + h * 128; U.ldk0 = IN_AB; U.ldv0 = IN_AB; U.n0 = 4; U.ntiles = 4;
            U.k1 = U.k0; U.v1 = U.v0; U.ldk1 = IN_AB; U.ldv1 = IN_AB;
            att::attn_unit<128, false>(U, F.ldsg, F.wave PT_ARG);
        } else {
            const int n = u - 256, b = n >> 6, h = (n >> 3) & 7, rb = n & 7, r0 = 4 * rb;
            const size_t row0 = (size_t)NCTX + (size_t)b * 2048 + (size_t)r0 * 64;
            U.q = P + row0 * IN_AB + h * 128; U.o = Cb + row0 * D + h * 128;
            const size_t coff = ((((size_t)b * 2 + i) * 8 + h) * 256) * 128;
            U.k0 = CK + coff; U.v0 = CV + coff; U.ldk0 = 128; U.ldv0 = 128; U.n0 = 4;
            const int kr_lo = min(max(r0 - 4, 0), 24), kr_hi = min(max(r0 - 1, 0), 24) + 7;
            const size_t krow0 = (size_t)NCTX + (size_t)b * 2048 + (size_t)kr_lo * 64;
            U.k1 = P + krow0 * IN_AB + 1024 + h * 128; U.v1 = P + krow0 * IN_AB + 2048 + h * 128; U.ldk1 = IN_AB; U.ldv1 = IN_AB;
            U.ntiles = 4 + (kr_hi - kr_lo + 1); U.r0 = r0; U.kr_lo = kr_lo; U.rpb = kin(15) + ((size_t)i * 8 + h) * 15 * 31;
            att::attn_unit<128, true>(U, F.ldsg, F.wave PT_ARG);
        }
    }
}
#ifndef PROBE_NT
#define PROBE_NT 36
#endif
__device__ __forceinline__ void phase_odd_attn(Frame& F, const bf16* Qn, const bf16* Kn, const bf16* Vn, bf16* Ob, int probe PT_PARAM) {
    for (int u = F.vcu; u < 1024; u += F.G) {
        att::AUnit U;
        U.scale = 0.07216878364870323f; U.ldq = 3072; U.ldo = D; U.r0 = 0; U.kr_lo = 0; U.rpb = nullptr;
        U.ldk0 = 3072; U.ldv0 = 2048; U.ldk1 = 3072; U.ldv1 = 2048;
        if (u < 512) {
            const int b = u >> 4, h = u & 15; const size_t r0 = (size_t)b * 256;
            U.q = Qn + r0 * 3072 + h * 192; U.o = Ob + r0 * D + h * 128; U.qsq = (const float*)(F.ws + SM_QSQ) + r0 * 96 + 6 * h;
            U.k0 = Kn + r0 * 3072 + h * 192; U.v0 = Vn + r0 * 2048 + h * 128; U.n0 = 4; U.ntiles = 4; U.k1 = U.k0; U.v1 = U.v0;
        } else {
            const int n = u - 512, b = n >> 7, h = (n >> 3) & 15, qb = n & 7;
            const size_t row0 = (size_t)NCTX + (size_t)b * 2048 + (size_t)qb * 256, kc0 = (size_t)NTOK + (size_t)b * 256, kl0 = (size_t)NCTX + (size_t)b * 2048;
            U.q = Qn + row0 * 3072 + h * 192; U.o = Ob + row0 * D + h * 128; U.qsq = (const float*)(F.ws + SM_QSQ) + row0 * 96 + 6 * h;
            U.k0 = Kn + kc0 * 3072 + h * 192; U.v0 = Vn + kc0 * 2048 + h * 128; U.n0 = 4;
            U.k1 = Kn + kl0 * 3072 + h * 192; U.v1 = Vn + kl0 * 2048 + h * 128; U.ntiles = probe ? PROBE_NT : 36;
        }
        att::attn_unit<192, false>(U, F.ldsg, F.wave PT_ARG);
    }
}

struct Args { const float* in[28]; float* out; unsigned char* ws; int ph_lo, ph_hi; };
constexpr int PH_END = 1 + DEPTH * 10;
__host__ __device__ constexpr int pid(int l, int s) { return 1 + l * 10 + s; }

__global__ void __launch_bounds__(NWAVES * 64, 2) fwd_kernel(Args args) {
    extern __shared__ __attribute__((aligned(16))) unsigned char lds[];
    Frame F;
    F.lds = (LAS unsigned char*)lds; F.ldsg = (char*)lds;
    F.tid = threadIdx.x; F.lane = F.tid & 63; F.wave = __builtin_amdgcn_readfirstlane(F.tid >> 6);
    F.G = gridDim.x; { const int bx = blockIdx.x; F.vcu = (F.G % 8 == 0) ? (bx % 8) * (F.G / 8) + bx / 8 : bx; }
    F.gw = F.vcu * NWAVES + F.wave; F.NGW = F.G * NWAVES;
    F.out = (GAS float*)args.out; F.ws = (GAS unsigned char*)args.ws; F.l = 0;
    unsigned char* ws = args.ws;
    for (int u = F.tid; u < (LDS_BYTES - LDSCTL_OFF) / 4; u += NWAVES * 64) ((LAS unsigned*)(F.lds + LDSCTL_OFF))[u] = 0u;
    __syncthreads();
    const int lo = args.ph_lo, hi = args.ph_hi;
    XcdBarrier bar; bar.bar = (unsigned*)(ws + WS_CTL) + CW_BAR; bar.x = 0; bar.st = nullptr;
    if (hi - lo > 1) bar = xcd_barrier_post((unsigned*)(ws + WS_CTL) + CW_BAR, (volatile LAS unsigned*)(F.lds + LDSCTL_OFF) + 8);
#ifndef PH_MASK
#define PH_MASK 0xFFFF
#endif
#define EN(k) ((PH_MASK >> (k)) & 1)
#ifndef REP_MASK
#define REP_MASK 0
#endif
#define REPS(k) for (int rep_ = 0; rep_ < 1 + ((REP_MASK >> (k)) & 1); ++rep_)
#define RUN(p) (lo <= (p) && (p) < hi && fresh(F))
#ifdef PROBE_SUB
    att::ProbeT PT; PT.acc = 0; PT.last = 0; PT.state = -1;
#ifdef PROBE_SUB_EVEN
#define PT_ARG_E , PT
#else
#define PT_ARG_E , PTdummy
    att::ProbeT PTdummy; PTdummy.acc = 0; PTdummy.last = 0; PTdummy.state = -1;
#endif
#else
#define PT_ARG_E
#endif
#ifdef PROBE_SLOT
#ifndef PROBE_MULT
#define PROBE_MULT 4
#endif
    unsigned long long t_last_ = rt(), t_acc_ = 0;
#define STAMP(p) do { const unsigned long long now_ = rt(); const int s_ = (p) == 0 ? 99 : (((p) - 1) % 10) + 10 * ((((p) - 1) / 10) & 1); if (s_ == PROBE_SLOT || (PROBE_SLOT >= 100 && (s_ % 10) == (PROBE_SLOT - 100) && s_ != 99)) t_acc_ += now_ - t_last_; t_last_ = now_; } while (0)
#else
#define STAMP(p) do { } while (0)
#endif
#define SEAM(p) do { if ((p) + 1 < hi) xcd_barrier(bar); STAMP(p); } while (0)

#define WSP (F.ws)
#define XP ((float*)(F.out + O_X))
#define MODL ((const float*)(WSP + WS_MOD) + (size_t)F.l * 5 * 12288)
#define HB ((bf16*)(WSP + WS_H))
#define CB ((bf16*)(WSP + WS_C))
#define FB ((bf16*)(WSP + B_F))
#define X16P ((_Float16*)(WSP + WS_X16))

#define REDP ((PG8_LAS float*)(F.lds + LDSCTL_OFF + 1024))

    REPS(0) if (EN(0) && RUN(0)) { phase_prologue(F); SEAM(0); }

    for (int l = 0; l < DEPTH; ++l) {
        F.l = l;
        if (EN(1) && RUN(pid(l, 0))) {
            const float* xc = F.l == 0 ? kin(0) : (const float*)nullptr; const float* xs = F.l == 0 ? kin(1) - (size_t)NCTX * D : (const float*)nullptr;
            phase_mod(F, xc, xs, X16P, kin(8) + (size_t)F.l * D, MODL, 0, HB); SEAM(pid(l, 0)); }
        if ((l & 1) == 0) {
            REPS(2) if (EN(2) && RUN(pid(l, 1))) {
                const int i = F.l >> 1; bf16* P = (bf16*)(WSP + B_P);
                pg8::Gemm g{HB, (const bf16*)(WSP + W_IN_AB + i * SZ_IN_AB), NTOK, IN_AB, D}; pg8::StaticOrder S; S.init(NTOK, IN_AB, F.G, (int)blockIdx.x);
                pg8::EpiInAB E{P, kin(13) + i * 128, kin(14) + i * 128, (float*)(F.out + O_NATK + (size_t)i * 8 * 32768), (float*)(F.out + O_NATV + (size_t)i * 8 * 32768), REDP};
                pg8::gemm_phase<pg8::EpiInAB, pg8::StaticOrder, true, true>(F.lds, g, S, E, F.wave);
                SEAM(pid(l, 1));
            }
            REPS(4) if (EN(4) && RUN(pid(l, 5))) { const int i = F.l >> 1; bf16* P = (bf16*)(WSP + B_P); phase_even_attn(F, i, P, CB PT_ARG_E); fresh(F); phase_even_conv(F, i, P, CB); SEAM(pid(l, 5)); }
        } else {
            REPS(5) if (EN(5) && RUN(pid(l, 1))) {
                const int i = F.l >> 1;
                pg8::Gemm g{HB, (const bf16*)(WSP + W_DOWN + i * SZ_DOWN), NTOK, NDOWN_P, D}; pg8::StaticOrder S; S.init(NTOK, NDOWN_P, F.G, (int)blockIdx.x);
                pg8::EpiDown E{(bf16*)(WSP + SM_CQN), (float*)(WSP + SM_CQP), (bf16*)(WSP + SM_CKVN + i * SZ_CKVN), kin(20) + i * KVL, (float*)(F.out + O_CKV + (size_t)i * 65536), (float*)(F.out + O_KR + (size_t)i * 16384),
                               kin(24) + i * 192 + 128, (float*)(WSP + SM_KR + i * SZ_KR), (float*)(WSP + SM_KRSQ + i * SZ_KRSQ), REDP};
                pg8::gemm_phase<pg8::EpiDown, pg8::StaticOrder, true, true>(F.lds, g, S, E, F.wave);
                SEAM(pid(l, 1));
            }
            REPS(7) if (EN(7) && RUN(pid(l, 3))) {
                { const int i = F.l >> 1;
                  pg8::Gemm g{(const bf16*)(WSP + SM_CQN), (const bf16*)(WSP + W_UQ + i * SZ_UQ), NTOK, 3072, QL}; pg8::StaticOrder S; S.init(NTOK, 3072, F.G, (int)blockIdx.x);
                  pg8::EpiUQ E{(bf16*)(WSP + B_QC), kin(23) + i * 192, (const float*)(WSP + SM_CQP), (float*)(WSP + SM_QSQ)};
#ifndef NO_UQ
                  pg8::gemm_phase<pg8::EpiUQ, pg8::StaticOrder, true, true>(F.lds, g, S, E, F.wave);
#endif
                }
                fresh(F);
                { const int i = F.l >> 1;
                  pg8::Gemm g{(const bf16*)(WSP + SM_CKVN + i * SZ_CKVN), (const bf16*)(WSP + W_UKV + i * SZ_UKV), NKVROWS, 4096, KVL}; pg8::StaticOrder S; S.init(NKVROWS, 4096, F.G, (int)blockIdx.x);
                  pg8::EpiUKV E{(bf16*)(WSP + B_KN), (bf16*)(WSP + B_KV), kin(24) + i * 192, (const float*)(WSP + SM_KR + i * SZ_KR), (const float*)(WSP + SM_KRSQ + i * SZ_KRSQ), REDP};
#ifndef NO_UKV
                  pg8::gemm_phase<pg8::EpiUKV, pg8::StaticOrder, true, true>(F.lds, g, S, E, F.wave);
#endif
                }
                SEAM(pid(l, 3));
            }
            REPS(9) if (EN(9) && RUN(pid(l, 5))) { phase_odd_attn(F, (const bf16*)(WSP + B_QC), (const bf16*)(WSP + B_KN), (const bf16*)(WSP + B_KV), rep_ == 0 ? CB : (bf16*)(WSP + WS_BIG + 420 * MiB), rep_ PT_ARG); SEAM(pid(l, 5)); }
        }
        REPS(10) if (EN(10) && RUN(pid(l, 6))) {
            const int i = F.l >> 1;
            const bf16* Wt = (F.l & 1) ? (const bf16*)(WSP + W_O + i * SZ_DD) : (const bf16*)(WSP + W_OUT_AB + i * SZ_DD);
            pg8::Gemm g{CB, Wt, NTOK, D, D}; pg8::StaticOrder S; S.init(NTOK, D, F.G, (int)blockIdx.x);
            pg8::EpiYX E{rep_ == 0 ? X16P : (_Float16*)(WSP + WS_BIG + 320 * MiB), MODL + 2 * 2048};
            pg8::gemm_phase<pg8::EpiYX, pg8::StaticOrder, true, true>(F.lds, g, S, E, F.wave);
            SEAM(pid(l, 6));
        }
        REPS(11) if (EN(11) && RUN(pid(l, 7))) {
            phase_mod(F, (const float*)nullptr, (const float*)nullptr, X16P, kin(9) + (size_t)F.l * D, MODL, 3, HB); SEAM(pid(l, 7)); }
        REPS(12) if (EN(12) && RUN(pid(l, 8))) {
            pg8::Gemm g{HB, (const bf16*)(WSP + W_FFN_IN + F.l * SZ_FFN_IN), NTOK, 2 * DFF, D}; pg8::StaticOrder S; S.init(NTOK, 2 * DFF, F.G, (int)blockIdx.x);
            pg8::EpiSwiGLU E{FB, DFF};
            pg8::gemm_phase<pg8::EpiSwiGLU, pg8::StaticOrder, true, true>(F.lds, g, S, E, F.wave);
            SEAM(pid(l, 8));
        }
        if (EN(13) && RUN(pid(l, 9))) {
            pg8::Gemm g{FB, (const bf16*)(WSP + W_FFN_OUT + F.l * SZ_FFN_OUT), NTOK, D, DFF}; pg8::StaticOrder S; S.init(NTOK, D, F.G, (int)blockIdx.x);
            if (F.l == DEPTH - 1) { pg8::EpiRes E{X16P, XP, MODL + 5 * 2048};
                pg8::gemm_phase<pg8::EpiRes, pg8::StaticOrder, true, true>(F.lds, g, S, E, F.wave); }
            else { pg8::EpiYX E{X16P, MODL + 5 * 2048};
                pg8::gemm_phase<pg8::EpiYX, pg8::StaticOrder, true, true>(F.lds, g, S, E, F.wave); }
            SEAM(pid(l, 9));
        }
    }
#ifdef PROBE_SUB
    if (blockIdx.x == 0) { const unsigned long long t0_ = rt(); while (rt() - t0_ < 4ull * PT.acc) __builtin_amdgcn_s_sleep(8); }
#endif
#ifdef PROBE_SLOT
    if (blockIdx.x == 0) { const unsigned long long t0_ = rt(); while (rt() - t0_ < (unsigned long long)PROBE_MULT * t_acc_) __builtin_amdgcn_s_sleep(8); }
#endif
#undef RUN
#undef SEAM
}

#ifndef MK_ONE_LAUNCH
#define MK_ONE_LAUNCH 1
#endif
extern "C" void kernel_launch(void* const* d_in, const int* in_sizes, int n_in, void* d_out, int out_size, void* d_ws, size_t ws_size, hipStream_t stream) {
    static int grid = 0;
    if (grid == 0) {
        if (n_in != 28 || (size_t)out_size != O_END || ws_size < WS_END) { fprintf(stderr, "kernel_launch: unexpected shapes: n_in %d out %d ws %zu (need %zu)\n", n_in, out_size, ws_size, (size_t)WS_END); grid = -1; return; }
        int dev = 0, cus = 0, per_cu = 0;
        if (hipGetDevice(&dev) != hipSuccess || hipDeviceGetAttribute(&cus, hipDeviceAttributeMultiprocessorCount, dev) != hipSuccess) { grid = -1; return; }
        if (hipFuncSetAttribute((const void*)fwd_kernel, hipFuncAttributeMaxDynamicSharedMemorySize, LDS_BYTES) != hipSuccess) { fprintf(stderr, "kernel_launch: hipFuncSetAttribute failed\n"); grid = -1; return; }
        if (hipOccupancyMaxActiveBlocksPerMultiprocessor(&per_cu, (const void*)fwd_kernel, NWAVES * 64, LDS_BYTES) != hipSuccess || per_cu < 1) { fprintf(stderr, "kernel_launch: occupancy query says %d blocks per CU\n", per_cu); }
        (void)hipGetLastError();
        grid = cus;
    }
    if (grid < 0) return;
    (void)in_sizes;
    if (hipMemsetAsync((char*)d_ws + WS_CTL, 0, CTL_ZERO_BYTES, stream) != hipSuccess) { fprintf(stderr, "kernel_launch: memset failed\n"); return; }
    Args a{};
    for (int k = 0; k < 28; ++k) a.in[k] = (const float*)d_in[k];
    a.out = (float*)d_out; a.ws = (unsigned char*)d_ws;
#if MK_ONE_LAUNCH
    a.ph_lo = 0; a.ph_hi = PH_END;
    hipLaunchKernelGGL(fwd_kernel, dim3(grid), dim3(NWAVES * 64), LDS_BYTES, stream, a);
#else
    for (int p = 0; p < PH_END; ++p) {
        if (p > 0) { const int l = (p - 1) / 10, s = (p - 1) % 10; if ((l & 1) == 0 && (s == 2 || s == 3 || s == 4)) continue; if ((l & 1) == 1 && (s == 2 || s == 4)) continue; }
        a.ph_lo = p; a.ph_hi = p + 1;
        hipLaunchKernelGGL(fwd_kernel, dim3(grid), dim3(NWAVES * 64), LDS_BYTES, stream, a);
    }
#endif
    const hipError_t le = hipPeekAtLastError();
    if (le != hipSuccess) fprintf(stderr, "kernel_launch: launch failed: %s\n", hipGetErrorName(le));
}
```

```cpp
#include <hip/hip_runtime.h>
#include <cstdio>
#include <cstdint>
#include <cstddef>
__device__ __forceinline__ int lane_id_fresh() { int l = (int)__builtin_amdgcn_mbcnt_hi(~0u, __builtin_amdgcn_mbcnt_lo(~0u, 0u)); asm volatile("" : "+v"(l)); return l; }
namespace pg8 {
#define PG8_LAS __attribute__((address_space(3)))
typedef unsigned short bf16_t;
typedef short bf16x8 __attribute__((ext_vector_type(8)));
typedef float f32x4 __attribute__((ext_vector_type(4)));
typedef unsigned u32x4 __attribute__((ext_vector_type(4)));
constexpr int BM = 256, BK = 64, HALF = 128, HTB = HALF * BK * 2  , STAGE_BYTES = 8 * HTB, NXCD = 8, WGM = 8;

__host__ __device__ __forceinline__ int lds_byte(int r, int c) { const int st = (r >> 4) * 2 + (c >> 5), rr = r & 15, cc = c & 31, ob = rr * 64 + cc * 2; return st * 1024 + (ob ^ (((ob >> 9) & 1) << 5)); }
__host__ __device__ __forceinline__ void stage_rc(int b, int& R, int& C) { const int st = b / 1024, sb = b % 1024, swz = sb ^ (((sb >> 9) & 1) << 5); R = (st >> 1) * 16 + swz / 64; C = (st & 1) * 32 + (swz % 64) / 2; }
__host__ __device__ __forceinline__ int perm32(int rho) { const int n = rho >> 4, i = rho & 15; return 8 * (i >> 2) + 4 * n + (i & 3); }

struct Unit { int pm, pn; };
struct Gemm { const bf16_t* A; const bf16_t* Bt; int M, N, K; };

struct StaticOrder {
    int nM, nN, nwg, G, c;
    __host__ __device__ void init(int M, int N, int G_, int c_) { nM = M / BM; nN = N / BM; nwg = nM * nN; G = G_; c = c_; }
    __host__ __device__ bool next(int i, Unit& u) const {
        const long L = (long)i * G + c; if (L >= nwg) return false;
        int wgid = (int)L; { const int q = nwg / NXCD, r = nwg % NXCD, xcd = wgid % NXCD, off = wgid / NXCD; wgid = (xcd < r ? xcd * (q + 1) : r * (q + 1) + (xcd - r) * q) + off; }
        const int nig = WGM * nN, gid = wgid / nig, fm = gid * WGM, gsz = (nM - fm) < WGM ? (nM - fm) : WGM;
        u.pm = fm + ((wgid % nig) % gsz); u.pn = (wgid % nig) / gsz; return true;
    }
    __device__ __forceinline__ void a_ready(const Unit&) const {}
    __device__ __forceinline__ void done(const Unit&) const {}
};
__device__ __forceinline__ unsigned cvt_pk_bf16(float lo, float hi) { unsigned r; asm volatile("v_cvt_pk_bf16_f32 %0, %1, %2" : "=v"(r) : "v"(lo), "v"(hi)); return r; }

__device__ __forceinline__ int cond_of_pm(int pm) { return pm < 32 ? 0 : 1 + ((pm - 32) >> 3); }

struct EpiBf16P {
    static constexpr bool PERM = true, AFTER_DRAIN = false;
    bf16_t* O; int ldc;
    __device__ __forceinline__ void operator()(const f32x4 (&acc)[2][2][4][2], const Unit& u, int wr, int wc, int fr_in, int fq_in) const {
        (void)fr_in; (void)fq_in; const int lane_e = lane_id_fresh(), fr = lane_e & 15, fq = lane_e >> 4;
        const int row0 = u.pm * BM + wr * 64 + fr, col0 = u.pn * BM + wc * 32 + 8 * fq;
#pragma unroll
        for (int ai = 0; ai < 2; ++ai)
#pragma unroll
            for (int m = 0; m < 4; ++m) { bf16_t* rowp = O + (unsigned)(row0 + ai * HALF + m * 16) * (unsigned)ldc + col0;
#pragma unroll
                for (int bj = 0; bj < 2; ++bj) { const f32x4 v0 = acc[ai][bj][m][0], v1 = acc[ai][bj][m][1];
                    u32x4 w; w.x = cvt_pk_bf16(v0[0], v0[1]); w.y = cvt_pk_bf16(v0[2], v0[3]); w.z = cvt_pk_bf16(v1[0], v1[1]); w.w = cvt_pk_bf16(v1[2], v1[3]);
                    *(u32x4*)(rowp + bj * HALF) = w; } }
    }
};
struct EpiF32P {
    static constexpr bool PERM = false, AFTER_DRAIN = false;
    float* C; int ldc;
    __device__ __forceinline__ void operator()(const f32x4 (&acc)[2][2][4][2], const Unit& u, int wr, int wc, int fr_in, int fq_in) const {
        (void)fr_in; (void)fq_in; const int lane_e = lane_id_fresh(), fr = lane_e & 15, fq = lane_e >> 4;
        const int row0 = u.pm * BM + wr * 64 + fr, col0 = u.pn * BM + wc * 32 + 4 * fq;
#pragma unroll
        for (int ai = 0; ai < 2; ++ai)
#pragma unroll
            for (int m = 0; m < 4; ++m) { float* rowp = C + (unsigned)(row0 + ai * HALF + m * 16) * (unsigned)ldc + col0;
#pragma unroll
                for (int bj = 0; bj < 2; ++bj)
#pragma unroll
                    for (int n = 0; n < 2; ++n) *(f32x4*)(rowp + bj * HALF + n * 16) = acc[ai][bj][m][n]; }
    }
};
struct EpiRes {
    static constexpr bool PERM = false, AFTER_DRAIN = false;
    const _Float16* base; float* out; const float* gate;
    __device__ __forceinline__ void operator()(const f32x4 (&acc)[2][2][4][2], const Unit& u, int wr, int wc, int fr_in, int fq_in) const {
        typedef _Float16 h16x4 __attribute__((ext_vector_type(4)));
        (void)fr_in; (void)fq_in; const int lane_e = lane_id_fresh(), fr = lane_e & 15, fq = lane_e >> 4;
        const int row0 = u.pm * BM + wr * 64 + fr, col0 = u.pn * BM + wc * 32 + 4 * fq;
        const float* g = gate + (unsigned)cond_of_pm(u.pm) * 12288u + col0;
        f32x4 gv[2][2];
#pragma unroll
        for (int bj = 0; bj < 2; ++bj)
#pragma unroll
            for (int n = 0; n < 2; ++n) gv[bj][n] = *(const f32x4*)(g + bj * HALF + n * 16);
#pragma unroll
        for (int ai = 0; ai < 2; ++ai)
#pragma unroll
            for (int m = 0; m < 4; ++m) { const unsigned off = (unsigned)(row0 + ai * HALF + m * 16) * 2048u + col0;
#pragma unroll
                for (int bj = 0; bj < 2; ++bj)
#pragma unroll
                    for (int n = 0; n < 2; ++n) { const f32x4 bs = __builtin_convertvector(*(const h16x4*)(base + off + bj * HALF + n * 16), f32x4);
                        *(f32x4*)(out + off + bj * HALF + n * 16) = bs + gv[bj][n] * acc[ai][bj][m][n]; }
                if (m & 1) asm volatile("" ::: "memory"); }
    }
};
__device__ __forceinline__ float silu_f(float x) { return x * __builtin_amdgcn_rcpf(1.0f + __builtin_amdgcn_exp2f(-1.4426950408889634f * x)); }
__device__ __forceinline__ f32x4 swiglu4(const f32x4 g, const f32x4 u) {
    const f32x4 t = g * (-1.4426950408889634f);
    f32x4 d; d[0] = __builtin_amdgcn_exp2f(t[0]); d[1] = __builtin_amdgcn_exp2f(t[1]); d[2] = __builtin_amdgcn_exp2f(t[2]); d[3] = __builtin_amdgcn_exp2f(t[3]);
    d = d + 1.0f;
    f32x4 r; r[0] = __builtin_amdgcn_rcpf(d[0]); r[1] = __builtin_amdgcn_rcpf(d[1]); r[2] = __builtin_amdgcn_rcpf(d[2]); r[3] = __builtin_amdgcn_rcpf(d[3]);
    return (g * u) * r;
}
struct EpiSwiGLU {
    static constexpr bool PERM = true, AFTER_DRAIN = false;
    bf16_t* O; int ldc;
    __device__ __forceinline__ void operator()(const f32x4 (&acc)[2][2][4][2], const Unit& u, int wr, int wc, int fr_in, int fq_in) const {
        (void)fr_in; (void)fq_in; const int lane_e = lane_id_fresh(), fr = lane_e & 15, fq = lane_e >> 4;
        const int row0 = u.pm * BM + wr * 64 + fr, col0 = u.pn * HALF + wc * 32 + 8 * fq;
#pragma unroll
        for (int ai = 0; ai < 2; ++ai)
#pragma unroll
            for (int m = 0; m < 4; ++m) { bf16_t* rowp = O + (unsigned)(row0 + ai * HALF + m * 16) * (unsigned)ldc + col0;
                const f32x4 g0 = acc[ai][0][m][0], g1 = acc[ai][0][m][1], u0 = acc[ai][1][m][0], u1 = acc[ai][1][m][1];
                const f32x4 h0 = swiglu4(g0, u0), h1 = swiglu4(g1, u1);
                u32x4 w; w.x = cvt_pk_bf16(h0[0], h0[1]); w.y = cvt_pk_bf16(h0[2], h0[3]); w.z = cvt_pk_bf16(h1[0], h1[1]); w.w = cvt_pk_bf16(h1[2], h1[3]);
                *(u32x4*)rowp = w; }
    }
};

constexpr float NORM_EPS = 1e-6f;
__device__ __forceinline__ float sum_rows4(float s) {
    const auto a = __builtin_amdgcn_permlane16_swap(__float_as_uint(s), __float_as_uint(s), false, false); s = __uint_as_float(a[0]) + __uint_as_float(a[1]);
    const auto b = __builtin_amdgcn_permlane32_swap(__float_as_uint(s), __float_as_uint(s), false, false); return __uint_as_float(b[0]) + __uint_as_float(b[1]);
}
__device__ __forceinline__ float xor32(float y, bool upper) { const auto b = __builtin_amdgcn_permlane32_swap(__float_as_uint(y), __float_as_uint(y), false, false); return __uint_as_float(upper ? b[0] : b[1]); }
__device__ __forceinline__ void row_half_allreduce(float (&ss)[2][4][2], PG8_LAS float* red, int wr, int wc, int fr, int fq) {
#pragma unroll
    for (int ai = 0; ai < 2; ++ai)
#pragma unroll
        for (int m = 0; m < 4; ++m)
#pragma unroll
            for (int bj = 0; bj < 2; ++bj) ss[ai][m][bj] = sum_rows4(ss[ai][m][bj]);
    if (fq == 0) {
#pragma unroll
        for (int ai = 0; ai < 2; ++ai)
#pragma unroll
            for (int m = 0; m < 4; ++m)
#pragma unroll
                for (int bj = 0; bj < 2; ++bj) red[((ai * HALF + wr * 64 + m * 16 + fr) * 2 + bj) * 4 + wc] = ss[ai][m][bj];
    }
    asm volatile("s_waitcnt lgkmcnt(0)" ::: "memory"); __builtin_amdgcn_s_barrier(); asm volatile("" ::: "memory");
}
__device__ __forceinline__ void row_half_read(const PG8_LAS float* red, int ai, int m, int wr, int fr, float& s0, float& s1) {
    const PG8_LAS f32x4* p = (const PG8_LAS f32x4*)(red + (ai * HALF + wr * 64 + m * 16 + fr) * 8);
    const f32x4 a = p[0], b = p[1]; s0 = (a[0] + a[1]) + (a[2] + a[3]); s1 = (b[0] + b[1]) + (b[2] + b[3]);
}
__device__ __forceinline__ float dot4(const f32x4 a) { return (a[0] * a[0] + a[1] * a[1]) + (a[2] * a[2] + a[3] * a[3]); }
__device__ __forceinline__ u32x4 pack8(const f32x4 a, const f32x4 b) { u32x4 w; w.x = cvt_pk_bf16(a[0], a[1]); w.y = cvt_pk_bf16(a[2], a[3]); w.z = cvt_pk_bf16(b[0], b[1]); w.w = cvt_pk_bf16(b[2], b[3]); return w; }

struct EpiInAB {
    static constexpr bool PERM = true, AFTER_DRAIN = false;
    bf16_t* P; const float* gq; const float* gk; float* natk; float* natv; PG8_LAS float* red;
    __device__ __forceinline__ void operator()(const f32x4 (&acc)[2][2][4][2], const Unit& u, int wr, int wc, int fr_in, int fq_in) const {
        (void)fr_in; (void)fq_in; const int lane_e = lane_id_fresh(), fr = lane_e & 15, fq = lane_e >> 4;
        const int row0 = u.pm * BM + wr * 64 + fr, col0 = u.pn * BM + wc * 32 + 8 * fq, dh = wc * 32 + 8 * fq;
        if (u.pn < 8) {
            float ss[2][4][2];
#pragma unroll
            for (int ai = 0; ai < 2; ++ai)
#pragma unroll
                for (int m = 0; m < 4; ++m)
#pragma unroll
                    for (int bj = 0; bj < 2; ++bj) ss[ai][m][bj] = dot4(acc[ai][bj][m][0]) + dot4(acc[ai][bj][m][1]);
            row_half_allreduce(ss, red, wr, wc, fr, fq);
            const float* g = (u.pn < 4 ? gq : gk) + dh; const f32x4 g0 = *(const f32x4*)g, g1 = *(const f32x4*)(g + 4);
            const bool emit = u.pn >= 4 && u.pm < 32;
#pragma unroll
            for (int ai = 0; ai < 2; ++ai)
#pragma unroll
                for (int m = 0; m < 4; ++m) { bf16_t* rowp = P + (unsigned)(row0 + ai * HALF + m * 16) * 6144u + col0;
                    float st[2]; row_half_read(red, ai, m, wr, fr, st[0], st[1]);
#pragma unroll
                    for (int bj = 0; bj < 2; ++bj) { const float rstd = __builtin_amdgcn_rsqf(st[bj] * (1.0f / 128.0f) + NORM_EPS);
                        const f32x4 y0 = acc[ai][bj][m][0] * rstd * g0, y1 = acc[ai][bj][m][1] * rstd * g1;
                        *(u32x4*)(rowp + bj * HALF) = pack8(y0, y1);
                        if (emit) { const int h = (u.pn - 4) * 2 + bj, t = ai * HALF + wr * 64 + m * 16 + fr; float* dst = natk + ((unsigned)(u.pm * 16 + h) * 256u + (unsigned)t) * 128u + dh;
                            *(f32x4*)dst = y0; *(f32x4*)(dst + 4) = y1; } }
                    asm volatile("" ::: "memory"); }
        } else {
            const bool emit = u.pn < 12 && u.pm < 32;
#pragma unroll
            for (int ai = 0; ai < 2; ++ai)
#pragma unroll
                for (int m = 0; m < 4; ++m) { bf16_t* rowp = P + (unsigned)(row0 + ai * HALF + m * 16) * 6144u + col0;
#pragma unroll
                    for (int bj = 0; bj < 2; ++bj) { const f32x4 y0 = acc[ai][bj][m][0], y1 = acc[ai][bj][m][1];
                        *(u32x4*)(rowp + bj * HALF) = pack8(y0, y1);
                        if (emit) { const int h = (u.pn - 8) * 2 + bj, t = ai * HALF + wr * 64 + m * 16 + fr; float* dst = natv + ((unsigned)(u.pm * 16 + h) * 256u + (unsigned)t) * 128u + dh;
                            *(f32x4*)dst = y0; *(f32x4*)(dst + 4) = y1; } } }
        }
    }
};
struct EpiUQ {
    static constexpr bool PERM = true, AFTER_DRAIN = false;
    bf16_t* Qn; const float* gq; const float* CQP; float* QSQ;
    __device__ __forceinline__ void operator()(const f32x4 (&acc)[2][2][4][2], const Unit& u, int wr, int wc, int fr_in, int fq_in) const {
        (void)fr_in; (void)fq_in; const int lane_e = lane_id_fresh(), fr = lane_e & 15, fq = lane_e >> 4;
        const int row0 = u.pm * BM + wr * 64 + fr;
        float rq[2][4];
#pragma unroll
        for (int ai = 0; ai < 2; ++ai)
#pragma unroll
            for (int m = 0; m < 4; ++m) { const float* cp = CQP + (unsigned)(row0 + ai * HALF + m * 16) * 8u; const f32x4 a = *(const f32x4*)cp, b = *(const f32x4*)(cp + 4);
                rq[ai][m] = __builtin_amdgcn_rsqf((((a[0] + a[1]) + (a[2] + a[3])) + ((b[0] + b[1]) + (b[2] + b[3]))) * (1.0f / 512.0f) + NORM_EPS); }
        const bool lat = u.pm >= 32; const int jf = 8 * (fq & 1); const bool isx2 = (fq >> 1) != 0;
        f32x4 fr0, fr1;
#pragma unroll
        for (int e4 = 0; e4 < 4; ++e4) { fr0[e4] = exp2f(-(float)(jf + e4) * (13.287712379549449f / 16.0f)) * 0.15915494309189535f; fr1[e4] = exp2f(-(float)(jf + 4 + e4) * (13.287712379549449f / 16.0f)) * 0.15915494309189535f; }
#pragma unroll
        for (int bj = 0; bj < 2; ++bj) {
            const int blk = 4 * u.pn + 2 * bj + (wc >> 1), hd = blk / 3, part = blk - 3 * hd;
            const int dh = part * 64 + (wc & 1) * 32 + 8 * fq;
            const f32x4 g0 = *(const f32x4*)(gq + dh), g1 = *(const f32x4*)(gq + dh + 4);
            const bool rope = part == 2 && lat;
#pragma unroll
            for (int ai = 0; ai < 2; ++ai)
#pragma unroll
                for (int m = 0; m < 4; ++m) { const unsigned row = (unsigned)(row0 + ai * HALF + m * 16);
                    const f32x4 q0 = acc[ai][bj][m][0] * rq[ai][m], q1 = acc[ai][bj][m][1] * rq[ai][m];
                    const float s = sum_rows4(dot4(q0) + dot4(q1));
                    if (fq == 0) QSQ[row * 96u + 2 * blk + (wc & 1)] = s;
                    f32x4 y0 = q0 * g0, y1 = q1 * g1;
                    if (rope) {
                        const int t = ((int)row - 8192) & 2047; const float pos = (float)((wc & 1) ? (t & 63) : (t >> 6));
                        f32x4 c0, c1, s0, s1, p0, p1;
#pragma unroll
                        for (int e4 = 0; e4 < 4; ++e4) { c0[e4] = __builtin_amdgcn_cosf(pos * fr0[e4]); s0[e4] = __builtin_amdgcn_sinf(pos * fr0[e4]); c1[e4] = __builtin_amdgcn_cosf(pos * fr1[e4]); s1[e4] = __builtin_amdgcn_sinf(pos * fr1[e4]); }
#pragma unroll
                        for (int e4 = 0; e4 < 4; ++e4) { p0[e4] = xor32(y0[e4], isx2); p1[e4] = xor32(y1[e4], isx2); }
                        if (isx2) { y0 = p0 * s0 + y0 * c0; y1 = p1 * s1 + y1 * c1; } else { y0 = y0 * c0 - p0 * s0; y1 = y1 * c1 - p1 * s1; }
                    }
                    *(u32x4*)(Qn + row * 3072u + u.pn * BM + bj * HALF + wc * 32 + 8 * fq) = pack8(y0, y1);
                    asm volatile("" ::: "memory"); }
        }
    }
};
struct EpiUKV {
    static constexpr bool PERM = true, AFTER_DRAIN = false;
    bf16_t* Kn; bf16_t* Vn; const float* gk; const float* RK; const float* KRSQ; PG8_LAS float* red;
    __device__ __forceinline__ void operator()(const f32x4 (&acc)[2][2][4][2], const Unit& u, int wr, int wc, int fr_in, int fq_in) const {
        typedef unsigned u32x2v __attribute__((ext_vector_type(2)));
        (void)fr_in; (void)fq_in; const int lane_e = lane_id_fresh(), fr = lane_e & 15, fq = lane_e >> 4;
        const int row0 = u.pm * BM + wr * 64 + fr, dh = wc * 32 + 8 * fq, kc = wc * 16 + 4 * fq;
        f32x4 rk[2][4]; float ksq[2][4];
#pragma unroll
        for (int ai = 0; ai < 2; ++ai)
#pragma unroll
            for (int m = 0; m < 4; ++m) { const unsigned row = (unsigned)(row0 + ai * HALF + m * 16); rk[ai][m] = *(const f32x4*)(RK + row * 64u + kc); ksq[ai][m] = KRSQ[row]; }
        const f32x4 ga0 = *(const f32x4*)(gk + dh), ga1 = *(const f32x4*)(gk + dh + 4);
        float ss[2][4][2];
#pragma unroll
        for (int ai = 0; ai < 2; ++ai)
#pragma unroll
            for (int m = 0; m < 4; ++m) { ss[ai][m][0] = dot4(acc[ai][0][m][0]) + dot4(acc[ai][0][m][1]); ss[ai][m][1] = 0.f; }
        row_half_allreduce(ss, red, wr, wc, fr, fq);
#pragma unroll
        for (int ai = 0; ai < 2; ++ai)
#pragma unroll
            for (int m = 0; m < 4; ++m) { const unsigned row = (unsigned)(row0 + ai * HALF + m * 16); bf16_t* rowp = Kn + row * 3072u + u.pn * 192;
                float st0, st1; row_half_read(red, ai, m, wr, fr, st0, st1);
                const float rstd = __builtin_amdgcn_rsqf((st0 + ksq[ai][m]) * (1.0f / 192.0f) + NORM_EPS);
                *(u32x4*)(rowp + dh) = pack8(acc[ai][0][m][0] * rstd * ga0, acc[ai][0][m][1] * rstd * ga1);
                *(u32x4*)(Vn + row * 2048u + u.pn * 128 + dh) = pack8(acc[ai][1][m][0], acc[ai][1][m][1]);
                const f32x4 y = rk[ai][m] * rstd; u32x2v w; w.x = cvt_pk_bf16(y[0], y[1]); w.y = cvt_pk_bf16(y[2], y[3]);
                *(u32x2v*)(rowp + 128 + kc) = w; }
    }
};
struct EpiYX {
    static constexpr bool PERM = true, AFTER_DRAIN = false;
    _Float16* X; const float* gate;
    __device__ __forceinline__ void operator()(const f32x4 (&acc)[2][2][4][2], const Unit& u, int wr, int wc, int fr_in, int fq_in) const {
        typedef _Float16 h16x4 __attribute__((ext_vector_type(4)));
        typedef _Float16 h16x8 __attribute__((ext_vector_type(8)));
        (void)fr_in; (void)fq_in; const int lane_e = lane_id_fresh(), fr = lane_e & 15, fq = lane_e >> 4;
        const int row0 = u.pm * BM + wr * 64 + fr, col0 = u.pn * BM + wc * 32 + 8 * fq;
        const float* g = gate + (unsigned)cond_of_pm(u.pm) * 12288u + col0;
        _Float16* xb = X + (unsigned)row0 * 2048u + col0;
        h16x8 xr[2][4][2];
#pragma unroll
        for (int ai = 0; ai < 2; ++ai)
#pragma unroll
            for (int m = 0; m < 4; ++m)
#pragma unroll
                for (int bj = 0; bj < 2; ++bj) xr[ai][m][bj] = *(const h16x8*)(xb + (unsigned)(ai * HALF + m * 16) * 2048u + bj * HALF);
        f32x4 gv[2][2];
#pragma unroll
        for (int bj = 0; bj < 2; ++bj)
#pragma unroll
            for (int n = 0; n < 2; ++n) gv[bj][n] = *(const f32x4*)(g + bj * HALF + n * 4);
        asm volatile("" ::: "memory");
#pragma unroll
        for (int ai = 0; ai < 2; ++ai)
#pragma unroll
            for (int m = 0; m < 4; ++m)
#pragma unroll
                for (int bj = 0; bj < 2; ++bj) {
                    const f32x4 x0 = __builtin_convertvector(__builtin_shufflevector(xr[ai][m][bj], xr[ai][m][bj], 0, 1, 2, 3), f32x4) + acc[ai][bj][m][0] * gv[bj][0];
                    const f32x4 x1 = __builtin_convertvector(__builtin_shufflevector(xr[ai][m][bj], xr[ai][m][bj], 4, 5, 6, 7), f32x4) + acc[ai][bj][m][1] * gv[bj][1];
                    const h16x4 h0 = __builtin_convertvector(x0, h16x4), h1 = __builtin_convertvector(x1, h16x4);
                    *(h16x8*)(xb + (unsigned)(ai * HALF + m * 16) * 2048u + bj * HALF) = __builtin_shufflevector(h0, h1, 0, 1, 2, 3, 4, 5, 6, 7); }
    }
};
struct EpiDown {
    static constexpr bool PERM = true, AFTER_DRAIN = false;
    bf16_t* cqn; float* CQP; bf16_t* ckvn; const float* gckv; float* out_ckv; float* out_kr; const float* gkr; float* RK; float* KRSQ; PG8_LAS float* red;
    __device__ __forceinline__ void operator()(const f32x4 (&acc)[2][2][4][2], const Unit& u, int wr, int wc, int fr_in, int fq_in) const {
        (void)fr_in; (void)fq_in; const int lane_e = lane_id_fresh(), fr = lane_e & 15, fq = lane_e >> 4;
        const int row0 = u.pm * BM + wr * 64 + fr, dh = wc * 32 + 8 * fq;
        if (u.pn < 2) {
#pragma unroll
            for (int ai = 0; ai < 2; ++ai)
#pragma unroll
                for (int m = 0; m < 4; ++m) { const unsigned row = (unsigned)(row0 + ai * HALF + m * 16);
                    float s = (dot4(acc[ai][0][m][0]) + dot4(acc[ai][0][m][1])) + (dot4(acc[ai][1][m][0]) + dot4(acc[ai][1][m][1]));
                    s = sum_rows4(s);
                    if (fq == 0) CQP[row * 8u + u.pn * 4 + wc] = s;
#pragma unroll
                    for (int bj = 0; bj < 2; ++bj) *(u32x4*)(cqn + row * 512u + u.pn * 256 + bj * HALF + dh) = pack8(acc[ai][bj][m][0], acc[ai][bj][m][1]); }
        } else if (u.pn == 2) {
            float ss[2][4][2];
#pragma unroll
            for (int ai = 0; ai < 2; ++ai)
#pragma unroll
                for (int m = 0; m < 4; ++m)
#pragma unroll
                    for (int bj = 0; bj < 2; ++bj) ss[ai][m][bj] = dot4(acc[ai][bj][m][0]) + dot4(acc[ai][bj][m][1]);
            row_half_allreduce(ss, red, wr, wc, fr, fq);
            f32x4 g[2][2];
#pragma unroll
            for (int bj = 0; bj < 2; ++bj) { g[bj][0] = *(const f32x4*)(gckv + bj * HALF + dh); g[bj][1] = *(const f32x4*)(gckv + bj * HALF + dh + 4); }
#pragma unroll
            for (int ai = 0; ai < 2; ++ai)
#pragma unroll
                for (int m = 0; m < 4; ++m) { const unsigned row = (unsigned)(row0 + ai * HALF + m * 16);
                    float st0, st1; row_half_read(red, ai, m, wr, fr, st0, st1);
                    const float rstd = __builtin_amdgcn_rsqf((st0 + st1) * (1.0f / 256.0f) + NORM_EPS);
#pragma unroll
                    for (int bj = 0; bj < 2; ++bj) { const f32x4 y0 = acc[ai][bj][m][0] * rstd * g[bj][0], y1 = acc[ai][bj][m][1] * rstd * g[bj][1];
                        *(u32x4*)(ckvn + row * 256u + bj * HALF + dh) = pack8(y0, y1);
                        if (u.pm < 32) { float* dst = out_ckv + ((unsigned)(u.pm * 2) * 256u + (unsigned)(ai * HALF + wr * 64 + m * 16 + fr)) * 256u + bj * HALF + dh; *(f32x4*)dst = y0; *(f32x4*)(dst + 4) = y1; } }
                    asm volatile("" ::: "memory"); }
        } else {
            const bool mine = wc < 2;
            float ss[2][4][2];
#pragma unroll
            for (int ai = 0; ai < 2; ++ai)
#pragma unroll
                for (int m = 0; m < 4; ++m) { ss[ai][m][0] = mine ? dot4(acc[ai][0][m][0]) + dot4(acc[ai][0][m][1]) : 0.f; ss[ai][m][1] = 0.f; }
            row_half_allreduce(ss, red, wr, wc, fr, fq);
            f32x4 g0 = {0.f, 0.f, 0.f, 0.f}, g1 = {0.f, 0.f, 0.f, 0.f};
            if (mine) { g0 = *(const f32x4*)(gkr + dh); g1 = *(const f32x4*)(gkr + dh + 4); }
            const bool lat = u.pm >= 32; const int jf = 8 * (fq & 1); const bool isx2 = (fq >> 1) != 0;
            f32x4 fr0, fr1;
#pragma unroll
            for (int e4 = 0; e4 < 4; ++e4) { fr0[e4] = exp2f(-(float)(jf + e4) * (13.287712379549449f / 16.0f)) * 0.15915494309189535f; fr1[e4] = exp2f(-(float)(jf + 4 + e4) * (13.287712379549449f / 16.0f)) * 0.15915494309189535f; }
#pragma unroll
            for (int ai = 0; ai < 2; ++ai)
#pragma unroll
                for (int m = 0; m < 4; ++m) { const unsigned row = (unsigned)(row0 + ai * HALF + m * 16);
                    float st0, st1; row_half_read(red, ai, m, wr, fr, st0, st1);
                    if (wc == 0 && fq == 0) KRSQ[row] = st0;
                    const f32x4 k0 = acc[ai][0][m][0], k1 = acc[ai][0][m][1];
                    if (mine && u.pm < 32) { float* dst = out_kr + ((unsigned)(u.pm * 2) * 256u + (unsigned)(ai * HALF + wr * 64 + m * 16 + fr)) * 64u + dh; *(f32x4*)dst = k0; *(f32x4*)(dst + 4) = k1; }
                    f32x4 y0 = k0 * g0, y1 = k1 * g1;
                    if (lat && mine) {
                        const int t = ((int)row - 8192) & 2047; const float pos = (float)(wc ? (t & 63) : (t >> 6));
                        f32x4 c0, c1, s0, s1, p0, p1;
#pragma unroll
                        for (int e4 = 0; e4 < 4; ++e4) { c0[e4] = __builtin_amdgcn_cosf(pos * fr0[e4]); s0[e4] = __builtin_amdgcn_sinf(pos * fr0[e4]); c1[e4] = __builtin_amdgcn_cosf(pos * fr1[e4]); s1[e4] = __builtin_amdgcn_sinf(pos * fr1[e4]); }
#pragma unroll
                        for (int e4 = 0; e4 < 4; ++e4) { p0[e4] = xor32(y0[e4], isx2); p1[e4] = xor32(y1[e4], isx2); }
                        if (isx2) { y0 = p0 * s0 + y0 * c0; y1 = p1 * s1 + y1 * c1; } else { y0 = y0 * c0 - p0 * s0; y1 = y1 * c1 - p1 * s1; }
                    }
                    if (mine) { float* dst = RK + row * 64u + dh; *(f32x4*)dst = y0; *(f32x4*)(dst + 4) = y1; }
                    asm volatile("" ::: "memory"); }
        }
    }
};
template <class Epi, class Sched, bool ALIGN_EPI = false, bool SP2 = false>
__device__ __forceinline__ void gemm_phase(PG8_LAS unsigned char* lds, const Gemm g, const Sched& S, const Epi& E, const int wid_in) {
    const int tid_ = wid_in * 64 + lane_id_fresh();
    const int tid = tid_, wid = wid_in, lane = tid & 63, wr = wid >> 2, wc = wid & 3, fr = lane & 15, fq = lane >> 4;
    int K_ = g.K; asm volatile("" : "+s"(K_));
    const int K = K_, nt = K / BK;
    unsigned voffA[2], voffB[2];
#pragma unroll
    for (int i = 0; i < 2; ++i) { int R, C; stage_rc(tid * 16 + i * 8192, R, C); const int Rb = Epi::PERM ? ((R & ~31) + perm32(R & 31)) : R;
        voffA[i] = (unsigned)(R * K + C) * 2u; voffB[i] = (unsigned)(Rb * K + C) * 2u; }
    const size_t kstep = (size_t)(BK * 2);
    const size_t hstep = (size_t)HALF * K * 2;
    const size_t tstep = 2 * hstep;
    const unsigned ldsw = (unsigned)wid * 1024u;
    const int aoff = lds_byte(wr * 64 + fr, fq * 8), boff = lds_byte(wc * 32 + fr, fq * 8);
#define PG8_SA(b, h) (((b) * 2 + (h)) * HTB)
#define PG8_SB(b, h) ((4 + (b) * 2 + (h)) * HTB)
#define PG8_STAGE(bufoff, gbase, voff) do { _Pragma("unroll") for (int _i = 0; _i < 2; ++_i) \
        __builtin_amdgcn_global_load_lds((const unsigned*)((const char*)(gbase) + (voff)[_i]), (PG8_LAS unsigned*)(lds + (bufoff) + ldsw + _i * 8192), 16, 0, 0); } while (0)
#define PG8_LDA(dst, b, h) do { _Pragma("unroll") for (int m = 0; m < 4; ++m) _Pragma("unroll") for (int k = 0; k < 2; ++k) dst[m][k] = *(const PG8_LAS bf16x8*)(lds + PG8_SA(b, h) + aoff + m * 2048 + k * 1024); } while (0)
#define PG8_LDB(dst, b, h) do { _Pragma("unroll") for (int n = 0; n < 2; ++n) _Pragma("unroll") for (int k = 0; k < 2; ++k) dst[n][k] = *(const PG8_LAS bf16x8*)(lds + PG8_SB(b, h) + boff + n * 2048 + k * 1024); } while (0)
#define PG8_MMA(ai, bj, At, Bt) do { __builtin_amdgcn_s_setprio(1); _Pragma("unroll") for (int m = 0; m < 4; ++m) _Pragma("unroll") for (int n = 0; n < 2; ++n) _Pragma("unroll") for (int k = 0; k < 2; ++k) \
        acc[ai][bj][m][n] = __builtin_amdgcn_mfma_f32_16x16x32_bf16(Bt[n][k], At[m][k], acc[ai][bj][m][n], 0, 0, 0); __builtin_amdgcn_s_setprio(0); } while (0)
#define PG8_WAIT_V(n) asm volatile("s_waitcnt vmcnt(" #n ")" ::: "memory")
#define PG8_WAIT_L(n) asm volatile("s_waitcnt lgkmcnt(" #n ")" ::: "memory")
#define PG8_BAR __builtin_amdgcn_s_barrier()
#define PG8_SCHED __builtin_amdgcn_sched_barrier(0)
    Unit cur, nxt; int ui = 0;
    if (!S.next(0, cur)) return;
    f32x4 acc[2][2][4][2];
#pragma unroll
    for (int a = 0; a < 2; ++a)
#pragma unroll
        for (int b = 0; b < 2; ++b)
#pragma unroll
            for (int m = 0; m < 4; ++m)
#pragma unroll
                for (int n = 0; n < 2; ++n) acc[a][b][m][n] = (f32x4){0.f, 0.f, 0.f, 0.f};
    bf16x8 At[4][2], B0[2][2], B1[2][2];
    const char* cA = (const char*)g.A + (size_t)cur.pm * tstep; const char* cB = (const char*)g.Bt + (size_t)cur.pn * tstep;
    S.a_ready(cur);
    if constexpr (SP2) {
        PG8_STAGE(PG8_SB(0, 0), cB, voffB); PG8_STAGE(PG8_SB(0, 1), cB + hstep, voffB); PG8_STAGE(PG8_SA(0, 0), cA, voffA); PG8_STAGE(PG8_SA(0, 1), cA + hstep, voffA);
        if (wr == 1) PG8_BAR;
        PG8_WAIT_V(2); PG8_BAR;
        PG8_STAGE(PG8_SB(1, 0), cB + kstep, voffB); PG8_STAGE(PG8_SA(1, 0), cA + kstep, voffA); PG8_STAGE(PG8_SB(1, 1), cB + hstep + kstep, voffB);
        PG8_WAIT_V(6); PG8_BAR;
    } else {
        PG8_STAGE(PG8_SB(0, 0), cB, voffB); PG8_STAGE(PG8_SA(0, 0), cA, voffA); PG8_STAGE(PG8_SB(0, 1), cB + hstep, voffB); PG8_STAGE(PG8_SA(0, 1), cA + hstep, voffA);
        if (wr == 1) PG8_BAR;
        PG8_WAIT_V(4); PG8_BAR;
        PG8_STAGE(PG8_SB(1, 0), cB + kstep, voffB); PG8_STAGE(PG8_SA(1, 0), cA + kstep, voffA); PG8_STAGE(PG8_SB(1, 1), cB + hstep + kstep, voffB);
        PG8_WAIT_V(6); PG8_BAR;
    }
    for (;;) {
        const bool has_next = S.next(ui + 1, nxt);
        const char* nA = has_next ? (const char*)g.A + (size_t)nxt.pm * tstep : cA; const char* nB = has_next ? (const char*)g.Bt + (size_t)nxt.pn * tstep : cB;
        for (int t = 0; t < nt; t += 2) {
            const bool last = (t == nt - 2);
            const char* a1 = cA + (size_t)(t + 1) * kstep;
            const char* a2 = last ? nA : cA + (size_t)(t + 2) * kstep; const char* b2 = last ? nB : cB + (size_t)(t + 2) * kstep;
            const char* a3 = a2 + kstep; const char* b3 = b2 + kstep;
            if (last && has_next) S.a_ready(nxt);
            if constexpr (SP2) {
            PG8_LDB(B0, 0, 0); PG8_LDB(B1, 0, 1); PG8_SCHED; PG8_LDA(At, 0, 0); PG8_STAGE(PG8_SA(1, 1), a1 + hstep, voffA);
            PG8_WAIT_V(8); PG8_WAIT_L(0); PG8_BAR; PG8_MMA(0, 0, At, B0); PG8_MMA(0, 1, At, B1); PG8_BAR; PG8_SCHED;
            PG8_LDA(At, 0, 1); PG8_STAGE(PG8_SB(0, 0), b2, voffB); PG8_STAGE(PG8_SB(0, 1), b2 + hstep, voffB); PG8_STAGE(PG8_SA(0, 0), a2, voffA);
            PG8_WAIT_V(8); PG8_WAIT_L(0); PG8_BAR; PG8_MMA(1, 0, At, B0); PG8_MMA(1, 1, At, B1); PG8_BAR; PG8_SCHED;
            PG8_LDB(B0, 1, 0); PG8_LDB(B1, 1, 1); PG8_SCHED; PG8_LDA(At, 1, 0); PG8_STAGE(PG8_SA(0, 1), a2 + hstep, voffA);
            PG8_WAIT_V(8); PG8_WAIT_L(0); PG8_BAR; PG8_MMA(0, 0, At, B0); PG8_MMA(0, 1, At, B1); PG8_BAR; PG8_SCHED;
            PG8_LDA(At, 1, 1); PG8_STAGE(PG8_SB(1, 0), b3, voffB); PG8_STAGE(PG8_SB(1, 1), b3 + hstep, voffB); PG8_STAGE(PG8_SA(1, 0), a3, voffA);
            PG8_WAIT_V(8); PG8_WAIT_L(0); PG8_BAR; PG8_MMA(1, 0, At, B0); PG8_MMA(1, 1, At, B1); PG8_BAR; PG8_SCHED;
            } else {
            PG8_LDB(B0, 0, 0); PG8_SCHED; PG8_LDA(At, 0, 0); PG8_STAGE(PG8_SA(1, 1), a1 + hstep, voffA);
            PG8_WAIT_L(8); PG8_BAR; PG8_WAIT_L(0); PG8_MMA(0, 0, At, B0); PG8_BAR; PG8_SCHED;
            PG8_LDB(B1, 0, 1); PG8_STAGE(PG8_SB(0, 0), b2, voffB);
            PG8_BAR; PG8_WAIT_L(0); PG8_MMA(0, 1, At, B1); PG8_BAR;
            PG8_LDA(At, 0, 1); PG8_STAGE(PG8_SA(0, 0), a2, voffA);
            PG8_BAR; PG8_WAIT_L(0); PG8_MMA(1, 0, At, B0); PG8_BAR; PG8_SCHED;
            PG8_STAGE(PG8_SB(0, 1), b2 + hstep, voffB);
            PG8_WAIT_V(6); PG8_BAR; PG8_MMA(1, 1, At, B1); PG8_BAR;
            PG8_LDB(B0, 1, 0); PG8_SCHED; PG8_LDA(At, 1, 0); PG8_STAGE(PG8_SA(0, 1), a2 + hstep, voffA);
            PG8_WAIT_L(8); PG8_BAR; PG8_WAIT_L(0); PG8_MMA(0, 0, At, B0); PG8_BAR; PG8_SCHED;
            PG8_LDB(B1, 1, 1); PG8_STAGE(PG8_SB(1, 0), b3, voffB);
            PG8_BAR; PG8_WAIT_L(0); PG8_MMA(0, 1, At, B1); PG8_BAR;
            PG8_LDA(At, 1, 1); PG8_STAGE(PG8_SA(1, 0), a3, voffA);
            PG8_BAR; PG8_WAIT_L(0); PG8_MMA(1, 0, At, B0); PG8_BAR; PG8_SCHED;
            PG8_STAGE(PG8_SB(1, 1), b3 + hstep, voffB);
            PG8_WAIT_V(6); PG8_BAR; PG8_MMA(1, 1, At, B1); PG8_BAR;
            }
        }
        if constexpr (ALIGN_EPI) { if (wr == 0) PG8_BAR; }
        if constexpr (!Epi::AFTER_DRAIN) { E(acc, cur, wr, wc, fr, fq); S.done(cur); }
        if (!has_next) break;
#pragma unroll
        for (int a = 0; a < 2; ++a)
#pragma unroll
            for (int b = 0; b < 2; ++b)
#pragma unroll
                for (int m = 0; m < 4; ++m)
#pragma unroll
                    for (int n = 0; n < 2; ++n) acc[a][b][m][n] = (f32x4){0.f, 0.f, 0.f, 0.f};
        cur = nxt; cA = nA; cB = nB; ++ui;
        if constexpr (ALIGN_EPI) { if (wr == 1) PG8_BAR; }
    }
    PG8_WAIT_V(0);
    if constexpr (!ALIGN_EPI) { if (wr == 0) PG8_BAR; }
    PG8_BAR;
    if constexpr (Epi::AFTER_DRAIN) { E.fused(acc, cur, wr, wc, fr, fq, lds, wid, lane); S.done(cur); }
#undef PG8_SA
#undef PG8_SB
#undef PG8_STAGE
#undef PG8_LDA
#undef PG8_LDB
#undef PG8_MMA
#undef PG8_WAIT_V
#undef PG8_WAIT_L
#undef PG8_BAR
#undef PG8_SCHED
}
}
#define GAS __attribute__((address_space(1)))
#define LAS __attribute__((address_space(3)))
typedef unsigned short bf16;
typedef unsigned v4u __attribute__((ext_vector_type(4)));
typedef float f32x4 __attribute__((ext_vector_type(4)));
typedef short bf16x8 __attribute__((ext_vector_type(8)));
typedef GAS unsigned gu32;
typedef GAS unsigned long long gu64;
#define RLX_AGENT __ATOMIC_RELAXED, __HIP_MEMORY_SCOPE_AGENT
#define LDS_WAIT() asm volatile("s_waitcnt lgkmcnt(0)" ::: "memory")
#define VM_WAIT() asm volatile("s_waitcnt vmcnt(0)" ::: "memory")
__device__ __forceinline__ unsigned long long rt() { return __builtin_amdgcn_s_memrealtime(); }
__device__ __forceinline__ unsigned f2bf(float f) { unsigned u = __builtin_bit_cast(unsigned, f); return (u + 0x7fffu + ((u >> 16) & 1u)) >> 16; }
__device__ __forceinline__ unsigned pk2(float lo, float hi) { return f2bf(lo) | (f2bf(hi) << 16); }
#define XB_TMO      128
#define XB_XCNT(j)  (256  + 64 * (j))
#define XB_XSUB(j)  (1280 + 64 * (j))
#define XB_XGEN(j)  (2304 + 64 * (j))
#define XB_TOP      3328
#define XB_TOPGEN   3392
#define XCD_BAR_WORDS 3456
#define XB_SPIN_CAP (1u << 18)

__device__ __forceinline__ unsigned xb_ld(unsigned* p)              { return __hip_atomic_load(p, __ATOMIC_RELAXED, __HIP_MEMORY_SCOPE_AGENT); }
__device__ __forceinline__ unsigned xb_add(unsigned* p, unsigned v) { return __hip_atomic_fetch_add(p, v, __ATOMIC_RELAXED, __HIP_MEMORY_SCOPE_AGENT); }
__device__ __forceinline__ unsigned xb_xcc_id() { return (unsigned)__builtin_amdgcn_s_getreg((3 << 11) | 20) & 0xFu; }
#define XB_SPIN(cond, bar) do { unsigned _sp = 0; while (cond) { __builtin_amdgcn_s_sleep(1); \
    if ((++_sp & 255u) == 0u) { if (xb_ld(&(bar)[XB_TMO])) break; if (_sp > XB_SPIN_CAP) { atomicAdd(&(bar)[XB_TMO], 1u); break; } } } } while (0)

struct XcdBarrier {
    unsigned* bar; unsigned x;
    volatile LAS unsigned* st;
};

__device__ __forceinline__ XcdBarrier xcd_barrier_post(unsigned* bar, volatile LAS unsigned* st) {
    XcdBarrier b; b.bar = bar; b.x = xb_xcc_id(); b.st = st;
    if (threadIdx.x == 0) (void)xb_add(&bar[XB_XCNT(b.x)], 1u);
    return b;
}
__device__ __forceinline__ void xcd_barrier_complete(unsigned* bar, unsigned x, unsigned& nloc, unsigned& nx) {
    const unsigned G = gridDim.x * gridDim.y * gridDim.z;
    unsigned sum, cnt, mine, sp = 0u;
    for (;;) {
        sum = 0u; cnt = 0u; mine = 0u;
#pragma unroll
        for (unsigned j = 0; j < 16; ++j) { const unsigned c = xb_ld(&bar[XB_XCNT(j)]); sum += c; cnt += (c > 0u) ? 1u : 0u; mine = (j == x) ? c : mine; }
        if (sum == G) break;
        __builtin_amdgcn_s_sleep(1);
        if ((++sp & 255u) == 0u) { if (xb_ld(&bar[XB_TMO])) break; if (sp > XB_SPIN_CAP) { atomicAdd(&bar[XB_TMO], 1u); break; } }
    }
    nloc = mine > 0u ? mine : 1u; nx = cnt > 0u ? cnt : 1u;
}

__device__ __forceinline__ void xcd_barrier(const XcdBarrier& b) {
    asm volatile("s_waitcnt vmcnt(0)" ::: "memory");
    __syncthreads();
    if (threadIdx.x == 0) {
        unsigned* bar = b.bar;
        __builtin_amdgcn_s_waitcnt(0);
        unsigned nloc = b.st[0], nx = b.st[1];
        if (nloc == 0u) { xcd_barrier_complete(bar, b.x, nloc, nx); b.st[0] = nloc; b.st[1] = nx; }
        const unsigned old = xb_add(&bar[XB_XSUB(b.x)], 1u);
        const unsigned gen = old / nloc;
        if (old + 1u == (gen + 1u) * nloc) {
            __builtin_amdgcn_fence(__ATOMIC_RELEASE, "agent");
            asm volatile("s_waitcnt vmcnt(0)" ::: "memory");
            const unsigned og = xb_add(&bar[XB_TOP], 1u);
            const unsigned tg = og / nx;
            if (og + 1u == (tg + 1u) * nx) xb_add(&bar[XB_TOPGEN], 1u);
            else XB_SPIN(xb_ld(&bar[XB_TOPGEN]) == tg, bar);
            __builtin_amdgcn_fence(__ATOMIC_ACQUIRE, "agent");
            xb_add(&bar[XB_XGEN(b.x)], 1u);
            asm volatile("s_waitcnt vmcnt(0)" ::: "memory");
        } else {
            XB_SPIN(xb_ld(&bar[XB_XGEN(b.x)]) == gen, bar);
            __builtin_amdgcn_fence(__ATOMIC_ACQUIRE, "agent");
            asm volatile("s_waitcnt vmcnt(0)" ::: "memory");
        }
    }
    __syncthreads();
}

namespace att {
struct ProbeT { unsigned long long acc, last; int state; };
#ifdef PROBE_SUB
#define ATT_MARK(k) do { const unsigned long long now_ = __builtin_amdgcn_s_memrealtime(); if (PT.state == PROBE_SUB) PT.acc += now_ - PT.last; PT.last = now_; PT.state = (k); } while (0)
#define ATT_PROBE_PARAM , ProbeT& PT
#else
#define ATT_MARK(k) do { } while (0)
#define ATT_PROBE_PARAM
#endif
typedef unsigned short bf16_t;
using bf16x8 = __attribute__((ext_vector_type(8))) short;
using s16x4  = __attribute__((ext_vector_type(4))) short;
using f32x16 = __attribute__((ext_vector_type(16))) float;
using u32x4  = __attribute__((ext_vector_type(4))) unsigned;
constexpr int NW = 8, QBLK = 32, KVBLK = 64;
constexpr int VBUF = KVBLK * 128 * 2;
#define ATT_SBAR() __builtin_amdgcn_sched_barrier(0)
__device__ __forceinline__ int crow(int r, int hi) { return (r & 3) + 8 * (r >> 2) + 4 * hi; }
__device__ __forceinline__ unsigned cvtpk(float lo, float hi) { unsigned r; asm volatile("v_cvt_pk_bf16_f32 %0, %1, %2" : "=v"(r) : "v"(lo), "v"(hi)); return r; }
template <int DQ> __device__ __forceinline__ int kswz(int row, int colB) { return row * (DQ * 2) + (colB ^ ((row & 7) << 4)); }

__device__ __forceinline__ void partialSM(f32x16& p0, f32x16& p1, float& m_reg, float& mn, float& alpha, const float C, const float thr, const float rs = 1.f) {
  float pmax = p0[0];
#pragma unroll
  for (int r = 1; r < 16; ++r) pmax = fmaxf(pmax, p0[r]);
#pragma unroll
  for (int r = 0; r < 16; ++r) pmax = fmaxf(pmax, p1[r]);
  { auto rr = __builtin_amdgcn_permlane32_swap(__float_as_uint(pmax), __float_as_uint(pmax), false, false);
    pmax = fmaxf(__uint_as_float(rr[0]), __uint_as_float(rr[1])) * rs; }
  if (__builtin_expect(__all(pmax - m_reg <= thr), 1)) { mn = m_reg; alpha = 1.f; }
  else { mn = fmaxf(m_reg, pmax); alpha = __builtin_amdgcn_exp2f((m_reg - mn) * C); m_reg = mn; }
  const float mnC = -mn * C, Cl = C * rs;
#pragma unroll
  for (int r = 0; r < 16; ++r) p0[r] = fmaf(p0[r], Cl, mnC);
#pragma unroll
  for (int r = 0; r < 16; ++r) p1[r] = fmaf(p1[r], Cl, mnC);
#pragma unroll
  for (int r = 0; r < 16; ++r) p0[r] = __builtin_amdgcn_exp2f(p0[r]);
}
__device__ __forceinline__ void finishSM(f32x16& p0, f32x16& p1, float alpha, float& l_reg, bf16x8& pa0, bf16x8& pa1, bf16x8& pa2, bf16x8& pa3) {
#pragma unroll
  for (int r = 0; r < 16; ++r) p1[r] = __builtin_amdgcn_exp2f(p1[r]);
  float ps = 0;
#pragma unroll
  for (int r = 0; r < 16; ++r) ps += p0[r];
#pragma unroll
  for (int r = 0; r < 16; ++r) ps += p1[r];
  { auto rr = __builtin_amdgcn_permlane32_swap(__float_as_uint(ps), __float_as_uint(ps), false, false);
    ps = __uint_as_float(rr[0]) + __uint_as_float(rr[1]); }
  l_reg = l_reg * alpha + ps;
#define ATT_PK4(P, BASE, OUT) do { unsigned a0 = cvtpk(P[BASE + 0], P[BASE + 1]), a1 = cvtpk(P[BASE + 2], P[BASE + 3]);   \
    unsigned b0 = cvtpk(P[BASE + 4], P[BASE + 5]), b1 = cvtpk(P[BASE + 6], P[BASE + 7]);                              \
    auto r0 = __builtin_amdgcn_permlane32_swap(a0, b0, false, false); auto r1 = __builtin_amdgcn_permlane32_swap(a1, b1, false, false); \
    u32x4 w = {r0[0], r1[0], r0[1], r1[1]}; OUT = *reinterpret_cast<bf16x8*>(&w); } while (0)
  ATT_PK4(p0, 0, pa0); ATT_PK4(p0, 8, pa1); ATT_PK4(p1, 0, pa2); ATT_PK4(p1, 8, pa3);
#undef ATT_PK4
}
template <int OFF> __device__ __forceinline__ bf16x8 lds_rd128(unsigned addr) { bf16x8 r; asm volatile("ds_read_b128 %0, %1 offset:%2" : "=&v"(r) : "v"(addr), "i"(OFF) : "memory"); return r; }
template <int N> __device__ __forceinline__ void lgkm_wait() { static_assert(N == 0 || N == 2 || N == 4 || N == 6, "count"); if constexpr (N == 0) asm volatile("s_waitcnt lgkmcnt(0)" ::: "memory"); else if constexpr (N == 2) asm volatile("s_waitcnt lgkmcnt(2)" ::: "memory"); else if constexpr (N == 4) asm volatile("s_waitcnt lgkmcnt(4)" ::: "memory"); else asm volatile("s_waitcnt lgkmcnt(6)" ::: "memory"); }
template <int GS, int G, int S = 0> struct QktLoad {
  static __device__ __forceinline__ void run(unsigned kb, bf16x8 (&f0)[2][GS], bf16x8 (&f1)[2][GS]) {
    f0[G & 1][S] = lds_rd128<(G * GS + S) * 2048>(kb); f1[G & 1][S] = lds_rd128<(G * GS + S) * 2048 + 512>(kb);
    if constexpr (S + 1 < GS) QktLoad<GS, G, S + 1>::run(kb, f0, f1);
  }
};
template <int DQ, int GS, int G = 0> struct QktStep {
  static __device__ __forceinline__ void run(f32x16& p0, f32x16& p1, unsigned kb, const bf16x8* qr, bf16x8 (&f0)[2][GS], bf16x8 (&f1)[2][GS]) {
    constexpr int NG = DQ / 16 / GS;
    if constexpr (G + 1 < NG) { QktLoad<GS, G + 1>::run(kb, f0, f1); lgkm_wait<2 * GS>(); } else lgkm_wait<0>();
    ATT_SBAR();
#pragma unroll
    for (int s_ = 0; s_ < GS; ++s_) { p0 = __builtin_amdgcn_mfma_f32_32x32x16_bf16(f0[G & 1][s_], qr[G * GS + s_], p0, 0, 0, 0); p1 = __builtin_amdgcn_mfma_f32_32x32x16_bf16(f1[G & 1][s_], qr[G * GS + s_], p1, 0, 0, 0); }
    ATT_SBAR();
    if constexpr (G + 1 < NG) QktStep<DQ, GS, G + 1>::run(p0, p1, kb, qr, f0, f1);
  }
};
template <int DQ, int GS> __device__ __forceinline__ void qkt(f32x16& p0, f32x16& p1, const char* Ks, const bf16x8* qr, int r32, int hi) {
  static_assert((DQ / 16) % GS == 0 && GS >= 1 && GS <= 3, "group size");
  p0 = f32x16{}; p1 = f32x16{};
  const unsigned kb = (unsigned)(uintptr_t)Ks + (unsigned)(hi * 1024 + r32 * 16);
  bf16x8 f0[2][GS], f1[2][GS];
  QktLoad<GS, 0>::run(kb, f0, f1);
  QktStep<DQ, GS, 0>::run(p0, p1, kb, qr, f0, f1);
}
__device__ __forceinline__ int v_st(int k, int c) { const int kk = (k & ~0xC) | ((k & 4) << 1) | ((k & 8) >> 1); return ((kk >> 3) * 4 + (c >> 5)) * 512 + ((kk & 7) * 32 + (c & 31)) * 2; }
__device__ __forceinline__ int v_rd_base(int lane) { return ((lane & 3) << 3) | (((lane >> 2) & 3) << 6) | (((lane >> 4) & 1) << 5) | (((lane >> 5) & 1) << 8); }
constexpr int v_rd_off(int d0, int ks, int half) { return d0 * 512 + ks * 4096 + half * 2048; }
template <int OFF> __device__ __forceinline__ s16x4 tr_read(int vb) {
  s16x4 r; asm volatile("ds_read_b64_tr_b16 %0, %1 offset:%2" : "=&v"(r) : "v"(vb), "i"(OFF) : "memory"); return r;
}
template <int HB> __device__ __forceinline__ void pv_rd(s16x4 (&s)[4], int vb) {
  constexpr int D0 = HB >> 1, K0 = 2 * (HB & 1);
  s[0] = tr_read<v_rd_off(D0, K0, 0)>(vb); s[1] = tr_read<v_rd_off(D0, K0, 1)>(vb); s[2] = tr_read<v_rd_off(D0, K0 + 1, 0)>(vb); s[3] = tr_read<v_rd_off(D0, K0 + 1, 1)>(vb);
}
__device__ __forceinline__ void pv_mm(f32x16& od, const s16x4 (&s)[4], bf16x8 pa, bf16x8 pb) {
#define ATT_PK(L, H) (bf16x8){L[0], L[1], L[2], L[3], H[0], H[1], H[2], H[3]}
  od = __builtin_amdgcn_mfma_f32_32x32x16_bf16(pa, ATT_PK(s[0], s[1]), od, 0, 0, 0);
  od = __builtin_amdgcn_mfma_f32_32x32x16_bf16(pb, ATT_PK(s[2], s[3]), od, 0, 0, 0);
#undef ATT_PK
}
template <int H> __device__ __forceinline__ void pv_half(f32x16* o, int vb, bf16x8 pa0, bf16x8 pa1, bf16x8 pa2, bf16x8 pa3) {
  s16x4 s0[4], s1[4], s2[4];
#define ATT_W8() asm volatile("s_waitcnt lgkmcnt(8)" ::: "memory")
#define ATT_W4() asm volatile("s_waitcnt lgkmcnt(4)" ::: "memory")
#define ATT_W0() asm volatile("s_waitcnt lgkmcnt(0)" ::: "memory")
  pv_rd<4 * H + 0>(s0, vb); pv_rd<4 * H + 1>(s1, vb);
  pv_rd<4 * H + 2>(s2, vb); ATT_W8(); ATT_SBAR(); pv_mm(o[2 * H], s0, pa0, pa1); ATT_SBAR();
  pv_rd<4 * H + 3>(s0, vb); ATT_W8(); ATT_SBAR(); pv_mm(o[2 * H], s1, pa2, pa3); ATT_SBAR();
  ATT_W4(); ATT_SBAR(); pv_mm(o[2 * H + 1], s2, pa0, pa1); ATT_SBAR();
  ATT_W0(); ATT_SBAR(); pv_mm(o[2 * H + 1], s0, pa2, pa3); ATT_SBAR();
#undef ATT_W8
#undef ATT_W4
#undef ATT_W0
}

struct AUnit {
  const bf16_t* q; bf16_t* o; const bf16_t *k0, *v0, *k1, *v1;
  int ldq, ldo, ldk0, ldv0, ldk1, ldv1, n0, ntiles; float scale;
  int r0, kr_lo; const float* rpb;
  const float* qsq;
};
constexpr int TBL_FLOATS = 15 * 128;
constexpr int NBUF = 3;
template <int DQ> constexpr int attn_lds_bytes() { return NBUF * VBUF + NBUF * KVBLK * DQ * 2 + NW * 64 * 4 + TBL_FLOATS * 4; }

template <int DQ, bool NAT>
__device__ __forceinline__ void attn_unit(const AUnit& U, char* lds, const int wid_in ATT_PROBE_PARAM) {
  constexpr int KB = KVBLK * DQ * 2, NKC = DQ / 64, CPR = DQ / 8;
  ATT_MARK(0);
  const int tid = wid_in * 64 + lane_id_fresh(), wid = wid_in, lane = tid & 63, r32 = lane & 31, hi = lane >> 5;
  char* V_lds = lds; char* K_lds = lds + NBUF * VBUF;
  float* ws = (float*)(lds + NBUF * VBUF + NBUF * KB) + wid * 64; float* li_l = ws; float* al_l = ws + 32;
  float* tbl = (float*)(lds + NBUF * VBUF + NBUF * KB + NW * 64 * 4);
  const float C = U.scale * 1.4426950408889634f, thr = 8.f / U.scale;
  if constexpr (NAT) {
    const float inv = 1.0f / U.scale;
    for (int idx = tid; idx < TBL_FLOATS; idx += 512) { const int ro = idx >> 7, d = (idx & 127) - 48; tbl[idx] = (d >= 0 && d <= 30) ? U.rpb[ro * 31 + d] * inv : 0.f; }
  }
  float m_reg = -1e30f, l_reg = 0.f; f32x16 o[4] = {}; bf16x8 qr[DQ / 16];
  const bf16_t* Qw = U.q + (long)(wid * QBLK + r32) * U.ldq + hi * 8;
#pragma unroll
  for (int d0 = 0; d0 < DQ / 16; ++d0) qr[d0] = *reinterpret_cast<const bf16x8*>(Qw + d0 * 16);
  float qrs = 1.f;
  if (U.qsq) { typedef float f32x2v __attribute__((ext_vector_type(2))); const float* sp = U.qsq + (long)(wid * QBLK + r32) * 96;
    const f32x2v a = *(const f32x2v*)sp, b = *(const f32x2v*)(sp + 2), c = *(const f32x2v*)(sp + 4); qrs = __builtin_amdgcn_rsqf(((a[0] + a[1]) + (b[0] + b[1]) + (c[0] + c[1])) * (1.0f / 192.0f) + 1e-6f); }
  const int sr = tid >> 4, sc = (tid & 15) * 8, vst0 = v_st(sr, sc), vst1 = v_st(32 + sr, sc);
  const int vb0 = (int)(uintptr_t)V_lds + v_rd_base(lane);
  bf16x8 st[NKC], sv[2];
#define ATT_TILE(j) const int j_ = (j); const bool f_ = j_ < U.n0; const int jj_ = f_ ? j_ : j_ - U.n0; const int ldk_ = f_ ? U.ldk0 : U.ldk1, ldv_ = f_ ? U.ldv0 : U.ldv1; \
    const bf16_t* kp_ = (f_ ? U.k0 : U.k1) + (long)jj_ * KVBLK * ldk_; const bf16_t* vp_ = (f_ ? U.v0 : U.v1) + (long)jj_ * KVBLK * ldv_; (void)kp_; (void)vp_; (void)ldk_; (void)ldv_
#define ATT_KLOAD_TO(dst, j) do { ATT_TILE(j); _Pragma("unroll") for (int i_ = 0; i_ < NKC; ++i_) { const int c_ = tid + 512 * i_, kr_ = c_ & 63, kc_ = c_ >> 6; dst[i_] = *reinterpret_cast<const bf16x8*>(kp_ + (long)kr_ * ldk_ + kc_ * 8); } } while (0)
#define ATT_KLOAD(j) ATT_KLOAD_TO(st, j)
#define ATT_KWRITE_FROM(src, b) do { _Pragma("unroll") for (int i_ = 0; i_ < NKC; ++i_) { const int c_ = tid + 512 * i_; *(bf16x8*)(K_lds + (b) * KB + c_ * 16) = src[i_]; } } while (0)
#define ATT_KWRITE(b) ATT_KWRITE_FROM(st, b)
#define ATT_VLOAD_TO(dst, j) do { ATT_TILE(j); dst[0] = *reinterpret_cast<const bf16x8*>(vp_ + (long)sr * ldv_ + sc); dst[1] = *reinterpret_cast<const bf16x8*>(vp_ + (long)(32 + sr) * ldv_ + sc); } while (0)
#define ATT_VLOAD(j) ATT_VLOAD_TO(sv, j)
#define ATT_VWRITE_FROM(src, b) do { *(bf16x8*)(V_lds + (b) * VBUF + vst0) = src[0]; *(bf16x8*)(V_lds + (b) * VBUF + vst1) = src[1]; } while (0)
#define ATT_VWRITE(b) ATT_VWRITE_FROM(sv, b)
#define ATT_BAR() do { asm volatile("s_waitcnt lgkmcnt(0)" ::: "memory"); __builtin_amdgcn_s_barrier(); asm volatile("" ::: "memory"); } while (0)
  const int NT = U.ntiles;
  const int R = U.r0 + (wid >> 1), rs = min(max(R - 4, 0), 24), qc = (wid & 1) * 32 + r32, cs = min(max(qc - 8, 0), 48);
  { bf16x8 k0_[NKC], k1_[NKC], k2_[NKC], v0_[2], v1_[2], v2_[2];
    ATT_KLOAD_TO(k0_, 0); ATT_VLOAD_TO(v0_, 0); ATT_KLOAD_TO(k1_, 1); ATT_VLOAD_TO(v1_, 1);
    if (2 < NT) { ATT_KLOAD_TO(k2_, 2); ATT_VLOAD_TO(v2_, 2); }
    if (3 < NT) { ATT_KLOAD(3); ATT_VLOAD(3); }
    ATT_KWRITE_FROM(k0_, 0); ATT_VWRITE_FROM(v0_, 0); ATT_KWRITE_FROM(k1_, 1); ATT_VWRITE_FROM(v1_, 1);
    if (2 < NT) { ATT_KWRITE_FROM(k2_, 2); ATT_VWRITE_FROM(v2_, 2); } }
  ATT_BAR();
  if (wid >= 4) { ATT_BAR(); __builtin_amdgcn_s_setprio(1); }
  ATT_MARK(1);
  int b = 0, bn = 1, bp = 2;
  bool act_prev = false; bf16x8 pa0, pa1, pa2, pa3; f32x16 p0, p1;
  for (int j = 0; j <= NT; ++j) {
    bool act = j < NT; int kr = 0;
    if constexpr (NAT) { if (j >= U.n0 && j < NT) { kr = U.kr_lo + (j - U.n0); act = (kr >= rs) && (kr <= rs + 7); } }
    if (j >= 2 && j + 1 < NT) { ATT_KWRITE(bn); if (j + 2 < NT) ATT_KLOAD(j + 2); }
    if (act) {
      qkt<DQ, 2>(p0, p1, K_lds + b * KB, qr, r32, hi);
      if constexpr (NAT) { if (j >= U.n0) {
        const int ro = kr - R + 7; const float* tb = tbl + ro * 128 + 63 - qc + 4 * hi; const int t0 = 4 * hi - cs; const float NEG = -INFINITY;
#pragma unroll
        for (int r = 0; r < 16; ++r) { const int kc = (r & 3) + 8 * (r >> 2);
          p0[r] = ((unsigned)(t0 + kc) < 16u) ? p0[r] + tb[kc] : NEG;
          p1[r] = ((unsigned)(t0 + kc + 32) < 16u) ? p1[r] + tb[kc + 32] : NEG; } } }
    }
    if (act_prev) pv_half<1>(o, vb0 + bp * VBUF, pa0, pa1, pa2, pa3);
    if (j == NT) break;
    ATT_MARK(2); ATT_BAR(); ATT_MARK(3);
    if (j >= 2 && j + 1 < NT) { ATT_VWRITE(bn); if (j + 2 < NT) ATT_VLOAD(j + 2); }
    if (act) {
      float mn, alpha;
      partialSM(p0, p1, m_reg, mn, alpha, C, thr, qrs);
      if (__any(alpha < 1.f)) { if (hi == 0) al_l[r32] = alpha; asm volatile("s_waitcnt lgkmcnt(0)" ::: "memory");
#pragma unroll
        for (int d = 0; d < 4; ++d)
#pragma unroll
          for (int r = 0; r < 16; ++r) o[d][r] *= al_l[crow(r, hi)]; }
      finishSM(p0, p1, alpha, l_reg, pa0, pa1, pa2, pa3); ATT_SBAR();
      pv_half<0>(o, vb0 + b * VBUF, pa0, pa1, pa2, pa3);
    }
    ATT_MARK(4); ATT_BAR(); ATT_MARK(1);
    act_prev = act; bp = b; b = bn; bn = (bn == NBUF - 1) ? 0 : bn + 1;
  }
  ATT_MARK(5);
  ATT_BAR();
  if (wid < 4) ATT_BAR();
  __builtin_amdgcn_s_setprio(0);
  if (hi == 0) li_l[r32] = l_reg; asm volatile("s_waitcnt lgkmcnt(0)" ::: "memory");
  float rli[16];
#pragma unroll
  for (int r = 0; r < 16; ++r) rli[r] = __builtin_amdgcn_rcpf(li_l[crow(r, hi)]);
  bf16_t* Ow = U.o + (long)(wid * QBLK) * U.ldo;
#pragma unroll
  for (int r = 0; r < 16; ++r) { const int orow = crow(r, hi);
#pragma unroll
    for (int d0 = 0; d0 < 4; ++d0) { const float v = o[d0][r] * rli[r]; unsigned u = __float_as_uint(v); u = (u + 0x7fffu + ((u >> 16) & 1u)) >> 16; Ow[(long)orow * U.ldo + d0 * 32 + r32] = (bf16_t)u; } }
  ATT_MARK(6);
#undef ATT_TILE
#undef ATT_KLOAD
#undef ATT_KWRITE
#undef ATT_VLOAD
#undef ATT_VWRITE
#undef ATT_KLOAD_TO
#undef ATT_KWRITE_FROM
#undef ATT_VLOAD_TO
#undef ATT_VWRITE_FROM
#undef ATT_BAR
}
}

constexpr int D = 2048, NTOK = 16384, NCTX = 8192, DEPTH = 4;
constexpr int IN_AB = 6144, DFF = 5632, NDOWN = 832, NDOWN_P = 1024, QL = 512, KVL = 256, ROPE_D = 64;
constexpr int NKVROWS = NTOK + 1024;
constexpr float EPS = 1e-6f;
constexpr int NWAVES = 8;
constexpr size_t O_X = 0, O_NATK = (size_t)NTOK * D, O_NATV = O_NATK + 16777216, O_CKV = O_NATV + 16777216, O_KR = O_CKV + 4194304, O_END = O_KR + 1048576;
constexpr size_t MiB = 1u << 20;
constexpr size_t WS_CTL = 0, CTL_ZERO_BYTES = 1 * MiB;
constexpr size_t WS_MOD = 1 * MiB;
constexpr size_t WS_W = 2 * MiB;
constexpr size_t SZ_FFN_IN = (size_t)2 * DFF * D * 2, SZ_FFN_OUT = (size_t)D * DFF * 2, SZ_IN_AB = (size_t)IN_AB * D * 2, SZ_DD = (size_t)D * D * 2;
constexpr size_t SZ_DOWN = (size_t)NDOWN_P * D * 2, SZ_UQ = (size_t)3072 * QL * 2, SZ_UKV = (size_t)4096 * KVL * 2;
constexpr size_t W_FFN_IN = WS_W, W_FFN_OUT = W_FFN_IN + 4 * SZ_FFN_IN, W_IN_AB = W_FFN_OUT + 4 * SZ_FFN_OUT, W_OUT_AB = W_IN_AB + 2 * SZ_IN_AB;
constexpr size_t W_DOWN = W_OUT_AB + 2 * SZ_DD, W_UQ = W_DOWN + 2 * SZ_DOWN, W_UKV = W_UQ + 2 * SZ_UQ, W_O = W_UKV + 2 * SZ_UKV, W_END = W_O + 2 * SZ_DD;
constexpr size_t WS_H = 384 * MiB;
constexpr size_t WS_C = WS_H + 64 * MiB;
constexpr size_t WS_SM = WS_C + 64 * MiB;
constexpr size_t SZ_CKVN = 9 * MiB, SZ_KR = 5 * MiB, SZ_KRSQ = 128 * 1024;
constexpr size_t SM_CQN = WS_SM, SM_CKVN = SM_CQN + (size_t)NTOK * QL * 2, SM_KR = SM_CKVN + 2 * SZ_CKVN, SM_CK = SM_KR + 2 * SZ_KR, SM_CV = SM_CK + 4 * MiB, SM_KRSQ = SM_CV + 4 * MiB, SM_CQP = SM_KRSQ + 1 * MiB, SM_QSQ = SM_CQP + 1 * MiB, SM_END = SM_QSQ + 7 * MiB;
static_assert((size_t)NKVROWS * KVL * 2 <= SZ_CKVN && (size_t)NKVROWS * 64 * 4 <= SZ_KR && (size_t)NKVROWS * 4 <= SZ_KRSQ && (size_t)NTOK * 8 * 4 <= 1 * MiB, "latent buffers");
constexpr size_t WS_BIG = WS_SM + 64 * MiB;
constexpr size_t B_P = WS_BIG;
constexpr size_t B_L = WS_BIG, B_QC = B_L + 64 * MiB, B_KV = B_QC + 96 * MiB, B_KN = B_KV + 136 * MiB;
constexpr size_t WS_CS = WS_MOD + 983040;
constexpr size_t B_F = WS_BIG;
constexpr size_t WS_X16 = WS_BIG + 512 * MiB;
constexpr size_t WS_END = WS_X16 + 64 * MiB;
static_assert(W_END <= WS_H && SM_END <= WS_BIG && B_KN + (size_t)NKVROWS * 3072 * 2 <= WS_X16 && B_F + (size_t)NTOK * DFF * 2 <= WS_END, "d_ws map");
constexpr int CW_BAR = 4096;
constexpr int RING_BYTES = 131072, LDSCTL_OFF = RING_BYTES, LDS_BYTES = 147456;

typedef unsigned short bf16;
typedef float f32x2 __attribute__((ext_vector_type(2)));
typedef unsigned u32x2 __attribute__((ext_vector_type(2)));
typedef _Float16 h16x4 __attribute__((ext_vector_type(4)));

__device__ __forceinline__ float wave_sum(float v) {
    v += __int_as_float(__builtin_amdgcn_ds_swizzle(__float_as_int(v), 0x041F));
    v += __int_as_float(__builtin_amdgcn_ds_swizzle(__float_as_int(v), 0x081F));
    v += __int_as_float(__builtin_amdgcn_ds_swizzle(__float_as_int(v), 0x101F));
    v += __int_as_float(__builtin_amdgcn_ds_swizzle(__float_as_int(v), 0x201F));
    v += __int_as_float(__builtin_amdgcn_ds_swizzle(__float_as_int(v), 0x401F));
    const auto b = __builtin_amdgcn_permlane32_swap(__float_as_uint(v), __float_as_uint(v), false, false);
    return __uint_as_float(b[0]) + __uint_as_float(b[1]);
}
__device__ __forceinline__ float bf2f(unsigned short b) { return __uint_as_float(((unsigned)b) << 16); }
__device__ __forceinline__ float bflo(unsigned w) { return __uint_as_float(w << 16); }
__device__ __forceinline__ float bfhi(unsigned w) { return __uint_as_float(w & 0xffff0000u); }

struct Frame {
    LAS unsigned char* lds; char* ldsg;
    int tid, lane, wave, G, vcu, gw, NGW;
    GAS float* out; GAS unsigned char* ws; int l;
};
__device__ __forceinline__ const float* kin(int k) { asm volatile("" : "+s"(k)); return (const float*)((GAS const float* const __attribute__((address_space(4)))*)__builtin_amdgcn_kernarg_segment_ptr())[k]; }

__device__ __forceinline__ bool fresh(Frame& F) {
    F.lane = lane_id_fresh(); F.tid = F.wave * 64 + F.lane;
    { GAS unsigned char* w = F.ws; GAS float* o = F.out; int l = F.l; asm volatile("" : "+s"(w), "+s"(o), "+s"(l)); F.ws = w; F.out = o; F.l = l; }
    return true;
}
__device__ __forceinline__ void p0_transpose_item(const float* W, int K, int N, bf16* WT, int k0, int n0, int drow0, LAS float* scr, int lane, const float* ksc) {
    { const int r = lane >> 3, n4 = (lane & 7) * 4; f32x4 w[8];
#pragma unroll
      for (int i = 0; i < 8; ++i) w[i] = *(const f32x4*)(W + (size_t)(k0 + r + 8 * i) * N + n0 + n4);
#pragma unroll
      for (int i = 0; i < 8; ++i) { LAS float* d = scr + (r + 8 * i) * 33 + n4; d[0] = w[i][0]; d[1] = w[i][1]; d[2] = w[i][2]; d[3] = w[i][3]; } }
    LDS_WAIT(); asm volatile("" ::: "memory");
    const int c = lane & 7;
    f32x4 sa = {1.f, 1.f, 1.f, 1.f}, sb = {1.f, 1.f, 1.f, 1.f};
    if (ksc) { sa = *(const f32x4*)(ksc + k0 + 8 * c); sb = *(const f32x4*)(ksc + k0 + 8 * c + 4); }
#pragma unroll
    for (int j = 0; j < 4; ++j) { const int n = (lane >> 3) + 8 * j; const LAS float* s = scr + (8 * c) * 33 + n;
        v4u o; o.x = pk2(s[0 * 33] * sa[0], s[1 * 33] * sa[1]); o.y = pk2(s[2 * 33] * sa[2], s[3 * 33] * sa[3]); o.z = pk2(s[4 * 33] * sb[0], s[5 * 33] * sb[1]); o.w = pk2(s[6 * 33] * sb[2], s[7 * 33] * sb[3]);
        *(GAS v4u*)(WT + (size_t)(drow0 + n) * K + k0 + 8 * c) = o; }
    LDS_WAIT(); asm volatile("" ::: "memory");
}
__device__ __forceinline__ void p0_do_matrix(const float* W, int K, int N, bf16* WT, int item, int ffn_map, LAS float* scr, int lane, const float* ksc = nullptr) {
    const int nblk = N / 32, kb = item / nblk, nb = item % nblk, k0 = 64 * kb, n0 = 32 * nb;
    int drow0 = n0;
    if (ffn_map == 1) { const int up = n0 >= DFF ? 1 : 0, j = n0 - up * DFF; drow0 = (j >> 7) * 256 + up * 128 + (j & 127); }
    if (ffn_map == 2) { drow0 = (n0 / 192) * 256 + (n0 % 192); }
    p0_transpose_item(W, K, N, WT, k0, n0, drow0, scr, lane, ksc);
}
__device__ __forceinline__ void phase_prologue(Frame& F) {
    {
        LAS float* sil = (LAS float*)F.lds;
        LAS float* red = sil + 5 * 2048;
        const float* c = kin(6); const float* cctx = kin(7);
        for (int i = F.tid; i < 5 * 2048; i += 512) { const int cc = i >> 11, k = i & 2047; const float x = cc == 0 ? cctx[k] : c[(cc - 1) * 2048 + k]; sil[i] = x / (1.0f + __expf(-x)); }
        __syncthreads();
        const float* w_ada = kin(10); const float* b_ada = kin(11); float* mod = (float*)(F.ws + WS_MOD);
        for (int task = F.vcu; task < 4 * 192; task += F.G) {
            const int l = task / 192, n = (task % 192) * 64 + F.lane;
            const float* wp = w_ada + ((size_t)l * 2048 + F.wave * 256) * 12288 + n;
            float a0 = 0.f, a1 = 0.f, a2 = 0.f, a3 = 0.f, a4 = 0.f;
            for (int k = 0; k < 256; k += 16) {
                float w[16];
#pragma unroll
                for (int u = 0; u < 16; ++u) w[u] = wp[(size_t)(k + u) * 12288];
#pragma unroll
                for (int u = 0; u < 16; ++u) { const int kk = F.wave * 256 + k + u; a0 += sil[kk] * w[u]; a1 += sil[2048 + kk] * w[u]; a2 += sil[4096 + kk] * w[u]; a3 += sil[6144 + kk] * w[u]; a4 += sil[8192 + kk] * w[u]; }
            }
            red[(F.wave * 5 + 0) * 64 + F.lane] = a0; red[(F.wave * 5 + 1) * 64 + F.lane] = a1; red[(F.wave * 5 + 2) * 64 + F.lane] = a2; red[(F.wave * 5 + 3) * 64 + F.lane] = a3; red[(F.wave * 5 + 4) * 64 + F.lane] = a4;
            __syncthreads();
            if (F.tid < 320) { const int cc = F.tid >> 6, ln = F.tid & 63; float s = 0.f;
#pragma unroll
                for (int w8 = 0; w8 < 8; ++w8) s += red[(w8 * 5 + cc) * 64 + ln];
                const int nn = (task % 192) * 64 + ln; mod[((size_t)l * 5 + cc) * 12288 + nn] = s + b_ada[(size_t)l * 12288 + nn]; }
            __syncthreads();
        }
    }
    {
        LAS float* scr = (LAS float*)(F.lds + F.wave * 16384);
        constexpr int I_FI = 32 * 352, I_FO = 88 * 64, I_IA = 32 * 192, I_DD = 32 * 64, I_DN = 32 * 26, I_UQ = 8 * 96, I_UK = 4 * 128;
        constexpr int NITEMS = 4 * I_FI + 4 * I_FO + 2 * I_IA + 2 * I_DD + 2 * I_DN + 2 * I_UQ + 2 * I_UK + 2 * I_DD;
        unsigned char* ws = (unsigned char*)F.ws;
        for (int it = F.gw; it < NITEMS; it += F.NGW) {
            int r = it;
            if (r < 4 * I_FI) { const int l = r / I_FI; p0_do_matrix(kin(26) + (size_t)l * D * 2 * DFF, D, 2 * DFF, (bf16*)(ws + W_FFN_IN + l * SZ_FFN_IN), r % I_FI, 1, scr, F.lane); continue; } r -= 4 * I_FI;
            if (r < 4 * I_FO) { const int l = r / I_FO; p0_do_matrix(kin(27) + (size_t)l * DFF * D, DFF, D, (bf16*)(ws + W_FFN_OUT + l * SZ_FFN_OUT), r % I_FO, 0, scr, F.lane); continue; } r -= 4 * I_FO;
            if (r < 2 * I_IA) { const int l = r / I_IA; p0_do_matrix(kin(12) + (size_t)l * D * IN_AB, D, IN_AB, (bf16*)(ws + W_IN_AB + l * SZ_IN_AB), r % I_IA, 0, scr, F.lane); continue; } r -= 2 * I_IA;
            if (r < 2 * I_DD) { const int l = r / I_DD; p0_do_matrix(kin(17) + (size_t)l * D * D, D, D, (bf16*)(ws + W_OUT_AB + l * SZ_DD), r % I_DD, 0, scr, F.lane); continue; } r -= 2 * I_DD;
            if (r < 2 * I_DN) { const int l = r / I_DN; p0_do_matrix(kin(18) + (size_t)l * D * NDOWN, D, NDOWN, (bf16*)(ws + W_DOWN + l * SZ_DOWN), r % I_DN, 0, scr, F.lane); continue; } r -= 2 * I_DN;
            if (r < 2 * I_UQ) { const int l = r / I_UQ; p0_do_matrix(kin(21) + (size_t)l * QL * 3072, QL, 3072, (bf16*)(ws + W_UQ + l * SZ_UQ), r % I_UQ, 0, scr, F.lane, kin(19) + l * QL); continue; } r -= 2 * I_UQ;
            if (r < 2 * I_UK) { const int l = r / I_UK; p0_do_matrix(kin(22) + (size_t)l * KVL * 4096, KVL, 4096, (bf16*)(ws + W_UKV + l * SZ_UKV), r % I_UK, 0, scr, F.lane); continue; } r -= 2 * I_UK;
            { const int l = r / I_DD; p0_do_matrix(kin(25) + (size_t)l * D * D, D, D, (bf16*)(ws + W_O + l * SZ_DD), r % I_DD, 0, scr, F.lane); }
        }
        const int gt = F.vcu * 512 + F.tid, NT = F.G * 512;
        for (int i = gt; i < 2 * (NDOWN_P - NDOWN) * D / 8; i += NT) { const int l = i / ((NDOWN_P - NDOWN) * D / 8), e = i % ((NDOWN_P - NDOWN) * D / 8);
            *(v4u*)(ws + W_DOWN + l * SZ_DOWN + (size_t)NDOWN * D * 2 + (size_t)e * 16) = (v4u){0u, 0u, 0u, 0u}; }
        if (gt < 1024) { const int pos = gt >> 4, j = gt & 15; const float ang = (float)pos * exp2f(-(float)j * (13.287712379549449f / 16.0f));
            ((float*)(ws + WS_CS))[gt] = __cosf(ang); ((float*)(ws + WS_CS))[1024 + gt] = __sinf(ang); }
        for (int rr = F.gw; rr < 2 * 1024; rr += F.NGW) { const int i = rr >> 10, cr = rr & 1023, b = cr >> 8, t = cr & 255; const size_t row = (size_t)NTOK + cr;
            const f32x4 y = *(const f32x4*)(kin(4) + (((size_t)b * 2 + i) * 256 + t) * 256 + F.lane * 4);
            u32x2 w; w.x = pk2(y[0], y[1]); w.y = pk2(y[2], y[3]); *(u32x2*)((bf16*)(ws + SM_CKVN + i * SZ_CKVN) + row * KVL + F.lane * 4) = w;
            const float krv = kin(5)[(((size_t)b * 2 + i) * 256 + t) * 64 + F.lane];
            ((float*)(ws + SM_KR + i * SZ_KR))[row * 64 + F.lane] = krv * (kin(24) + i * 192)[128 + F.lane];
            const float q2 = wave_sum(krv * krv); if (F.lane == 0) ((float*)(ws + SM_KRSQ + i * SZ_KRSQ))[row] = q2; }
        const float* ck = kin(2); const float* cv = kin(3);
        for (int i = gt; i < 2 * 262144; i += NT) { const bool isk = i < 262144; const int e = isk ? i : i - 262144; const float* s = (isk ? ck : cv) + (size_t)e * 8;
            const f32x4 a = *(const f32x4*)s, b = *(const f32x4*)(s + 4); v4u o; o.x = pk2(a[0], a[1]); o.y = pk2(a[2], a[3]); o.z = pk2(b[0], b[1]); o.w = pk2(b[2], b[3]);
            *(v4u*)(ws + (isk ? SM_CK : SM_CV) + (size_t)e * 16) = o; }
    }
}

#ifndef MOD_ROWS
#define MOD_ROWS 4
#endif
__device__ __forceinline__ void phase_mod(Frame& F, const float* xc32, const float* xs32, _Float16* X16, const float* g, const float* mod_l, int chunk, bf16* Hb) {
    for (int rb = F.gw; rb < NTOK / 8; rb += F.NGW) {
        const int row0 = rb * 8, cond = row0 < NCTX ? 0 : 1 + ((row0 - NCTX) >> 11);
        const float* sh = mod_l + (size_t)cond * 12288 + chunk * 2048; const float* scl = sh + 2048;
        f32x4 a[8], b[8];
#pragma unroll
        for (int j = 0; j < 8; ++j) { const int c = 4 * (64 * j + F.lane); const f32x4 gv = *(const f32x4*)(g + c), sv = *(const f32x4*)(scl + c); a[j] = gv * (sv + 1.0f); b[j] = *(const f32x4*)(sh + c); }
        if (xc32) {
            for (int rr = 0; rr < 8; rr += 2) {
                f32x4 v[2][8];
#pragma unroll
                for (int q = 0; q < 2; ++q) { const int row = row0 + rr + q; const float* xr = (row < NCTX ? xc32 : xs32) + (size_t)row * D;
#pragma unroll
                    for (int j = 0; j < 8; ++j) v[q][j] = *(const f32x4*)(xr + 4 * (64 * j + F.lane)); }
#pragma unroll
                for (int q = 0; q < 2; ++q) {
                    const int row = row0 + rr + q; _Float16* xh = X16 + (size_t)row * D; float ss = 0.f;
#pragma unroll
                    for (int j = 0; j < 8; ++j) { const h16x4 hv = __builtin_convertvector(v[q][j], h16x4); *(h16x4*)(xh + 4 * (64 * j + F.lane)) = hv; v[q][j] = __builtin_convertvector(hv, f32x4); }
#pragma unroll
                    for (int j = 0; j < 8; ++j) ss += (v[q][j][0] * v[q][j][0] + v[q][j][1] * v[q][j][1]) + (v[q][j][2] * v[q][j][2] + v[q][j][3] * v[q][j][3]);
                    const float rstd = 1.0f / sqrtf(wave_sum(ss) * (1.0f / D) + EPS);
                    bf16* orow = Hb + (size_t)row * D;
#pragma unroll
                    for (int j = 0; j < 8; ++j) { const f32x4 y = v[q][j] * rstd * a[j] + b[j]; u32x2 w; w.x = pk2(y[0], y[1]); w.y = pk2(y[2], y[3]); *(u32x2*)(orow + 4 * (64 * j + F.lane)) = w; }
                }
            }
        } else {
            for (int rr = 0; rr < 8; rr += MOD_ROWS) {
                h16x4 xr[MOD_ROWS][8];
#pragma unroll
                for (int q = 0; q < MOD_ROWS; ++q) { const _Float16* xh = X16 + (size_t)(row0 + rr + q) * D;
#pragma unroll
                    for (int j = 0; j < 8; ++j) xr[q][j] = *(const h16x4*)(xh + 4 * (64 * j + F.lane)); }
#pragma unroll
                for (int q = 0; q < MOD_ROWS; ++q) {
                    f32x4 v[8]; float ss = 0.f;
#pragma unroll
                    for (int j = 0; j < 8; ++j) { v[j] = __builtin_convertvector(xr[q][j], f32x4); ss += (v[j][0] * v[j][0] + v[j][1] * v[j][1]) + (v[j][2] * v[j][2] + v[j][3] * v[j][3]); }
                    const float rstd = 1.0f / sqrtf(wave_sum(ss) * (1.0f / D) + EPS);
                    bf16* orow = Hb + (size_t)(row0 + rr + q) * D;
#pragma unroll
                    for (int j = 0; j < 8; ++j) { const f32x4 y = v[j] * rstd * a[j] + b[j]; u32x2 w; w.x = pk2(y[0], y[1]); w.y = pk2(y[2], y[3]); *(u32x2*)(orow + 4 * (64 * j + F.lane)) = w; }
                }
            }
        }
    }
}

__device__ __forceinline__ void phase_even_conv(Frame& F, int i, const bf16* P, bf16* Cb) {
    const float* cw = kin(16) + (size_t)i * 3 * 1024;
    const int gt = F.vcu * 512 + F.tid, NT = F.G * 512;
    for (int idx = gt; idx < (NTOK / 8) * 128; idx += NT) {
        const int row0 = (idx >> 7) * 8, c = (idx & 127) * 8;
        int t0, L; if (row0 < NCTX) { t0 = row0 & 255; L = 256; } else { t0 = (row0 - NCTX) & 2047; L = 2048; }
        const bf16* pr = P + (size_t)row0 * IN_AB;
        v4u gcv[10], uv[10], gbv[8];
#pragma unroll
        for (int r = 0; r < 10; ++r) { const int tt = t0 + r - 1; const bool ok = tt >= 0 && tt < L; const bf16* p2 = pr + (ptrdiff_t)(r - 1) * IN_AB;
            gcv[r] = ok ? *(const v4u*)(p2 + 4096 + c) : (v4u){0u, 0u, 0u, 0u}; uv[r] = ok ? *(const v4u*)(p2 + 5120 + c) : (v4u){0u, 0u, 0u, 0u}; }
#pragma unroll
        for (int r = 0; r < 8; ++r) gbv[r] = *(const v4u*)(pr + (size_t)r * IN_AB + 3072 + c);
        f32x4 w[3][2];
#pragma unroll
        for (int j = 0; j < 3; ++j) { w[j][0] = *(const f32x4*)(cw + j * 1024 + c); w[j][1] = *(const f32x4*)(cw + j * 1024 + c + 4); }
        f32x4 pa[3][2];
#define CONV_PROD(dst, r) do { const v4u g_ = gcv[r], u_ = uv[r]; dst[0] = (f32x4){bflo(g_.x) * bflo(u_.x), bfhi(g_.x) * bfhi(u_.x), bflo(g_.y) * bflo(u_.y), bfhi(g_.y) * bfhi(u_.y)}; \
            dst[1] = (f32x4){bflo(g_.z) * bflo(u_.z), bfhi(g_.z) * bfhi(u_.z), bflo(g_.w) * bflo(u_.w), bfhi(g_.w) * bfhi(u_.w)}; } while (0)
        CONV_PROD(pa[0], 0); CONV_PROD(pa[1], 1);
#pragma unroll
        for (int r = 0; r < 8; ++r) {
            CONV_PROD(pa[(r + 2) % 3], r + 2);
            const f32x4 a0 = w[0][0] * pa[r % 3][0] + w[1][0] * pa[(r + 1) % 3][0] + w[2][0] * pa[(r + 2) % 3][0];
            const f32x4 a1 = w[0][1] * pa[r % 3][1] + w[1][1] * pa[(r + 1) % 3][1] + w[2][1] * pa[(r + 2) % 3][1];
            const v4u gb = gbv[r];
            v4u o; o.x = pk2(bflo(gb.x) * a0[0], bfhi(gb.x) * a0[1]); o.y = pk2(bflo(gb.y) * a0[2], bfhi(gb.y) * a0[3]); o.z = pk2(bflo(gb.z) * a1[0], bfhi(gb.z) * a1[1]); o.w = pk2(bflo(gb.w) * a1[2], bfhi(gb.w) * a1[3]);
            *(v4u*)(Cb + (size_t)(row0 + r) * D + 1024 + c) = o;
        }
#undef CONV_PROD
    }
}

#ifdef PROBE_SUB
#define PT_ARG , PT
#define PT_PARAM , att::ProbeT& PT
#else
#define PT_ARG
#define PT_PARAM
#endif
__device__ __forceinline__ void phase_even_attn(Frame& F, int i, const bf16* P, bf16* Cb PT_PARAM) {
    const bf16* CK = (const bf16*)(F.ws + SM_CK); const bf16* CV = (const bf16*)(F.ws + SM_CV);
    for (int u = F.vcu; u < 512; u += F.G) {
        att::AUnit U;
        U.scale = 0.08838834764831845f; U.ldq = IN_AB; U.ldo = D; U.r0 = 0; U.kr_lo = 0; U.rpb = nullptr; U.qsq = nullptr;
        if (u < 256) {
            const int b = u >> 3, h = u & 7; const size_t r0 = (size_t)b * 256;
            U.q = P + r0 * IN_AB + h * 128; U.o = Cb + r0 * D + h * 128;
            U.k0 = P + r0 * IN_AB + 1024 + h * 128; U.v0 = P + r0 * IN_AB + 2048 + h * 128; U.ldk0 = IN_AB; U.ldv0 = IN_AB; U.n0 = 4; U.ntiles = 4;
            U.k1 = U.k0; U.v1 = U.v0; U.ldk1 = IN_AB; U.ldv1 = IN_AB;
            att::attn_unit<128, false>(U, F.ldsg, F.wave PT_ARG);
        } else {
            const int n = u - 256, b = n >> 6, h = (n >> 3) & 7, rb = n & 7, r0 = 4 * rb;
            const size_t row0 = (size_t)NCTX + (size_t)b * 2048 + (size_t)r0 * 64;
            U.q = P + row0 * IN_AB + h * 128; U.o = Cb + row0 * D + h * 128;
            const size_t coff = ((((size_t)b * 2 + i) * 8 + h) * 256) * 128;
            U.k0 = CK + coff; U.v0 = CV + coff; U.ldk0 = 128; U.ldv0 = 128; U.n0 = 4;
            const int kr_lo = min(max(r0 - 4, 0), 24), kr_hi = min(max(r0 - 1, 0), 24) + 7;
            const size_t krow0 = (size_t)NCTX + (size_t)b * 2048 + (size_t)kr_lo * 64;
            U.k1 = P + krow0 * IN_AB + 1024 + h * 128; U.v1 = P + krow0 * IN_AB + 2048 + h * 128; U.ldk1 = IN_AB; U.ldv1 = IN_AB;
            U.ntiles = 4 + (kr_hi - kr_lo + 1); U.r0 = r0; U.kr_lo = kr_lo; U.rpb = kin(15) + ((size_t)i * 8 + h) * 15 * 31;
            att::attn_unit<128, true>(U, F.ldsg, F.wave PT_ARG);
        }
    }
}
#ifndef PROBE_NT
#define PROBE_NT 36
#endif
__device__ __forceinline__ void phase_odd_attn(Frame& F, const bf16* Qn, const bf16* Kn, const bf16* Vn, bf16* Ob, int probe PT_PARAM) {
    for (int u = F.vcu; u < 1024; u += F.G) {
        att::AUnit U;
        U.scale = 0.07216878364870323f; U.ldq = 3072; U.ldo = D; U.r0 = 0; U.kr_lo = 0; U.rpb = nullptr;
        U.ldk0 = 3072; U.ldv0 = 2048; U.ldk1 = 3072; U.ldv1 = 2048;
        if (u < 512) {
            const int b = u >> 4, h = u & 15; const size_t r0 = (size_t)b * 256;
            U.q = Qn + r0 * 3072 + h * 192; U.o = Ob + r0 * D + h * 128; U.qsq = (const float*)(F.ws + SM_QSQ) + r0 * 96 + 6 * h;
            U.k0 = Kn + r0 * 3072 + h * 192; U.v0 = Vn + r0 * 2048 + h * 128; U.n0 = 4; U.ntiles = 4; U.k1 = U.k0; U.v1 = U.v0;
        } else {
            const int n = u - 512, b = n >> 7, h = (n >> 3) & 15, qb = n & 7;
            const size_t row0 = (size_t)NCTX + (size_t)b * 2048 + (size_t)qb * 256, kc0 = (size_t)NTOK + (size_t)b * 256, kl0 = (size_t)NCTX + (size_t)b * 2048;
            U.q = Qn + row0 * 3072 + h * 192; U.o = Ob + row0 * D + h * 128; U.qsq = (const float*)(F.ws + SM_QSQ) + row0 * 96 + 6 * h;
            U.k0 = Kn + kc0 * 3072 + h * 192; U.v0 = Vn + kc0 * 2048 + h * 128; U.n0 = 4;
            U.k1 = Kn + kl0 * 3072 + h * 192; U.v1 = Vn + kl0 * 2048 + h * 128; U.ntiles = probe ? PROBE_NT : 36;
        }
        att::attn_unit<192, false>(U, F.ldsg, F.wave PT_ARG);
    }
}

struct Args { const float* in[28]; float* out; unsigned char* ws; int ph_lo, ph_hi; };
constexpr int PH_END = 1 + DEPTH * 10;
__host__ __device__ constexpr int pid(int l, int s) { return 1 + l * 10 + s; }

__global__ void __launch_bounds__(NWAVES * 64, 2) fwd_kernel(Args args) {
    extern __shared__ __attribute__((aligned(16))) unsigned char lds[];
    Frame F;
    F.lds = (LAS unsigned char*)lds; F.ldsg = (char*)lds;
    F.tid = threadIdx.x; F.lane = F.tid & 63; F.wave = __builtin_amdgcn_readfirstlane(F.tid >> 6);
    F.G = gridDim.x; { const int bx = blockIdx.x; F.vcu = (F.G % 8 == 0) ? (bx % 8) * (F.G / 8) + bx / 8 : bx; }
    F.gw = F.vcu * NWAVES + F.wave; F.NGW = F.G * NWAVES;
    F.out = (GAS float*)args.out; F.ws = (GAS unsigned char*)args.ws; F.l = 0;
    unsigned char* ws = args.ws;
    for (int u = F.tid; u < (LDS_BYTES - LDSCTL_OFF) / 4; u += NWAVES * 64) ((LAS unsigned*)(F.lds + LDSCTL_OFF))[u] = 0u;
    __syncthreads();
    const int lo = args.ph_lo, hi = args.ph_hi;
    XcdBarrier bar; bar.bar = (unsigned*)(ws + WS_CTL) + CW_BAR; bar.x = 0; bar.st = nullptr;
    if (hi - lo > 1) bar = xcd_barrier_post((unsigned*)(ws + WS_CTL) + CW_BAR, (volatile LAS unsigned*)(F.lds + LDSCTL_OFF) + 8);
#ifndef PH_MASK
#define PH_MASK 0xFFFF
#endif
#define EN(k) ((PH_MASK >> (k)) & 1)
#ifndef REP_MASK
#define REP_MASK 0
#endif
#define REPS(k) for (int rep_ = 0; rep_ < 1 + ((REP_MASK >> (k)) & 1); ++rep_)
#define RUN(p) (lo <= (p) && (p) < hi && fresh(F))
#ifdef PROBE_SUB
    att::ProbeT PT; PT.acc = 0; PT.last = 0; PT.state = -1;
#ifdef PROBE_SUB_EVEN
#define PT_ARG_E , PT
#else
#define PT_ARG_E , PTdummy
    att::ProbeT PTdummy; PTdummy.acc = 0; PTdummy.last = 0; PTdummy.state = -1;
#endif
#else
#define PT_ARG_E
#endif
#ifdef PROBE_SLOT
#ifndef PROBE_MULT
#define PROBE_MULT 4
#endif
    unsigned long long t_last_ = rt(), t_acc_ = 0;
#define STAMP(p) do { const unsigned long long now_ = rt(); const int s_ = (p) == 0 ? 99 : (((p) - 1) % 10) + 10 * ((((p) - 1) / 10) & 1); if (s_ == PROBE_SLOT || (PROBE_SLOT >= 100 && (s_ % 10) == (PROBE_SLOT - 100) && s_ != 99)) t_acc_ += now_ - t_last_; t_last_ = now_; } while (0)
#else
#define STAMP(p) do { } while (0)
#endif
#define SEAM(p) do { if ((p) + 1 < hi) xcd_barrier(bar); STAMP(p); } while (0)

#define WSP (F.ws)
#define XP ((float*)(F.out + O_X))
#define MODL ((const float*)(WSP + WS_MOD) + (size_t)F.l * 5 * 12288)
#define HB ((bf16*)(WSP + WS_H))
#define CB ((bf16*)(WSP + WS_C))
#define FB ((bf16*)(WSP + B_F))
#define X16P ((_Float16*)(WSP + WS_X16))

#define REDP ((PG8_LAS float*)(F.lds + LDSCTL_OFF + 1024))

    REPS(0) if (EN(0) && RUN(0)) { phase_prologue(F); SEAM(0); }

    for (int l = 0; l < DEPTH; ++l) {
        F.l = l;
        if (EN(1) && RUN(pid(l, 0))) {
            const float* xc = F.l == 0 ? kin(0) : (const float*)nullptr; const float* xs = F.l == 0 ? kin(1) - (size_t)NCTX * D : (const float*)nullptr;
            phase_mod(F, xc, xs, X16P, kin(8) + (size_t)F.l * D, MODL, 0, HB); SEAM(pid(l, 0)); }
        if ((l & 1) == 0) {
            REPS(2) if (EN(2) && RUN(pid(l, 1))) {
                const int i = F.l >> 1; bf16* P = (bf16*)(WSP + B_P);
                pg8::Gemm g{HB, (const bf16*)(WSP + W_IN_AB + i * SZ_IN_AB), NTOK, IN_AB, D}; pg8::StaticOrder S; S.init(NTOK, IN_AB, F.G, (int)blockIdx.x);
                pg8::EpiInAB E{P, kin(13) + i * 128, kin(14) + i * 128, (float*)(F.out + O_NATK + (size_t)i * 8 * 32768), (float*)(F.out + O_NATV + (size_t)i * 8 * 32768), REDP};
                pg8::gemm_phase<pg8::EpiInAB, pg8::StaticOrder, true, true>(F.lds, g, S, E, F.wave);
                SEAM(pid(l, 1));
            }
            REPS(4) if (EN(4) && RUN(pid(l, 5))) { const int i = F.l >> 1; bf16* P = (bf16*)(WSP + B_P); phase_even_attn(F, i, P, CB PT_ARG_E); fresh(F); phase_even_conv(F, i, P, CB); SEAM(pid(l, 5)); }
        } else {
            REPS(5) if (EN(5) && RUN(pid(l, 1))) {
                const int i = F.l >> 1;
                pg8::Gemm g{HB, (const bf16*)(WSP + W_DOWN + i * SZ_DOWN), NTOK, NDOWN_P, D}; pg8::StaticOrder S; S.init(NTOK, NDOWN_P, F.G, (int)blockIdx.x);
                pg8::EpiDown E{(bf16*)(WSP + SM_CQN), (float*)(WSP + SM_CQP), (bf16*)(WSP + SM_CKVN + i * SZ_CKVN), kin(20) + i * KVL, (float*)(F.out + O_CKV + (size_t)i * 65536), (float*)(F.out + O_KR + (size_t)i * 16384),
                               kin(24) + i * 192 + 128, (float*)(WSP + SM_KR + i * SZ_KR), (float*)(WSP + SM_KRSQ + i * SZ_KRSQ), REDP};
                pg8::gemm_phase<pg8::EpiDown, pg8::StaticOrder, true, true>(F.lds, g, S, E, F.wave);
                SEAM(pid(l, 1));
            }
            REPS(7) if (EN(7) && RUN(pid(l, 3))) {
                { const int i = F.l >> 1;
                  pg8::Gemm g{(const bf16*)(WSP + SM_CQN), (const bf16*)(WSP + W_UQ + i * SZ_UQ), NTOK, 3072, QL}; pg8::StaticOrder S; S.init(NTOK, 3072, F.G, (int)blockIdx.x);
                  pg8::EpiUQ E{(bf16*)(WSP + B_QC), kin(23) + i * 192, (const float*)(WSP + SM_CQP), (float*)(WSP + SM_QSQ)};
#ifndef NO_UQ
                  pg8::gemm_phase<pg8::EpiUQ, pg8::StaticOrder, true, true>(F.lds, g, S, E, F.wave);
#endif
                }
                fresh(F);
                { const int i = F.l >> 1;
                  pg8::Gemm g{(const bf16*)(WSP + SM_CKVN + i * SZ_CKVN), (const bf16*)(WSP + W_UKV + i * SZ_UKV), NKVROWS, 4096, KVL}; pg8::StaticOrder S; S.init(NKVROWS, 4096, F.G, (int)blockIdx.x);
                  pg8::EpiUKV E{(bf16*)(WSP + B_KN), (bf16*)(WSP + B_KV), kin(24) + i * 192, (const float*)(WSP + SM_KR + i * SZ_KR), (const float*)(WSP + SM_KRSQ + i * SZ_KRSQ), REDP};
#ifndef NO_UKV
                  pg8::gemm_phase<pg8::EpiUKV, pg8::StaticOrder, true, true>(F.lds, g, S, E, F.wave);
#endif
                }
                SEAM(pid(l, 3));
            }
            REPS(9) if (EN(9) && RUN(pid(l, 5))) { phase_odd_attn(F, (const bf16*)(WSP + B_QC), (const bf16*)(WSP + B_KN), (const bf16*)(WSP + B_KV), rep_ == 0 ? CB : (bf16*)(WSP + WS_BIG + 420 * MiB), rep_ PT_ARG); SEAM(pid(l, 5)); }
        }
        REPS(10) if (EN(10) && RUN(pid(l, 6))) {
            const int i = F.l >> 1;
            const bf16* Wt = (F.l & 1) ? (const bf16*)(WSP + W_O + i * SZ_DD) : (const bf16*)(WSP + W_OUT_AB + i * SZ_DD);
            pg8::Gemm g{CB, Wt, NTOK, D, D}; pg8::StaticOrder S; S.init(NTOK, D, F.G, (int)blockIdx.x);
            pg8::EpiYX E{rep_ == 0 ? X16P : (_Float16*)(WSP + WS_BIG + 320 * MiB), MODL + 2 * 2048};
            pg8::gemm_phase<pg8::EpiYX, pg8::StaticOrder, true, true>(F.lds, g, S, E, F.wave);
            SEAM(pid(l, 6));
        }
        REPS(11) if (EN(11) && RUN(pid(l, 7))) {
            phase_mod(F, (const float*)nullptr, (const float*)nullptr, X16P, kin(9) + (size_t)F.l * D, MODL, 3, HB); SEAM(pid(l, 7)); }
        REPS(12) if (EN(12) && RUN(pid(l, 8))) {
            pg8::Gemm g{HB, (const bf16*)(WSP + W_FFN_IN + F.l * SZ_FFN_IN), NTOK, 2 * DFF, D}; pg8::StaticOrder S; S.init(NTOK, 2 * DFF, F.G, (int)blockIdx.x);
            pg8::EpiSwiGLU E{FB, DFF};
            pg8::gemm_phase<pg8::EpiSwiGLU, pg8::StaticOrder, true, true>(F.lds, g, S, E, F.wave);
            SEAM(pid(l, 8));
        }
        if (EN(13) && RUN(pid(l, 9))) {
            pg8::Gemm g{FB, (const bf16*)(WSP + W_FFN_OUT + F.l * SZ_FFN_OUT), NTOK, D, DFF}; pg8::StaticOrder S; S.init(NTOK, D, F.G, (int)blockIdx.x);
            if (F.l == DEPTH - 1) { pg8::EpiRes E{X16P, XP, MODL + 5 * 2048};
                pg8::gemm_phase<pg8::EpiRes, pg8::StaticOrder, true, true>(F.lds, g, S, E, F.wave); }
            else { pg8::EpiYX E{X16P, MODL + 5 * 2048};
                pg8::gemm_phase<pg8::EpiYX, pg8::StaticOrder, true, true>(F.lds, g, S, E, F.wave); }
            SEAM(pid(l, 9));
        }
    }
#ifdef PROBE_SUB
    if (blockIdx.x == 0) { const unsigned long long t0_ = rt(); while (rt() - t0_ < 4ull * PT.acc) __builtin_amdgcn_s_sleep(8); }
#endif
#ifdef PROBE_SLOT
    if (blockIdx.x == 0) { const unsigned long long t0_ = rt(); while (rt() - t0_ < (unsigned long long)PROBE_MULT * t_acc_) __builtin_amdgcn_s_sleep(8); }
#endif
#undef RUN
#undef SEAM
}

#ifndef MK_ONE_LAUNCH
#define MK_ONE_LAUNCH 1
#endif
extern "C" void kernel_launch(void* const* d_in, const int* in_sizes, int n_in, void* d_out, int out_size, void* d_ws, size_t ws_size, hipStream_t stream) {
    static int grid = 0;
    if (grid == 0) {
        if (n_in != 28 || (size_t)out_size != O_END || ws_size < WS_END) { fprintf(stderr, "kernel_launch: unexpected shapes: n_in %d out %d ws %zu (need %zu)\n", n_in, out_size, ws_size, (size_t)WS_END); grid = -1; return; }
        int dev = 0, cus = 0, per_cu = 0;
        if (hipGetDevice(&dev) != hipSuccess || hipDeviceGetAttribute(&cus, hipDeviceAttributeMultiprocessorCount, dev) != hipSuccess) { grid = -1; return; }
        if (hipFuncSetAttribute((const void*)fwd_kernel, hipFuncAttributeMaxDynamicSharedMemorySize, LDS_BYTES) != hipSuccess) { fprintf(stderr, "kernel_launch: hipFuncSetAttribute failed\n"); grid = -1; return; }
        if (hipOccupancyMaxActiveBlocksPerMultiprocessor(&per_cu, (const void*)fwd_kernel, NWAVES * 64, LDS_BYTES) != hipSuccess || per_cu < 1) { fprintf(stderr, "kernel_launch: occupancy query says %d blocks per CU\n", per_cu); }
        (void)hipGetLastError();
        grid = cus;
    }
    if (grid < 0) return;
    (void)in_sizes;
    if (hipMemsetAsync((char*)d_ws + WS_CTL, 0, CTL_ZERO_BYTES, stream) != hipSuccess) { fprintf(stderr, "kernel_launch: memset failed\n"); return; }
    Args a{};
    for (int k = 0; k < 28; ++k) a.in[k] = (const float*)d_in[k];
    a.out = (float*)d_out; a.ws = (unsigned char*)d_ws;
#if MK_ONE_LAUNCH
    a.ph_lo = 0; a.ph_hi = PH_END;
    hipLaunchKernelGGL(fwd_kernel, dim3(grid), dim3(NWAVES * 64), LDS_BYTES, stream, a);
#else
    for (int p = 0; p < PH_END; ++p) {
        if (p > 0) { const int l = (p - 1) / 10, s = (p - 1) % 10; if ((l & 1) == 0 && (s == 2 || s == 3 || s == 4)) continue; if ((l & 1) == 1 && (s == 2 || s == 4)) continue; }
        a.ph_lo = p; a.ph_hi = p + 1;
        hipLaunchKernelGGL(fwd_kernel, dim3(grid), dim3(NWAVES * 64), LDS_BYTES, stream, a);
    }
#endif
    const hipError_t le = hipPeekAtLastError();
    if (le != hipSuccess) fprintf(stderr, "kernel_launch: launch failed: %s\n", hipGetErrorName(le));
}
```

```cpp
#include <hip/hip_runtime.h>
#include <cstdio>
#include <cstdint>
#include <cstddef>
__device__ __forceinline__ int lane_id_fresh() { int l = (int)__builtin_amdgcn_mbcnt_hi(~0u, __builtin_amdgcn_mbcnt_lo(~0u, 0u)); asm volatile("" : "+v"(l)); return l; }
namespace pg8 {
#define PG8_LAS __attribute__((address_space(3)))
typedef unsigned short bf16_t;
typedef short bf16x8 __attribute__((ext_vector_type(8)));
typedef float f32x4 __attribute__((ext_vector_type(4)));
typedef unsigned u32x4 __attribute__((ext_vector_type(4)));
constexpr int BM = 256, BK = 64, HALF = 128, HTB = HALF * BK * 2  , STAGE_BYTES = 8 * HTB, NXCD = 8, WGM = 8;

__host__ __device__ __forceinline__ int lds_byte(int r, int c) { const int st = (r >> 4) * 2 + (c >> 5), rr = r & 15, cc = c & 31, ob = rr * 64 + cc * 2; return st * 1024 + (ob ^ (((ob >> 9) & 1) << 5)); }
__host__ __device__ __forceinline__ void stage_rc(int b, int& R, int& C) { const int st = b / 1024, sb = b % 1024, swz = sb ^ (((sb >> 9) & 1) << 5); R = (st >> 1) * 16 + swz / 64; C = (st & 1) * 32 + (swz % 64) / 2; }
__host__ __device__ __forceinline__ int perm32(int rho) { const int n = rho >> 4, i = rho & 15; return 8 * (i >> 2) + 4 * n + (i & 3); }

struct Unit { int pm, pn; };
struct Gemm { const bf16_t* A; const bf16_t* Bt; int M, N, K; };

struct StaticOrder {
    int nM, nN, nwg, G, c;
    __host__ __device__ void init(int M, int N, int G_, int c_) { nM = M / BM; nN = N / BM; nwg = nM * nN; G = G_; c = c_; }
    __host__ __device__ bool next(int i, Unit& u) const {
        const long L = (long)i * G + c; if (L >= nwg) return false;
        int wgid = (int)L; { const int q = nwg / NXCD, r = nwg % NXCD, xcd = wgid % NXCD, off = wgid / NXCD; wgid = (xcd < r ? xcd * (q + 1) : r * (q + 1) + (xcd - r) * q) + off; }
        const int nig = WGM * nN, gid = wgid / nig, fm = gid * WGM, gsz = (nM - fm) < WGM ? (nM - fm) : WGM;
        u.pm = fm + ((wgid % nig) % gsz); u.pn = (wgid % nig) / gsz; return true;
    }
    __device__ __forceinline__ void a_ready(const Unit&) const {}
    __device__ __forceinline__ void done(const Unit&) const {}
};
__device__ __forceinline__ unsigned cvt_pk_bf16(float lo, float hi) { unsigned r; asm volatile("v_cvt_pk_bf16_f32 %0, %1, %2" : "=v"(r) : "v"(lo), "v"(hi)); return r; }

__device__ __forceinline__ int cond_of_pm(int pm) { return pm < 32 ? 0 : 1 + ((pm - 32) >> 3); }

struct EpiBf16P {
    static constexpr bool PERM = true, AFTER_DRAIN = false;
    bf16_t* O; int ldc;
    __device__ __forceinline__ void operator()(const f32x4 (&acc)[2][2][4][2], const Unit& u, int wr, int wc, int fr_in, int fq_in) const {
        (void)fr_in; (void)fq_in; const int lane_e = lane_id_fresh(), fr = lane_e & 15, fq = lane_e >> 4;
        const int row0 = u.pm * BM + wr * 64 + fr, col0 = u.pn * BM + wc * 32 + 8 * fq;
#pragma unroll
        for (int ai = 0; ai < 2; ++ai)
#pragma unroll
            for (int m = 0; m < 4; ++m) { bf16_t* rowp = O + (unsigned)(row0 + ai * HALF + m * 16) * (unsigned)ldc + col0;
#pragma unroll
                for (int bj = 0; bj < 2; ++bj) { const f32x4 v0 = acc[ai][bj][m][0], v1 = acc[ai][bj][m][1];
                    u32x4 w; w.x = cvt_pk_bf16(v0[0], v0[1]); w.y = cvt_pk_bf16(v0[2], v0[3]); w.z = cvt_pk_bf16(v1[0], v1[1]); w.w = cvt_pk_bf16(v1[2], v1[3]);
                    *(u32x4*)(rowp + bj * HALF) = w; } }
    }
};
struct EpiF32P {
    static constexpr bool PERM = false, AFTER_DRAIN = false;
    float* C; int ldc;
    __device__ __forceinline__ void operator()(const f32x4 (&acc)[2][2][4][2], const Unit& u, int wr, int wc, int fr_in, int fq_in) const {
        (void)fr_in; (void)fq_in; const int lane_e = lane_id_fresh(), fr = lane_e & 15, fq = lane_e >> 4;
        const int row0 = u.pm * BM + wr * 64 + fr, col0 = u.pn * BM + wc * 32 + 4 * fq;
#pragma unroll
        for (int ai = 0; ai < 2; ++ai)
#pragma unroll
            for (int m = 0; m < 4; ++m) { float* rowp = C + (unsigned)(row0 + ai * HALF + m * 16) * (unsigned)ldc + col0;
#pragma unroll
                for (int bj = 0; bj < 2; ++bj)
#pragma unroll
                    for (int n = 0; n < 2; ++n) *(f32x4*)(rowp + bj * HALF + n * 16) = acc[ai][bj][m][n]; }
    }
};
struct EpiRes {
    static constexpr bool PERM = false, AFTER_DRAIN = false;
    const _Float16* base; float* out; const float* gate;
    __device__ __forceinline__ void operator()(const f32x4 (&acc)[2][2][4][2], const Unit& u, int wr, int wc, int fr_in, int fq_in) const {
        typedef _Float16 h16x4 __attribute__((ext_vector_type(4)));
        (void)fr_in; (void)fq_in; const int lane_e = lane_id_fresh(), fr = lane_e & 15, fq = lane_e >> 4;
        const int row0 = u.pm * BM + wr * 64 + fr, col0 = u.pn * BM + wc * 32 + 4 * fq;
        const float* g = gate + (unsigned)cond_of_pm(u.pm) * 12288u + col0;
        f32x4 gv[2][2];
#pragma unroll
        for (int bj = 0; bj < 2; ++bj)
#pragma unroll
            for (int n = 0; n < 2; ++n) gv[bj][n] = *(const f32x4*)(g + bj * HALF + n * 16);
#pragma unroll
        for (int ai = 0; ai < 2; ++ai)
#pragma unroll
            for (int m = 0; m < 4; ++m) { const unsigned off = (unsigned)(row0 + ai * HALF + m * 16) * 2048u + col0;
#pragma unroll
                for (int bj = 0; bj < 2; ++bj)
#pragma unroll
                    for (int n = 0; n < 2; ++n) { const f32x4 bs = __builtin_convertvector(*(const h16x4*)(base + off + bj * HALF + n * 16), f32x4);
                        *(f32x4*)(out + off + bj * HALF + n * 16) = bs + gv[bj][n] * acc[ai][bj][m][n]; }
                if (m & 1) asm volatile("" ::: "memory"); }
    }
};
__device__ __forceinline__ float silu_f(float x) { return x * __builtin_amdgcn_rcpf(1.0f + __builtin_amdgcn_exp2f(-1.4426950408889634f * x)); }
__device__ __forceinline__ f32x4 swiglu4(const f32x4 g, const f32x4 u) {
    const f32x4 t = g * (-1.4426950408889634f);
    f32x4 d; d[0] = __builtin_amdgcn_exp2f(t[0]); d[1] = __builtin_amdgcn_exp2f(t[1]); d[2] = __builtin_amdgcn_exp2f(t[2]); d[3] = __builtin_amdgcn_exp2f(t[3]);
    d = d + 1.0f;
    f32x4 r; r[0] = __builtin_amdgcn_rcpf(d[0]); r[1] = __builtin_amdgcn_rcpf(d[1]); r[2] = __builtin_amdgcn_rcpf(d[2]); r[3] = __builtin_amdgcn_rcpf(d[3]);
    return (g * u) * r;
}
struct EpiSwiGLU {
    static constexpr bool PERM = true, AFTER_DRAIN = false;
    bf16_t* O; int ldc;
    __device__ __forceinline__ void operator()(const f32x4 (&acc)[2][2][4][2], const Unit& u, int wr, int wc, int fr_in, int fq_in) const {
        (void)fr_in; (void)fq_in; const int lane_e = lane_id_fresh(), fr = lane_e & 15, fq = lane_e >> 4;
        const int row0 = u.pm * BM + wr * 64 + fr, col0 = u.pn * HALF + wc * 32 + 8 * fq;
#pragma unroll
        for (int ai = 0; ai < 2; ++ai)
#pragma unroll
            for (int m = 0; m < 4; ++m) { bf16_t* rowp = O + (unsigned)(row0 + ai * HALF + m * 16) * (unsigned)ldc + col0;
                const f32x4 g0 = acc[ai][0][m][0], g1 = acc[ai][0][m][1], u0 = acc[ai][1][m][0], u1 = acc[ai][1][m][1];
                const f32x4 h0 = swiglu4(g0, u0), h1 = swiglu4(g1, u1);
                u32x4 w; w.x = cvt_pk_bf16(h0[0], h0[1]); w.y = cvt_pk_bf16(h0[2], h0[3]); w.z = cvt_pk_bf16(h1[0], h1[1]); w.w = cvt_pk_bf16(h1[2], h1[3]);
                *(u32x4*)rowp = w; }
    }
};

constexpr float NORM_EPS = 1e-6f;
__device__ __forceinline__ float sum_rows4(float s) {
    const auto a = __builtin_amdgcn_permlane16_swap(__float_as_uint(s), __float_as_uint(s), false, false); s = __uint_as_float(a[0]) + __uint_as_float(a[1]);
    const auto b = __builtin_amdgcn_permlane32_swap(__float_as_uint(s), __float_as_uint(s), false, false); return __uint_as_float(b[0]) + __uint_as_float(b[1]);
}
__device__ __forceinline__ float xor32(float y, bool upper) { const auto b = __builtin_amdgcn_permlane32_swap(__float_as_uint(y), __float_as_uint(y), false, false); return __uint_as_float(upper ? b[0] : b[1]); }
__device__ __forceinline__ void row_half_allreduce(float (&ss)[2][4][2], PG8_LAS float* red, int wr, int wc, int fr, int fq) {
#pragma unroll
    for (int ai = 0; ai < 2; ++ai)
#pragma unroll
        for (int m = 0; m < 4; ++m)
#pragma unroll
            for (int bj = 0; bj < 2; ++bj) ss[ai][m][bj] = sum_rows4(ss[ai][m][bj]);
    if (fq == 0) {
#pragma unroll
        for (int ai = 0; ai < 2; ++ai)
#pragma unroll
            for (int m = 0; m < 4; ++m)
#pragma unroll
                for (int bj = 0; bj < 2; ++bj) red[((ai * HALF + wr * 64 + m * 16 + fr) * 2 + bj) * 4 + wc] = ss[ai][m][bj];
    }
    asm volatile("s_waitcnt lgkmcnt(0)" ::: "memory"); __builtin_amdgcn_s_barrier(); asm volatile("" ::: "memory");
}
__device__ __forceinline__ void row_half_read(const PG8_LAS float* red, int ai, int m, int wr, int fr, float& s0, float& s1) {
    const PG8_LAS f32x4* p = (const PG8_LAS f32x4*)(red + (ai * HALF + wr * 64 + m * 16 + fr) * 8);
    const f32x4 a = p[0], b = p[1]; s0 = (a[0] + a[1]) + (a[2] + a[3]); s1 = (b[0] + b[1]) + (b[2] + b[3]);
}
__device__ __forceinline__ float dot4(const f32x4 a) { return (a[0] * a[0] + a[1] * a[1]) + (a[2] * a[2] + a[3] * a[3]); }
__device__ __forceinline__ u32x4 pack8(const f32x4 a, const f32x4 b) { u32x4 w; w.x = cvt_pk_bf16(a[0], a[1]); w.y = cvt_pk_bf16(a[2], a[3]); w.z = cvt_pk_bf16(b[0], b[1]); w.w = cvt_pk_bf16(b[2], b[3]); return w; }

struct EpiInAB {
    static constexpr bool PERM = true, AFTER_DRAIN = false;
    bf16_t* P; const float* gq; const float* gk; float* natk; float* natv; PG8_LAS float* red;
    __device__ __forceinline__ void operator()(const f32x4 (&acc)[2][2][4][2], const Unit& u, int wr, int wc, int fr_in, int fq_in) const {
        (void)fr_in; (void)fq_in; const int lane_e = lane_id_fresh(), fr = lane_e & 15, fq = lane_e >> 4;
        const int row0 = u.pm * BM + wr * 64 + fr, col0 = u.pn * BM + wc * 32 + 8 * fq, dh = wc * 32 + 8 * fq;
        if (u.pn < 8) {
            float ss[2][4][2];
#pragma unroll
            for (int ai = 0; ai < 2; ++ai)
#pragma unroll
                for (int m = 0; m < 4; ++m)
#pragma unroll
                    for (int bj = 0; bj < 2; ++bj) ss[ai][m][bj] = dot4(acc[ai][bj][m][0]) + dot4(acc[ai][bj][m][1]);
            row_half_allreduce(ss, red, wr, wc, fr, fq);
            const float* g = (u.pn < 4 ? gq : gk) + dh; const f32x4 g0 = *(const f32x4*)g, g1 = *(const f32x4*)(g + 4);
            const bool emit = u.pn >= 4 && u.pm < 32;
#pragma unroll
            for (int ai = 0; ai < 2; ++ai)
#pragma unroll
                for (int m = 0; m < 4; ++m) { bf16_t* rowp = P + (unsigned)(row0 + ai * HALF + m * 16) * 6144u + col0;
                    float st[2]; row_half_read(red, ai, m, wr, fr, st[0], st[1]);
#pragma unroll
                    for (int bj = 0; bj < 2; ++bj) { const float rstd = __builtin_amdgcn_rsqf(st[bj] * (1.0f / 128.0f) + NORM_EPS);
                        const f32x4 y0 = acc[ai][bj][m][0] * rstd * g0, y1 = acc[ai][bj][m][1] * rstd * g1;
                        *(u32x4*)(rowp + bj * HALF) = pack8(y0, y1);
                        if (emit) { const int h = (u.pn - 4) * 2 + bj, t = ai * HALF + wr * 64 + m * 16 + fr; float* dst = natk + ((unsigned)(u.pm * 16 + h) * 256u + (unsigned)t) * 128u + dh;
                            *(f32x4*)dst = y0; *(f32x4*)(dst + 4) = y1; } }
                    asm volatile("" ::: "memory"); }
        } else {
            const bool emit = u.pn < 12 && u.pm < 32;
#pragma unroll
            for (int ai = 0; ai < 2; ++ai)
#pragma unroll
                for (int m = 0; m < 4; ++m) { bf16_t* rowp = P + (unsigned)(row0 + ai * HALF + m * 16) * 6144u + col0;
#pragma unroll
                    for (int bj = 0; bj < 2; ++bj) { const f32x4 y0 = acc[ai][bj][m][0], y1 = acc[ai][bj][m][1];
                        *(u32x4*)(rowp + bj * HALF) = pack8(y0, y1);
                        if (emit) { const int h = (u.pn - 8) * 2 + bj, t = ai * HALF + wr * 64 + m * 16 + fr; float* dst = natv + ((unsigned)(u.pm * 16 + h) * 256u + (unsigned)t) * 128u + dh;
                            *(f32x4*)dst = y0; *(f32x4*)(dst + 4) = y1; } } }
        }
    }
};
struct EpiUQ {
    static constexpr bool PERM = true, AFTER_DRAIN = false;
    bf16_t* Qn; const float* gq; const float* CQP; float* QSQ;
    __device__ __forceinline__ void operator()(const f32x4 (&acc)[2][2][4][2], const Unit& u, int wr, int wc, int fr_in, int fq_in) const {
        (void)fr_in; (void)fq_in; const int lane_e = lane_id_fresh(), fr = lane_e & 15, fq = lane_e >> 4;
        const int row0 = u.pm * BM + wr * 64 + fr;
        float rq[2][4];
#pragma unroll
        for (int ai = 0; ai < 2; ++ai)
#pragma unroll
            for (int m = 0; m < 4; ++m) { const float* cp = CQP + (unsigned)(row0 + ai * HALF + m * 16) * 8u; const f32x4 a = *(const f32x4*)cp, b = *(const f32x4*)(cp + 4);
                rq[ai][m] = __builtin_amdgcn_rsqf((((a[0] + a[1]) + (a[2] + a[3])) + ((b[0] + b[1]) + (b[2] + b[3]))) * (1.0f / 512.0f) + NORM_EPS); }
        const bool lat = u.pm >= 32; const int jf = 8 * (fq & 1); const bool isx2 = (fq >> 1) != 0;
        f32x4 fr0, fr1;
#pragma unroll
        for (int e4 = 0; e4 < 4; ++e4) { fr0[e4] = exp2f(-(float)(jf + e4) * (13.287712379549449f / 16.0f)) * 0.15915494309189535f; fr1[e4] = exp2f(-(float)(jf + 4 + e4) * (13.287712379549449f / 16.0f)) * 0.15915494309189535f; }
#pragma unroll
        for (int bj = 0; bj < 2; ++bj) {
            const int blk = 4 * u.pn + 2 * bj + (wc >> 1), hd = blk / 3, part = blk - 3 * hd;
            const int dh = part * 64 + (wc & 1) * 32 + 8 * fq;
            const f32x4 g0 = *(const f32x4*)(gq + dh), g1 = *(const f32x4*)(gq + dh + 4);
            const bool rope = part == 2 && lat;
#pragma unroll
            for (int ai = 0; ai < 2; ++ai)
#pragma unroll
                for (int m = 0; m < 4; ++m) { const unsigned row = (unsigned)(row0 + ai * HALF + m * 16);
                    const f32x4 q0 = acc[ai][bj][m][0] * rq[ai][m], q1 = acc[ai][bj][m][1] * rq[ai][m];
                    const float s = sum_rows4(dot4(q0) + dot4(q1));
                    if (fq == 0) QSQ[row * 96u + 2 * blk + (wc & 1)] = s;
                    f32x4 y0 = q0 * g0, y1 = q1 * g1;
                    if (rope) {
                        const int t = ((int)row - 8192) & 2047; const float pos = (float)((wc & 1) ? (t & 63) : (t >> 6));
                        f32x4 c0, c1, s0, s1, p0, p1;
#pragma unroll
                        for (int e4 = 0; e4 < 4; ++e4) { c0[e4] = __builtin_amdgcn_cosf(pos * fr0[e4]); s0[e4] = __builtin_amdgcn_sinf(pos * fr0[e4]); c1[e4] = __builtin_amdgcn_cosf(pos * fr1[e4]); s1[e4] = __builtin_amdgcn_sinf(pos * fr1[e4]); }
#pragma unroll
                        for (int e4 = 0; e4 < 4; ++e4) { p0[e4] = xor32(y0[e4], isx2); p1[e4] = xor32(y1[e4], isx2); }
                        if (isx2) { y0 = p0 * s0 + y0 * c0; y1 = p1 * s1 + y1 * c1; } else { y0 = y0 * c0 - p0 * s0; y1 = y1 * c1 - p1 * s1; }
                    }
                    *(u32x4*)(Qn + row * 3072u + u.pn * BM + bj * HALF + wc * 32 + 8 * fq) = pack8(y0, y1);
                    asm volatile("" ::: "memory"); }
        }
    }
};
struct EpiUKV {
    static constexpr bool PERM = true, AFTER_DRAIN = false;
    bf16_t* Kn; bf16_t* Vn; const float* gk; const float* RK; const float* KRSQ; PG8_LAS float* red;
    __device__ __forceinline__ void operator()(const f32x4 (&acc)[2][2][4][2], const Unit& u, int wr, int wc, int fr_in, int fq_in) const {
        typedef unsigned u32x2v __attribute__((ext_vector_type(2)));
        (void)fr_in; (void)fq_in; const int lane_e = lane_id_fresh(), fr = lane_e & 15, fq = lane_e >> 4;
        const int row0 = u.pm * BM + wr * 64 + fr, dh = wc * 32 + 8 * fq, kc = wc * 16 + 4 * fq;
        f32x4 rk[2][4]; float ksq[2][4];
#pragma unroll
        for (int ai = 0; ai < 2; ++ai)
#pragma unroll
            for (int m = 0; m < 4; ++m) { const unsigned row = (unsigned)(row0 + ai * HALF + m * 16); rk[ai][m] = *(const f32x4*)(RK + row * 64u + kc); ksq[ai][m] = KRSQ[row]; }
        const f32x4 ga0 = *(const f32x4*)(gk + dh), ga1 = *(const f32x4*)(gk + dh + 4);
        float ss[2][4][2];
#pragma unroll
        for (int ai = 0; ai < 2; ++ai)
#pragma unroll
            for (int m = 0; m < 4; ++m) { ss[ai][m][0] = dot4(acc[ai][0][m][0]) + dot4(acc[ai][0][m][1]); ss[ai][m][1] = 0.f; }
        row_half_allreduce(ss, red, wr, wc, fr, fq);
#pragma unroll
        for (int ai = 0; ai < 2; ++ai)
#pragma unroll
            for (int m = 0; m < 4; ++m) { const unsigned row = (unsigned)(row0 + ai * HALF + m * 16); bf16_t* rowp = Kn + row * 3072u + u.pn * 192;
                float st0, st1; row_half_read(red, ai, m, wr, fr, st0, st1);
                const float rstd = __builtin_amdgcn_rsqf((st0 + ksq[ai][m]) * (1.0f / 192.0f) + NORM_EPS);
                *(u32x4*)(rowp + dh) = pack8(acc[ai][0][m][0] * rstd * ga0, acc[ai][0][m][1] * rstd * ga1);
                *(u32x4*)(Vn + row * 2048u + u.pn * 128 + dh) = pack8(acc[ai][1][m][0], acc[ai][1][m][1]);
                const f32x4 y = rk[ai][m] * rstd; u32x2v w; w.x = cvt_pk_bf16(y[0], y[1]); w.y = cvt_pk_bf16(y[2], y[3]);
                *(u32x2v*)(rowp + 128 + kc) = w; }
    }
};
struct EpiYX {
    static constexpr bool PERM = true, AFTER_DRAIN = false;
    _Float16* X; const float* gate;
    __device__ __forceinline__ void operator()(const f32x4 (&acc)[2][2][4][2], const Unit& u, int wr, int wc, int fr_in, int fq_in) const {
        typedef _Float16 h16x4 __attribute__((ext_vector_type(4)));
        typedef _Float16 h16x8 __attribute__((ext_vector_type(8)));
        (void)fr_in; (void)fq_in; const int lane_e = lane_id_fresh(), fr = lane_e & 15, fq = lane_e >> 4;
        const int row0 = u.pm * BM + wr * 64 + fr, col0 = u.pn * BM + wc * 32 + 8 * fq;
        const float* g = gate + (unsigned)cond_of_pm(u.pm) * 12288u + col0;
        _Float16* xb = X + (unsigned)row0 * 2048u + col0;
        h16x8 xr[2][4][2];
#pragma unroll
        for (int ai = 0; ai < 2; ++ai)
#pragma unroll
            for (int m = 0; m < 4; ++m)
#pragma unroll
                for (int bj = 0; bj < 2; ++bj) xr[ai][m][bj] = *(const h16x8*)(xb + (unsigned)(ai * HALF + m * 16) * 2048u + bj * HALF);
        f32x4 gv[2][2];
#pragma unroll
        for (int bj = 0; bj < 2; ++bj)
#pragma unroll
            for (int n = 0; n < 2; ++n) gv[bj][n] = *(const f32x4*)(g + bj * HALF + n * 4);
        asm volatile("" ::: "memory");
#pragma unroll
        for (int ai = 0; ai < 2; ++ai)
#pragma unroll
            for (int m = 0; m < 4; ++m)
#pragma unroll
                for (int bj = 0; bj < 2; ++bj) {
                    const f32x4 x0 = __builtin_convertvector(__builtin_shufflevector(xr[ai][m][bj], xr[ai][m][bj], 0, 1, 2, 3), f32x4) + acc[ai][bj][m][0] * gv[bj][0];
                    const f32x4 x1 = __builtin_convertvector(__builtin_shufflevector(xr[ai][m][bj], xr[ai][m][bj], 4, 5, 6, 7), f32x4) + acc[ai][bj][m][1] * gv[bj][1];
                    const h16x4 h0 = __builtin_convertvector(x0, h16x4), h1 = __builtin_convertvector(x1, h16x4);
                    *(h16x8*)(xb + (unsigned)(ai * HALF + m * 16) * 2048u + bj * HALF) = __builtin_shufflevector(h0, h1, 0, 1, 2, 3, 4, 5, 6, 7); }
    }
};
struct EpiDown {
    static constexpr bool PERM = true, AFTER_DRAIN = false;
    bf16_t* cqn; float* CQP; bf16_t* ckvn; const float* gckv; float* out_ckv; float* out_kr; const float* gkr; float* RK; float* KRSQ; PG8_LAS float* red;
    __device__ __forceinline__ void operator()(const f32x4 (&acc)[2][2][4][2], const Unit& u, int wr, int wc, int fr_in, int fq_in) const {
        (void)fr_in; (void)fq_in; const int lane_e = lane_id_fresh(), fr = lane_e & 15, fq = lane_e >> 4;
        const int row0 = u.pm * BM + wr * 64 + fr, dh = wc * 32 + 8 * fq;
        if (u.pn < 2) {
#pragma unroll
            for (int ai = 0; ai < 2; ++ai)
#pragma unroll
                for (int m = 0; m < 4; ++m) { const unsigned row = (unsigned)(row0 + ai * HALF + m * 16);
                    float s = (dot4(acc[ai][0][m][0]) + dot4(acc[ai][0][m][1])) + (dot4(acc[ai][1][m][0]) + dot4(acc[ai][1][m][1]));
                    s = sum_rows4(s);
                    if (fq == 0) CQP[row * 8u + u.pn * 4 + wc] = s;
#pragma unroll
                    for (int bj = 0; bj < 2; ++bj) *(u32x4*)(cqn + row * 512u + u.pn * 256 + bj * HALF + dh) = pack8(acc[ai][bj][m][0], acc[ai][bj][m][1]); }
        } else if (u.pn == 2) {
            float ss[2][4][2];
#pragma unroll
            for (int ai = 0; ai < 2; ++ai)
#pragma unroll
                for (int m = 0; m < 4; ++m)
#pragma unroll
                    for (int bj = 0; bj < 2; ++bj) ss[ai][m][bj] = dot4(acc[ai][bj][m][0]) + dot4(acc[ai][bj][m][1]);
            row_half_allreduce(ss, red, wr, wc, fr, fq);
            f32x4 g[2][2];
#pragma unroll
            for (int bj = 0; bj < 2; ++bj) { g[bj][0] = *(const f32x4*)(gckv + bj * HALF + dh); g[bj][1] = *(const f32x4*)(gckv + bj * HALF + dh + 4); }
#pragma unroll
            for (int ai = 0; ai < 2; ++ai)
#pragma unroll
                for (int m = 0; m < 4; ++m) { const unsigned row = (unsigned)(row0 + ai * HALF + m * 16);
                    float st0, st1; row_half_read(red, ai, m, wr, fr, st0, st1);
                    const float rstd = __builtin_amdgcn_rsqf((st0 + st1) * (1.0f / 256.0f) + NORM_EPS);
#pragma unroll
                    for (int bj = 0; bj < 2; ++bj) { const f32x4 y0 = acc[ai][bj][m][0] * rstd * g[bj][0], y1 = acc[ai][bj][m][1] * rstd * g[bj][1];
                        *(u32x4*)(ckvn + row * 256u + bj * HALF + dh) = pack8(y0, y1);
                        if (u.pm < 32) { float* dst = out_ckv + ((unsigned)(u.pm * 2) * 256u + (unsigned)(ai * HALF + wr * 64 + m * 16 + fr)) * 256u + bj * HALF + dh; *(f32x4*)dst = y0; *(f32x4*)(dst + 4) = y1; } }
                    asm volatile("" ::: "memory"); }
        } else {
            const bool mine = wc < 2;
            float ss[2][4][2];
#pragma unroll
            for (int ai = 0; ai < 2; ++ai)
#pragma unroll
                for (int m = 0; m < 4; ++m) { ss[ai][m][0] = mine ? dot4(acc[ai][0][m][0]) + dot4(acc[ai][0][m][1]) : 0.f; ss[ai][m][1] = 0.f; }
            row_half_allreduce(ss, red, wr, wc, fr, fq);
            f32x4 g0 = {0.f, 0.f, 0.f, 0.f}, g1 = {0.f, 0.f, 0.f, 0.f};
            if (mine) { g0 = *(const f32x4*)(gkr + dh); g1 = *(const f32x4*)(gkr + dh + 4); }
            const bool lat = u.pm >= 32; const int jf = 8 * (fq & 1); const bool isx2 = (fq >> 1) != 0;
            f32x4 fr0, fr1;
#pragma unroll
            for (int e4 = 0; e4 < 4; ++e4) { fr0[e4] = exp2f(-(float)(jf + e4) * (13.287712379549449f / 16.0f)) * 0.15915494309189535f; fr1[e4] = exp2f(-(float)(jf + 4 + e4) * (13.287712379549449f / 16.0f)) * 0.15915494309189535f; }
#pragma unroll
            for (int ai = 0; ai < 2; ++ai)
#pragma unroll
                for (int m = 0; m < 4; ++m) { const unsigned row = (unsigned)(row0 + ai * HALF + m * 16);
                    float st0, st1; row_half_read(red, ai, m, wr, fr, st0, st1);
                    if (wc == 0 && fq == 0) KRSQ[row] = st0;
                    const f32x4 k0 = acc[ai][0][m][0], k1 = acc[ai][0][m][1];
                    if (mine && u.pm < 32) { float* dst = out_kr + ((unsigned)(u.pm * 2) * 256u + (unsigned)(ai * HALF + wr * 64 + m * 16 + fr)) * 64u + dh; *(f32x4*)dst = k0; *(f32x4*)(dst + 4) = k1; }
                    f32x4 y0 = k0 * g0, y1 = k1 * g1;
                    if (lat && mine) {
                        const int t = ((int)row - 8192) & 2047; const float pos = (float)(wc ? (t & 63) : (t >> 6));
                        f32x4 c0, c1, s0, s1, p0, p1;
#pragma unroll
                        for (int e4 = 0; e4 < 4; ++e4) { c0[e4] = __builtin_amdgcn_cosf(pos * fr0[e4]); s0[e4] = __builtin_amdgcn_sinf(pos * fr0[e4]); c1[e4] = __builtin_amdgcn_cosf(pos * fr1[e4]); s1[e4] = __builtin_amdgcn_sinf(pos * fr1[e4]); }
#pragma unroll
                        for (int e4 = 0; e4 < 4; ++e4) { p0[e4] = xor32(y0[e4], isx2); p1[e4] = xor32(y1[e4], isx2); }
                        if (isx2) { y0 = p0 * s0 + y0 * c0; y1 = p1 * s1 + y1 * c1; } else { y0 = y0 * c0 - p0 * s0; y1 = y1 * c1 - p1 * s1; }
                    }
                    if (mine) { float* dst = RK + row * 64u + dh; *(f32x4*)dst = y0; *(f32x4*)(dst + 4) = y1; }
                    asm volatile("" ::: "memory"); }
        }
    }
};
template <class Epi, class Sched, bool ALIGN_EPI = false, bool SP2 = false>
__device__ __forceinline__ void gemm_phase(PG8_LAS unsigned char* lds, const Gemm g, const Sched& S, const Epi& E, const int wid_in) {
    const int tid_ = wid_in * 64 + lane_id_fresh();
    const int tid = tid_, wid = wid_in, lane = tid & 63, wr = wid >> 2, wc = wid & 3, fr = lane & 15, fq = lane >> 4;
    int K_ = g.K; asm volatile("" : "+s"(K_));
    const int K = K_, nt = K / BK;
    unsigned voffA[2], voffB[2];
#pragma unroll
    for (int i = 0; i < 2; ++i) { int R, C; stage_rc(tid * 16 + i * 8192, R, C); const int Rb = Epi::PERM ? ((R & ~31) + perm32(R & 31)) : R;
        voffA[i] = (unsigned)(R * K + C) * 2u; voffB[i] = (unsigned)(Rb * K + C) * 2u; }
    const size_t kstep = (size_t)(BK * 2);
    const size_t hstep = (size_t)HALF * K * 2;
    const size_t tstep = 2 * hstep;
    const unsigned ldsw = (unsigned)wid * 1024u;
    const int aoff = lds_byte(wr * 64 + fr, fq * 8), boff = lds_byte(wc * 32 + fr, fq * 8);
#define PG8_SA(b, h) (((b) * 2 + (h)) * HTB)
#define PG8_SB(b, h) ((4 + (b) * 2 + (h)) * HTB)
#define PG8_STAGE(bufoff, gbase, voff) do { _Pragma("unroll") for (int _i = 0; _i < 2; ++_i) \
        __builtin_amdgcn_global_load_lds((const unsigned*)((const char*)(gbase) + (voff)[_i]), (PG8_LAS unsigned*)(lds + (bufoff) + ldsw + _i * 8192), 16, 0, 0); } while (0)
#define PG8_LDA(dst, b, h) do { _Pragma("unroll") for (int m = 0; m < 4; ++m) _Pragma("unroll") for (int k = 0; k < 2; ++k) dst[m][k] = *(const PG8_LAS bf16x8*)(lds + PG8_SA(b, h) + aoff + m * 2048 + k * 1024); } while (0)
#define PG8_LDB(dst, b, h) do { _Pragma("unroll") for (int n = 0; n < 2; ++n) _Pragma("unroll") for (int k = 0; k < 2; ++k) dst[n][k] = *(const PG8_LAS bf16x8*)(lds + PG8_SB(b, h) + boff + n * 2048 + k * 1024); } while (0)
#define PG8_MMA(ai, bj, At, Bt) do { __builtin_amdgcn_s_setprio(1); _Pragma("unroll") for (int m = 0; m < 4; ++m) _Pragma("unroll") for (int n = 0; n < 2; ++n) _Pragma("unroll") for (int k = 0; k < 2; ++k) \
        acc[ai][bj][m][n] = __builtin_amdgcn_mfma_f32_16x16x32_bf16(Bt[n][k], At[m][k], acc[ai][bj][m][n], 0, 0, 0); __builtin_amdgcn_s_setprio(0); } while (0)
#define PG8_WAIT_V(n) asm volatile("s_waitcnt vmcnt(" #n ")" ::: "memory")
#define PG8_WAIT_L(n) asm volatile("s_waitcnt lgkmcnt(" #n ")" ::: "memory")
#define PG8_BAR __builtin_amdgcn_s_barrier()
#define PG8_SCHED __builtin_amdgcn_sched_barrier(0)
    Unit cur, nxt; int ui = 0;
    if (!S.next(0, cur)) return;
    f32x4 acc[2][2][4][2];
#pragma unroll
    for (int a = 0; a < 2; ++a)
#pragma unroll
        for (int b = 0; b < 2; ++b)
#pragma unroll
            for (int m = 0; m < 4; ++m)
#pragma unroll
                for (int n = 0; n < 2; ++n) acc[a][b][m][n] = (f32x4){0.f, 0.f, 0.f, 0.f};
    bf16x8 At[4][2], B0[2][2], B1[2][2];
    const char* cA = (const char*)g.A + (size_t)cur.pm * tstep; const char* cB = (const char*)g.Bt + (size_t)cur.pn * tstep;
    S.a_ready(cur);
    if constexpr (SP2) {
        PG8_STAGE(PG8_SB(0, 0), cB, voffB); PG8_STAGE(PG8_SB(0, 1), cB + hstep, voffB); PG8_STAGE(PG8_SA(0, 0), cA, voffA); PG8_STAGE(PG8_SA(0, 1), cA + hstep, voffA);
        if (wr == 1) PG8_BAR;
        PG8_WAIT_V(2); PG8_BAR;
        PG8_STAGE(PG8_SB(1, 0), cB + kstep, voffB); PG8_STAGE(PG8_SA(1, 0), cA + kstep, voffA); PG8_STAGE(PG8_SB(1, 1), cB + hstep + kstep, voffB);
        PG8_WAIT_V(6); PG8_BAR;
    } else {
        PG8_STAGE(PG8_SB(0, 0), cB, voffB); PG8_STAGE(PG8_SA(0, 0), cA, voffA); PG8_STAGE(PG8_SB(0, 1), cB + hstep, voffB); PG8_STAGE(PG8_SA(0, 1), cA + hstep, voffA);
        if (wr == 1) PG8_BAR;
        PG8_WAIT_V(4); PG8_BAR;
        PG8_STAGE(PG8_SB(1, 0), cB + kstep, voffB); PG8_STAGE(PG8_SA(1, 0), cA + kstep, voffA); PG8_STAGE(PG8_SB(1, 1), cB + hstep + kstep, voffB);
        PG8_WAIT_V(6); PG8_BAR;
    }
    for (;;) {
        const bool has_next = S.next(ui + 1, nxt);
        const char* nA = has_next ? (const char*)g.A + (size_t)nxt.pm * tstep : cA; const char* nB = has_next ? (const char*)g.Bt + (size_t)nxt.pn * tstep : cB;
        for (int t = 0; t < nt; t += 2) {
            const bool last = (t == nt - 2);
            const char* a1 = cA + (size_t)(t + 1) * kstep;
            const char* a2 = last ? nA : cA + (size_t)(t + 2) * kstep; const char* b2 = last ? nB : cB + (size_t)(t + 2) * kstep;
            const char* a3 = a2 + kstep; const char* b3 = b2 + kstep;
            if (last && has_next) S.a_ready(nxt);
            if constexpr (SP2) {
            PG8_LDB(B0, 0, 0); PG8_LDB(B1, 0, 1); PG8_SCHED; PG8_LDA(At, 0, 0); PG8_STAGE(PG8_SA(1, 1), a1 + hstep, voffA);
            PG8_WAIT_V(8); PG8_WAIT_L(0); PG8_BAR; PG8_MMA(0, 0, At, B0); PG8_MMA(0, 1, At, B1); PG8_BAR; PG8_SCHED;
            PG8_LDA(At, 0, 1); PG8_STAGE(PG8_SB(0, 0), b2, voffB); PG8_STAGE(PG8_SB(0, 1), b2 + hstep, voffB); PG8_STAGE(PG8_SA(0, 0), a2, voffA);
            PG8_WAIT_V(8); PG8_WAIT_L(0); PG8_BAR; PG8_MMA(1, 0, At, B0); PG8_MMA(1, 1, At, B1); PG8_BAR; PG8_SCHED;
            PG8_LDB(B0, 1, 0); PG8_LDB(B1, 1, 1); PG8_SCHED; PG8_LDA(At, 1, 0); PG8_STAGE(PG8_SA(0, 1), a2 + hstep, voffA);
            PG8_WAIT_V(8); PG8_WAIT_L(0); PG8_BAR; PG8_MMA(0, 0, At, B0); PG8_MMA(0, 1, At, B1); PG8_BAR; PG8_SCHED;
            PG8_LDA(At, 1, 1); PG8_STAGE(PG8_SB(1, 0), b3, voffB); PG8_STAGE(PG8_SB(1, 1), b3 + hstep, voffB); PG8_STAGE(PG8_SA(1, 0), a3, voffA);
            PG8_WAIT_V(8); PG8_WAIT_L(0); PG8_BAR; PG8_MMA(1, 0, At, B0); PG8_MMA(1, 1, At, B1); PG8_BAR; PG8_SCHED;
            } else {
            PG8_LDB(B0, 0, 0); PG8_SCHED; PG8_LDA(At, 0, 0); PG8_STAGE(PG8_SA(1, 1), a1 + hstep, voffA);
            PG8_WAIT_L(8); PG8_BAR; PG8_WAIT_L(0); PG8_MMA(0, 0, At, B0); PG8_BAR; PG8_SCHED;
            PG8_LDB(B1, 0, 1); PG8_STAGE(PG8_SB(0, 0), b2, voffB);
            PG8_BAR; PG8_WAIT_L(0); PG8_MMA(0, 1, At, B1); PG8_BAR;
            PG8_LDA(At, 0, 1); PG8_STAGE(PG8_SA(0, 0), a2, voffA);
            PG8_BAR; PG8_WAIT_L(0); PG8_MMA(1, 0, At, B0); PG8_BAR; PG8_SCHED;
            PG8_STAGE(PG8_SB(0, 1), b2 + hstep, voffB);
            PG8_WAIT_V(6); PG8_BAR; PG8_MMA(1, 1, At, B1); PG8_BAR;
            PG8_LDB(B0, 1, 0); PG8_SCHED; PG8_LDA(At, 1, 0); PG8_STAGE(PG8_SA(0, 1), a2 + hstep, voffA);
            PG8_WAIT_L(8); PG8_BAR; PG8_WAIT_L(0); PG8_MMA(0, 0, At, B0); PG8_BAR; PG8_SCHED;
            PG8_LDB(B1, 1, 1); PG8_STAGE(PG8_SB(1, 0), b3, voffB);
            PG8_BAR; PG8_WAIT_L(0); PG8_MMA(0, 1, At, B1); PG8_BAR;
            PG8_LDA(At, 1, 1); PG8_STAGE(PG8_SA(1, 0), a3, voffA);
            PG8_BAR; PG8_WAIT_L(0); PG8_MMA(1, 0, At, B0); PG8_BAR; PG8_SCHED;
            PG8_STAGE(PG8_SB(1, 1), b3 + hstep, voffB);
            PG8_WAIT_V(6); PG8_BAR; PG8_MMA(1, 1, At, B1); PG8_BAR;
            }
        }
        if constexpr (ALIGN_EPI) { if (wr == 0) PG8_BAR; }
        if constexpr (!Epi::AFTER_DRAIN) { E(acc, cur, wr, wc, fr, fq); S.done(cur); }
        if (!has_next) break;
#pragma unroll
        for (int a = 0; a < 2; ++a)
#pragma unroll
            for (int b = 0; b < 2; ++b)
#pragma unroll
                for (int m = 0; m < 4; ++m)
#pragma unroll
                    for (int n = 0; n < 2; ++n) acc[a][b][m][n] = (f32x4){0.f, 0.f, 0.f, 0.f};
        cur = nxt; cA = nA; cB = nB; ++ui;
        if constexpr (ALIGN_EPI) { if (wr == 1) PG8_BAR; }
    }
    PG8_WAIT_V(0);
    if constexpr (!ALIGN_EPI) { if (wr == 0) PG8_BAR; }
    PG8_BAR;
    if constexpr (Epi::AFTER_DRAIN) { E.fused(acc, cur, wr, wc, fr, fq, lds, wid, lane); S.done(cur); }
#undef PG8_SA
#undef PG8_SB
#undef PG8_STAGE
#undef PG8_LDA
#undef PG8_LDB
#undef PG8_MMA
#undef PG8_WAIT_V
#undef PG8_WAIT_L
#undef PG8_BAR
#undef PG8_SCHED
}
}
#define GAS __attribute__((address_space(1)))
#define LAS __attribute__((address_space(3)))
typedef unsigned short bf16;
typedef unsigned v4u __attribute__((ext_vector_type(4)));
typedef float f32x4 __attribute__((ext_vector_type(4)));
typedef short bf16x8 __attribute__((ext_vector_type(8)));
typedef GAS unsigned gu32;
typedef GAS unsigned long long gu64;
#define RLX_AGENT __ATOMIC_RELAXED, __HIP_MEMORY_SCOPE_AGENT
#define LDS_WAIT() asm volatile("s_waitcnt lgkmcnt(0)" ::: "memory")
#define VM_WAIT() asm volatile("s_waitcnt vmcnt(0)" ::: "memory")
__device__ __forceinline__ unsigned long long rt() { return __builtin_amdgcn_s_memrealtime(); }
__device__ __forceinline__ unsigned f2bf(float f) { unsigned u = __builtin_bit_cast(unsigned, f); return (u + 0x7fffu + ((u >> 16) & 1u)) >> 16; }
__device__ __forceinline__ unsigned pk2(float lo, float hi) { return f2bf(lo) | (f2bf(hi) << 16); }
#define XB_TMO      128
#define XB_XCNT(j)  (256  + 64 * (j))
#define XB_XSUB(j)  (1280 + 64 * (j))
#define XB_XGEN(j)  (2304 + 64 * (j))
#define XB_TOP      3328
#define XB_TOPGEN   3392
#define XCD_BAR_WORDS 3456
#define XB_SPIN_CAP (1u << 18)

__device__ __forceinline__ unsigned xb_ld(unsigned* p)              { return __hip_atomic_load(p, __ATOMIC_RELAXED, __HIP_MEMORY_SCOPE_AGENT); }
__device__ __forceinline__ unsigned xb_add(unsigned* p, unsigned v) { return __hip_atomic_fetch_add(p, v, __ATOMIC_RELAXED, __HIP_MEMORY_SCOPE_AGENT); }
__device__ __forceinline__ unsigned xb_xcc_id() { return (unsigned)__builtin_amdgcn_s_getreg((3 << 11) | 20) & 0xFu; }
#define XB_SPIN(cond, bar) do { unsigned _sp = 0; while (cond) { __builtin_amdgcn_s_sleep(1); \
    if ((++_sp & 255u) == 0u) { if (xb_ld(&(bar)[XB_TMO])) break; if (_sp > XB_SPIN_CAP) { atomicAdd(&(bar)[XB_TMO], 1u); break; } } } } while (0)

struct XcdBarrier {
    unsigned* bar; unsigned x;
    volatile LAS unsigned* st;
};

__device__ __forceinline__ XcdBarrier xcd_barrier_post(unsigned* bar, volatile LAS unsigned* st) {
    XcdBarrier b; b.bar = bar; b.x = xb_xcc_id(); b.st = st;
    if (threadIdx.x == 0) (void)xb_add(&bar[XB_XCNT(b.x)], 1u);
    return b;
}
__device__ __forceinline__ void xcd_barrier_complete(unsigned* bar, unsigned x, unsigned& nloc, unsigned& nx) {
    const unsigned G = gridDim.x * gridDim.y * gridDim.z;
    unsigned sum, cnt, mine, sp = 0u;
    for (;;) {
        sum = 0u; cnt = 0u; mine = 0u;
#pragma unroll
        for (unsigned j = 0; j < 16; ++j) { const unsigned c = xb_ld(&bar[XB_XCNT(j)]); sum += c; cnt += (c > 0u) ? 1u : 0u; mine = (j == x) ? c : mine; }
        if (sum == G) break;
        __builtin_amdgcn_s_sleep(1);
        if ((++sp & 255u) == 0u) { if (xb_ld(&bar[XB_TMO])) break; if (sp > XB_SPIN_CAP) { atomicAdd(&bar[XB_TMO], 1u); break; } }
    }
    nloc = mine > 0u ? mine : 1u; nx = cnt > 0u ? cnt : 1u;
}

__device__ __forceinline__ void xcd_barrier(const XcdBarrier& b) {
    asm volatile("s_waitcnt vmcnt(0)" ::: "memory");
    __syncthreads();
    if (threadIdx.x == 0) {
        unsigned* bar = b.bar;
        __builtin_amdgcn_s_waitcnt(0);
        unsigned nloc = b.st[0], nx = b.st[1];
        if (nloc == 0u) { xcd_barrier_complete(bar, b.x, nloc, nx); b.st[0] = nloc; b.st[1] = nx; }
        const unsigned old = xb_add(&bar[XB_XSUB(b.x)], 1u);
        const unsigned gen = old / nloc;
        if (old + 1u == (gen + 1u) * nloc) {
            __builtin_amdgcn_fence(__ATOMIC_RELEASE, "agent");
            asm volatile("s_waitcnt vmcnt(0)" ::: "memory");
            const unsigned og = xb_add(&bar[XB_TOP], 1u);
            const unsigned tg = og / nx;
            if (og + 1u == (tg + 1u) * nx) xb_add(&bar[XB_TOPGEN], 1u);
            else XB_SPIN(xb_ld(&bar[XB_TOPGEN]) == tg, bar);
            __builtin_amdgcn_fence(__ATOMIC_ACQUIRE, "agent");
            xb_add(&bar[XB_XGEN(b.x)], 1u);
            asm volatile("s_waitcnt vmcnt(0)" ::: "memory");
        } else {
            XB_SPIN(xb_ld(&bar[XB_XGEN(b.x)]) == gen, bar);
            __builtin_amdgcn_fence(__ATOMIC_ACQUIRE, "agent");
            asm volatile("s_waitcnt vmcnt(0)" ::: "memory");
        }
    }
    __syncthreads();
}

namespace att {
struct ProbeT { unsigned long long acc, last; int state; };
#ifdef PROBE_SUB
#define ATT_MARK(k) do { const unsigned long long now_ = __builtin_amdgcn_s_memrealtime(); if (PT.state == PROBE_SUB) PT.acc += now_ - PT.last; PT.last = now_; PT.state = (k); } while (0)
#define ATT_PROBE_PARAM , ProbeT& PT
#else
#define ATT_MARK(k) do { } while (0)
#define ATT_PROBE_PARAM
#endif
typedef unsigned short bf16_t;
using bf16x8 = __attribute__((ext_vector_type(8))) short;
using s16x4  = __attribute__((ext_vector_type(4))) short;
using f32x16 = __attribute__((ext_vector_type(16))) float;
using u32x4  = __attribute__((ext_vector_type(4))) unsigned;
constexpr int NW = 8, QBLK = 32, KVBLK = 64;
constexpr int VBUF = KVBLK * 128 * 2;
#define ATT_SBAR() __builtin_amdgcn_sched_barrier(0)
__device__ __forceinline__ int crow(int r, int hi) { return (r & 3) + 8 * (r >> 2) + 4 * hi; }
__device__ __forceinline__ unsigned cvtpk(float lo, float hi) { unsigned r; asm volatile("v_cvt_pk_bf16_f32 %0, %1, %2" : "=v"(r) : "v"(lo), "v"(hi)); return r; }
template <int DQ> __device__ __forceinline__ int kswz(int row, int colB) { return row * (DQ * 2) + (colB ^ ((row & 7) << 4)); }

__device__ __forceinline__ void partialSM(f32x16& p0, f32x16& p1, float& m_reg, float& mn, float& alpha, const float C, const float thr, const float rs = 1.f) {
  float pmax = p0[0];
#pragma unroll
  for (int r = 1; r < 16; ++r) pmax = fmaxf(pmax, p0[r]);
#pragma unroll
  for (int r = 0; r < 16; ++r) pmax = fmaxf(pmax, p1[r]);
  { auto rr = __builtin_amdgcn_permlane32_swap(__float_as_uint(pmax), __float_as_uint(pmax), false, false);
    pmax = fmaxf(__uint_as_float(rr[0]), __uint_as_float(rr[1])) * rs; }
  if (__builtin_expect(__all(pmax - m_reg <= thr), 1)) { mn = m_reg; alpha = 1.f; }
  else { mn = fmaxf(m_reg, pmax); alpha = __builtin_amdgcn_exp2f((m_reg - mn) * C); m_reg = mn; }
  const float mnC = -mn * C, Cl = C * rs;
#pragma unroll
  for (int r = 0; r < 16; ++r) p0[r] = fmaf(p0[r], Cl, mnC);
#pragma unroll
  for (int r = 0; r < 16; ++r) p1[r] = fmaf(p1[r], Cl, mnC);
#pragma unroll
  for (int r = 0; r < 16; ++r) p0[r] = __builtin_amdgcn_exp2f(p0[r]);
}
__device__ __forceinline__ void finishSM(f32x16& p0, f32x16& p1, float alpha, float& l_reg, bf16x8& pa0, bf16x8& pa1, bf16x8& pa2, bf16x8& pa3) {
#pragma unroll
  for (int r = 0; r < 16; ++r) p1[r] = __builtin_amdgcn_exp2f(p1[r]);
  float ps = 0;
#pragma unroll
  for (int r = 0; r < 16; ++r) ps += p0[r];
#pragma unroll
  for (int r = 0; r < 16; ++r) ps += p1[r];
  { auto rr = __builtin_amdgcn_permlane32_swap(__float_as_uint(ps), __float_as_uint(ps), false, false);
    ps = __uint_as_float(rr[0]) + __uint_as_float(rr[1]); }
  l_reg = l_reg * alpha + ps;
#define ATT_PK4(P, BASE, OUT) do { unsigned a0 = cvtpk(P[BASE + 0], P[BASE + 1]), a1 = cvtpk(P[BASE + 2], P[BASE + 3]);   \
    unsigned b0 = cvtpk(P[BASE + 4], P[BASE + 5]), b1 = cvtpk(P[BASE + 6], P[BASE + 7]);                              \
    auto r0 = __builtin_amdgcn_permlane32_swap(a0, b0, false, false); auto r1 = __builtin_amdgcn_permlane32_swap(a1, b1, false, false); \
    u32x4 w = {r0[0], r1[0], r0[1], r1[1]}; OUT = *reinterpret_cast<bf16x8*>(&w); } while (0)
  ATT_PK4(p0, 0, pa0); ATT_PK4(p0, 8, pa1); ATT_PK4(p1, 0, pa2); ATT_PK4(p1, 8, pa3);
#undef ATT_PK4
}
template <int OFF> __device__ __forceinline__ bf16x8 lds_rd128(unsigned addr) { bf16x8 r; asm volatile("ds_read_b128 %0, %1 offset:%2" : "=&v"(r) : "v"(addr), "i"(OFF) : "memory"); return r; }
template <int N> __device__ __forceinline__ void lgkm_wait() { static_assert(N == 0 || N == 2 || N == 4 || N == 6, "count"); if constexpr (N == 0) asm volatile("s_waitcnt lgkmcnt(0)" ::: "memory"); else if constexpr (N == 2) asm volatile("s_waitcnt lgkmcnt(2)" ::: "memory"); else if constexpr (N == 4) asm volatile("s_waitcnt lgkmcnt(4)" ::: "memory"); else asm volatile("s_waitcnt lgkmcnt(6)" ::: "memory"); }
template <int GS, int G, int S = 0> struct QktLoad {
  static __device__ __forceinline__ void run(unsigned kb, bf16x8 (&f0)[2][GS], bf16x8 (&f1)[2][GS]) {
    f0[G & 1][S] = lds_rd128<(G * GS + S) * 2048>(kb); f1[G & 1][S] = lds_rd128<(G * GS + S) * 2048 + 512>(kb);
    if constexpr (S + 1 < GS) QktLoad<GS, G, S + 1>::run(kb, f0, f1);
  }
};
template <int DQ, int GS, int G = 0> struct QktStep {
  static __device__ __forceinline__ void run(f32x16& p0, f32x16& p1, unsigned kb, const bf16x8* qr, bf16x8 (&f0)[2][GS], bf16x8 (&f1)[2][GS]) {
    constexpr int NG = DQ / 16 / GS;
    if constexpr (G + 1 < NG) { QktLoad<GS, G + 1>::run(kb, f0, f1); lgkm_wait<2 * GS>(); } else lgkm_wait<0>();
    ATT_SBAR();
#pragma unroll
    for (int s_ = 0; s_ < GS; ++s_) { p0 = __builtin_amdgcn_mfma_f32_32x32x16_bf16(f0[G & 1][s_], qr[G * GS + s_], p0, 0, 0, 0); p1 = __builtin_amdgcn_mfma_f32_32x32x16_bf16(f1[G & 1][s_], qr[G * GS + s_], p1, 0, 0, 0); }
    ATT_SBAR();
    if constexpr (G + 1 < NG) QktStep<DQ, GS, G + 1>::run(p0, p1, kb, qr, f0, f1);
  }
};
template <int DQ, int GS> __device__ __forceinline__ void qkt(f32x16& p0, f32x16& p1, const char* Ks, const bf16x8* qr, int r32, int hi) {
  static_assert((DQ / 16) % GS == 0 && GS >= 1 && GS <= 3, "group size");
  p0 = f32x16{}; p1 = f32x16{};
  const unsigned kb = (unsigned)(uintptr_t)Ks + (unsigned)(hi * 1024 + r32 * 16);
  bf16x8 f0[2][GS], f1[2][GS];
  QktLoad<GS, 0>::run(kb, f0, f1);
  QktStep<DQ, GS, 0>::run(p0, p1, kb, qr, f0, f1);
}
__device__ __forceinline__ int v_st(int k, int c) { const int kk = (k & ~0xC) | ((k & 4) << 1) | ((k & 8) >> 1); return ((kk >> 3) * 4 + (c >> 5)) * 512 + ((kk & 7) * 32 + (c & 31)) * 2; }
__device__ __forceinline__ int v_rd_base(int lane) { return ((lane & 3) << 3) | (((lane >> 2) & 3) << 6) | (((lane >> 4) & 1) << 5) | (((lane >> 5) & 1) << 8); }
constexpr int v_rd_off(int d0, int ks, int half) { return d0 * 512 + ks * 4096 + half * 2048; }
template <int OFF> __device__ __forceinline__ s16x4 tr_read(int vb) {
  s16x4 r; asm volatile("ds_read_b64_tr_b16 %0, %1 offset:%2" : "=&v"(r) : "v"(vb), "i"(OFF) : "memory"); return r;
}
template <int HB> __device__ __forceinline__ void pv_rd(s16x4 (&s)[4], int vb) {
  constexpr int D0 = HB >> 1, K0 = 2 * (HB & 1);
  s[0] = tr_read<v_rd_off(D0, K0, 0)>(vb); s[1] = tr_read<v_rd_off(D0, K0, 1)>(vb); s[2] = tr_read<v_rd_off(D0, K0 + 1, 0)>(vb); s[3] = tr_read<v_rd_off(D0, K0 + 1, 1)>(vb);
}
__device__ __forceinline__ void pv_mm(f32x16& od, const s16x4 (&s)[4], bf16x8 pa, bf16x8 pb) {
#define ATT_PK(L, H) (bf16x8){L[0], L[1], L[2], L[3], H[0], H[1], H[2], H[3]}
  od = __builtin_amdgcn_mfma_f32_32x32x16_bf16(pa, ATT_PK(s[0], s[1]), od, 0, 0, 0);
  od = __builtin_amdgcn_mfma_f32_32x32x16_bf16(pb, ATT_PK(s[2], s[3]), od, 0, 0, 0);
#undef ATT_PK
}
template <int H> __device__ __forceinline__ void pv_half(f32x16* o, int vb, bf16x8 pa0, bf16x8 pa1, bf16x8 pa2, bf16x8 pa3) {
  s16x4 s0[4], s1[4], s2[4];
#define ATT_W8() asm volatile("s_waitcnt lgkmcnt(8)" ::: "memory")
#define ATT_W4() asm volatile("s_waitcnt lgkmcnt(4)" ::: "memory")
#define ATT_W0() asm volatile("s_waitcnt lgkmcnt(0)" ::: "memory")
  pv_rd<4 * H + 0>(s0, vb); pv_rd<4 * H + 1>(s1, vb);
  pv_rd<4 * H + 2>(s2, vb); ATT_W8(); ATT_SBAR(); pv_mm(o[2 * H], s0, pa0, pa1); ATT_SBAR();
  pv_rd<4 * H + 3>(s0, vb); ATT_W8(); ATT_SBAR(); pv_mm(o[2 * H], s1, pa2, pa3); ATT_SBAR();
  ATT_W4(); ATT_SBAR(); pv_mm(o[2 * H + 1], s2, pa0, pa1); ATT_SBAR();
  ATT_W0(); ATT_SBAR(); pv_mm(o[2 * H + 1], s0, pa2, pa3); ATT_SBAR();
#undef ATT_W8
#undef ATT_W4
#undef ATT_W0
}

struct AUnit {
  const bf16_t* q; bf16_t* o; const bf16_t *k0, *v0, *k1, *v1;
  int ldq, ldo, ldk0, ldv0, ldk1, ldv1, n0, ntiles; float scale;
  int r0, kr_lo; const float* rpb;
  const float* qsq;
};
constexpr int TBL_FLOATS = 15 * 128;
constexpr int NBUF = 3;
template <int DQ> constexpr int attn_lds_bytes() { return NBUF * VBUF + NBUF * KVBLK * DQ * 2 + NW * 64 * 4 + TBL_FLOATS * 4; }

template <int DQ, bool NAT>
__device__ __forceinline__ void attn_unit(const AUnit& U, char* lds, const int wid_in ATT_PROBE_PARAM) {
  constexpr int KB = KVBLK * DQ * 2, NKC = DQ / 64, CPR = DQ / 8;
  ATT_MARK(0);
  const int tid = wid_in * 64 + lane_id_fresh(), wid = wid_in, lane = tid & 63, r32 = lane & 31, hi = lane >> 5;
  char* V_lds = lds; char* K_lds = lds + NBUF * VBUF;
  float* ws = (float*)(lds + NBUF * VBUF + NBUF * KB) + wid * 64; float* li_l = ws; float* al_l = ws + 32;
  float* tbl = (float*)(lds + NBUF * VBUF + NBUF * KB + NW * 64 * 4);
  const float C = U.scale * 1.4426950408889634f, thr = 8.f / U.scale;
  if constexpr (NAT) {
    const float inv = 1.0f / U.scale;
    for (int idx = tid; idx < TBL_FLOATS; idx += 512) { const int ro = idx >> 7, d = (idx & 127) - 48; tbl[idx] = (d >= 0 && d <= 30) ? U.rpb[ro * 31 + d] * inv : 0.f; }
  }
  float m_reg = -1e30f, l_reg = 0.f; f32x16 o[4] = {}; bf16x8 qr[DQ / 16];
  const bf16_t* Qw = U.q + (long)(wid * QBLK + r32) * U.ldq + hi * 8;
#pragma unroll
  for (int d0 = 0; d0 < DQ / 16; ++d0) qr[d0] = *reinterpret_cast<const bf16x8*>(Qw + d0 * 16);
  float qrs = 1.f;
  if (U.qsq) { typedef float f32x2v __attribute__((ext_vector_type(2))); const float* sp = U.qsq + (long)(wid * QBLK + r32) * 96;
    const f32x2v a = *(const f32x2v*)sp, b = *(const f32x2v*)(sp + 2), c = *(const f32x2v*)(sp + 4); qrs = __builtin_amdgcn_rsqf(((a[0] + a[1]) + (b[0] + b[1]) + (c[0] + c[1])) * (1.0f / 192.0f) + 1e-6f); }
  const int sr = tid >> 4, sc = (tid & 15) * 8, vst0 = v_st(sr, sc), vst1 = v_st(32 + sr, sc);
  const int vb0 = (int)(uintptr_t)V_lds + v_rd_base(lane);
  bf16x8 st[NKC], sv[2];
#define ATT_TILE(j) const int j_ = (j); const bool f_ = j_ < U.n0; const int jj_ = f_ ? j_ : j_ - U.n0; const int ldk_ = f_ ? U.ldk0 : U.ldk1, ldv_ = f_ ? U.ldv0 : U.ldv1; \
    const bf16_t* kp_ = (f_ ? U.k0 : U.k1) + (long)jj_ * KVBLK * ldk_; const bf16_t* vp_ = (f_ ? U.v0 : U.v1) + (long)jj_ * KVBLK * ldv_; (void)kp_; (void)vp_; (void)ldk_; (void)ldv_
#define ATT_KLOAD_TO(dst, j) do { ATT_TILE(j); _Pragma("unroll") for (int i_ = 0; i_ < NKC; ++i_) { const int c_ = tid + 512 * i_, kr_ = c_ & 63, kc_ = c_ >> 6; dst[i_] = *reinterpret_cast<const bf16x8*>(kp_ + (long)kr_ * ldk_ + kc_ * 8); } } while (0)
#define ATT_KLOAD(j) ATT_KLOAD_TO(st, j)
#define ATT_KWRITE_FROM(src, b) do { _Pragma("unroll") for (int i_ = 0; i_ < NKC; ++i_) { const int c_ = tid + 512 * i_; *(bf16x8*)(K_lds + (b) * KB + c_ * 16) = src[i_]; } } while (0)
#define ATT_KWRITE(b) ATT_KWRITE_FROM(st, b)
#define ATT_VLOAD_TO(dst, j) do { ATT_TILE(j); dst[0] = *reinterpret_cast<const bf16x8*>(vp_ + (long)sr * ldv_ + sc); dst[1] = *reinterpret_cast<const bf16x8*>(vp_ + (long)(32 + sr) * ldv_ + sc); } while (0)
#define ATT_VLOAD(j) ATT_VLOAD_TO(sv, j)
#define ATT_VWRITE_FROM(src, b) do { *(bf16x8*)(V_lds + (b) * VBUF + vst0) = src[0]; *(bf16x8*)(V_lds + (b) * VBUF + vst1) = src[1]; } while (0)
#define ATT_VWRITE(b) ATT_VWRITE_FROM(sv, b)
#define ATT_BAR() do { asm volatile("s_waitcnt lgkmcnt(0)" ::: "memory"); __builtin_amdgcn_s_barrier(); asm volatile("" ::: "memory"); } while (0)
  const int NT = U.ntiles;
  const int R = U.r0 + (wid >> 1), rs = min(max(R - 4, 0), 24), qc = (wid & 1) * 32 + r32, cs = min(max(qc - 8, 0), 48);
  { bf16x8 k0_[NKC], k1_[NKC], k2_[NKC], v0_[2], v1_[2], v2_[2];
    ATT_KLOAD_TO(k0_, 0); ATT_VLOAD_TO(v0_, 0); ATT_KLOAD_TO(k1_, 1); ATT_VLOAD_TO(v1_, 1);
    if (2 < NT) { ATT_KLOAD_TO(k2_, 2); ATT_VLOAD_TO(v2_, 2); }
    if (3 < NT) { ATT_KLOAD(3); ATT_VLOAD(3); }
    ATT_KWRITE_FROM(k0_, 0); ATT_VWRITE_FROM(v0_, 0); ATT_KWRITE_FROM(k1_, 1); ATT_VWRITE_FROM(v1_, 1);
    if (2 < NT) { ATT_KWRITE_FROM(k2_, 2); ATT_VWRITE_FROM(v2_, 2); } }
  ATT_BAR();
  if (wid >= 4) { ATT_BAR(); __builtin_amdgcn_s_setprio(1); }
  ATT_MARK(1);
  int b = 0, bn = 1, bp = 2;
  bool act_prev = false; bf16x8 pa0, pa1, pa2, pa3; f32x16 p0, p1;
  for (int j = 0; j <= NT; ++j) {
    bool act = j < NT; int kr = 0;
    if constexpr (NAT) { if (j >= U.n0 && j < NT) { kr = U.kr_lo + (j - U.n0); act = (kr >= rs) && (kr <= rs + 7); } }
    if (j >= 2 && j + 1 < NT) { ATT_KWRITE(bn); if (j + 2 < NT) ATT_KLOAD(j + 2); }
    if (act) {
      qkt<DQ, 2>(p0, p1, K_lds + b * KB, qr, r32, hi);
      if constexpr (NAT) { if (j >= U.n0) {
        const int ro = kr - R + 7; const float* tb = tbl + ro * 128 + 63 - qc + 4 * hi; const int t0 = 4 * hi - cs; const float NEG = -INFINITY;
#pragma unroll
        for (int r = 0; r < 16; ++r) { const int kc = (r & 3) + 8 * (r >> 2);
          p0[r] = ((unsigned)(t0 + kc) < 16u) ? p0[r] + tb[kc] : NEG;
          p1[r] = ((unsigned)(t0 + kc + 32) < 16u) ? p1[r] + tb[kc + 32] : NEG; } } }
    }
    if (act_prev) pv_half<1>(o, vb0 + bp * VBUF, pa0, pa1, pa2, pa3);
    if (j == NT) break;
    ATT_MARK(2); ATT_BAR(); ATT_MARK(3);
    if (j >= 2 && j + 1 < NT) { ATT_VWRITE(bn); if (j + 2 < NT) ATT_VLOAD(j + 2); }
    if (act) {
      float mn, alpha;
      partialSM(p0, p1, m_reg, mn, alpha, C, thr, qrs);
      if (__any(alpha < 1.f)) { if (hi == 0) al_l[r32] = alpha; asm volatile("s_waitcnt lgkmcnt(0)" ::: "memory");
#pragma unroll
        for (int d = 0; d < 4; ++d)
#pragma unroll
          for (int r = 0; r < 16; ++r) o[d][r] *= al_l[crow(r, hi)]; }
      finishSM(p0, p1, alpha, l_reg, pa0, pa1, pa2, pa3); ATT_SBAR();
      pv_half<0>(o, vb0 + b * VBUF, pa0, pa1, pa2, pa3);
    }
    ATT_MARK(4); ATT_BAR(); ATT_MARK(1);
    act_prev = act; bp = b; b = bn; bn = (bn == NBUF - 1) ? 0 : bn + 1;
  }
  ATT_MARK(5);
  ATT_BAR();
  if (wid < 4) ATT_BAR();
  __builtin_amdgcn_s_setprio(0);
  if (hi == 0) li_l[r32] = l_reg; asm volatile("s_waitcnt lgkmcnt(0)" ::: "memory");
  float rli[16];
#pragma unroll
  for (int r = 0; r < 16; ++r) rli[r] = __builtin_amdgcn_rcpf(li_l[crow(r, hi)]);
  bf16_t* Ow = U.o + (long)(wid * QBLK) * U.ldo;
#pragma unroll
  for (int r = 0; r < 16; ++r) { const int orow = crow(r, hi);
#pragma unroll
    for (int d0 = 0; d0 < 4; ++d0) { const float v = o[d0][r] * rli[r]; unsigned u = __float_as_uint(v); u = (u + 0x7fffu + ((u >> 16) & 1u)) >> 16; Ow[(long)orow * U.ldo + d0 * 32 + r32] = (bf16_t)u; } }
  ATT_MARK(6);
#undef ATT_TILE
#undef ATT_KLOAD
#undef ATT_KWRITE
#undef ATT_VLOAD
#undef ATT_VWRITE
#undef ATT_KLOAD_TO
#undef ATT_KWRITE_FROM
#undef ATT_VLOAD_TO
#undef ATT_VWRITE_FROM
#undef ATT_BAR
}
}

constexpr int D = 2048, NTOK = 16384, NCTX = 8192, DEPTH = 4;
constexpr int IN_AB = 6144, DFF = 5632, NDOWN = 832, NDOWN_P = 1024, QL = 512, KVL = 256, ROPE_D = 64;
constexpr int NKVROWS = NTOK + 1024;
constexpr float EPS = 1e-6f;
constexpr int NWAVES = 8;
constexpr size_t O_X = 0, O_NATK = (size_t)NTOK * D, O_NATV = O_NATK + 16777216, O_CKV = O_NATV + 16777216, O_KR = O_CKV + 4194304, O_END = O_KR + 1048576;
constexpr size_t MiB = 1u << 20;
constexpr size_t WS_CTL = 0, CTL_ZERO_BYTES = 1 * MiB;
constexpr size_t WS_MOD = 1 * MiB;
constexpr size_t WS_W = 2 * MiB;
constexpr size_t SZ_FFN_IN = (size_t)2 * DFF * D * 2, SZ_FFN_OUT = (size_t)D * DFF * 2, SZ_IN_AB = (size_t)IN_AB * D * 2, SZ_DD = (size_t)D * D * 2;
constexpr size_t SZ_DOWN = (size_t)NDOWN_P * D * 2, SZ_UQ = (size_t)3072 * QL * 2, SZ_UKV = (size_t)4096 * KVL * 2;
constexpr size_t W_FFN_IN = WS_W, W_FFN_OUT = W_FFN_IN + 4 * SZ_FFN_IN, W_IN_AB = W_FFN_OUT + 4 * SZ_FFN_OUT, W_OUT_AB = W_IN_AB + 2 * SZ_IN_AB;
constexpr size_t W_DOWN = W_OUT_AB + 2 * SZ_DD, W_UQ = W_DOWN + 2 * SZ_DOWN, W_UKV = W_UQ + 2 * SZ_UQ, W_O = W_UKV + 2 * SZ_UKV, W_END = W_O + 2 * SZ_DD;
constexpr size_t WS_H = 384 * MiB;
constexpr size_t WS_C = WS_H + 64 * MiB;
constexpr size_t WS_SM = WS_C + 64 * MiB;
constexpr size_t SZ_CKVN = 9 * MiB, SZ_KR = 5 * MiB, SZ_KRSQ = 128 * 1024;
constexpr size_t SM_CQN = WS_SM, SM_CKVN = SM_CQN + (size_t)NTOK * QL * 2, SM_KR = SM_CKVN + 2 * SZ_CKVN, SM_CK = SM_KR + 2 * SZ_KR, SM_CV = SM_CK + 4 * MiB, SM_KRSQ = SM_CV + 4 * MiB, SM_CQP = SM_KRSQ + 1 * MiB, SM_QSQ = SM_CQP + 1 * MiB, SM_END = SM_QSQ + 7 * MiB;
static_assert((size_t)NKVROWS * KVL * 2 <= SZ_CKVN && (size_t)NKVROWS * 64 * 4 <= SZ_KR && (size_t)NKVROWS * 4 <= SZ_KRSQ && (size_t)NTOK * 8 * 4 <= 1 * MiB, "latent buffers");
constexpr size_t WS_BIG = WS_SM + 64 * MiB;
constexpr size_t B_P = WS_BIG;
constexpr size_t B_L = WS_BIG, B_QC = B_L + 64 * MiB, B_KV = B_QC + 96 * MiB, B_KN = B_KV + 136 * MiB;
constexpr size_t WS_CS = WS_MOD + 983040;
constexpr size_t B_F = WS_BIG;
constexpr size_t WS_X16 = WS_BIG + 512 * MiB;
constexpr size_t WS_END = WS_X16 + 64 * MiB;
static_assert(W_END <= WS_H && SM_END <= WS_BIG && B_KN + (size_t)NKVROWS * 3072 * 2 <= WS_X16 && B_F + (size_t)NTOK * DFF * 2 <= WS_END, "d_ws map");
constexpr int CW_BAR = 4096;
constexpr int RING_BYTES = 131072, LDSCTL_OFF = RING_BYTES, LDS_BYTES = 147456;

typedef unsigned short bf16;
typedef float f32x2 __attribute__((ext_vector_type(2)));
typedef unsigned u32x2 __attribute__((ext_vector_type(2)));
typedef _Float16 h16x4 __attribute__((ext_vector_type(4)));

__device__ __forceinline__ float wave_sum(float v) {
    v += __int_as_float(__builtin_amdgcn_ds_swizzle(__float_as_int(v), 0x041F));
    v += __int_as_float(__builtin_amdgcn_ds_swizzle(__float_as_int(v), 0x081F));
    v += __int_as_float(__builtin_amdgcn_ds_swizzle(__float_as_int(v), 0x101F));
    v += __int_as_float(__builtin_amdgcn_ds_swizzle(__float_as_int(v), 0x201F));
    v += __int_as_float(__builtin_amdgcn_ds_swizzle(__float_as_int(v), 0x401F));
    const auto b = __builtin_amdgcn_permlane32_swap(__float_as_uint(v), __float_as_uint(v), false, false);
    return __uint_as_float(b[0]) + __uint_as_float(b[1]);
}
__device__ __forceinline__ float bf2f(unsigned short b) { return __uint_as_float(((unsigned)b) << 16); }
__device__ __forceinline__ float bflo(unsigned w) { return __uint_as_float(w << 16); }
__device__ __forceinline__ float bfhi(unsigned w) { return __uint_as_float(w & 0xffff0000u); }

struct Frame {
    LAS unsigned char* lds; char* ldsg;
    int tid, lane, wave, G, vcu, gw, NGW;
#ifdef PROBE_PRO
    unsigned long long pacc;
#endif
    GAS float* out; GAS unsigned char* ws; int l;
};
__device__ __forceinline__ const float* kin(int k) { asm volatile("" : "+s"(k)); return (const float*)((GAS const float* const __attribute__((address_space(4)))*)__builtin_amdgcn_kernarg_segment_ptr())[k]; }

__device__ __forceinline__ bool fresh(Frame& F) {
    F.lane = lane_id_fresh(); F.tid = F.wave * 64 + F.lane;
    { GAS unsigned char* w = F.ws; GAS float* o = F.out; int l = F.l; asm volatile("" : "+s"(w), "+s"(o), "+s"(l)); F.ws = w; F.out = o; F.l = l; }
    return true;
}
__device__ __forceinline__ void p0_transpose_item(const float* W, int K, int N, bf16* WT, int k0, int n0, int drow0, LAS float* scr, int lane, const float* ksc) {
    { const int r = lane >> 3, n4 = (lane & 7) * 4; f32x4 w[8];
#pragma unroll
      for (int i = 0; i < 8; ++i) w[i] = *(const f32x4*)(W + (size_t)(k0 + r + 8 * i) * N + n0 + n4);
#pragma unroll
      for (int i = 0; i < 8; ++i) { LAS float* d = scr + (r + 8 * i) * 33 + n4; d[0] = w[i][0]; d[1] = w[i][1]; d[2] = w[i][2]; d[3] = w[i][3]; } }
    LDS_WAIT(); asm volatile("" ::: "memory");
    const int c = lane & 7;
    f32x4 sa = {1.f, 1.f, 1.f, 1.f}, sb = {1.f, 1.f, 1.f, 1.f};
    if (ksc) { sa = *(const f32x4*)(ksc + k0 + 8 * c); sb = *(const f32x4*)(ksc + k0 + 8 * c + 4); }
#pragma unroll
    for (int j = 0; j < 4; ++j) { const int n = (lane >> 3) + 8 * j; const LAS float* s = scr + (8 * c) * 33 + n;
        v4u o; o.x = pk2(s[0 * 33] * sa[0], s[1 * 33] * sa[1]); o.y = pk2(s[2 * 33] * sa[2], s[3 * 33] * sa[3]); o.z = pk2(s[4 * 33] * sb[0], s[5 * 33] * sb[1]); o.w = pk2(s[6 * 33] * sb[2], s[7 * 33] * sb[3]);
        *(GAS v4u*)(WT + (size_t)(drow0 + n) * K + k0 + 8 * c) = o; }
    LDS_WAIT(); asm volatile("" ::: "memory");
}
__device__ __forceinline__ void p0_do_matrix(const float* W, int K, int N, bf16* WT, int item, int ffn_map, LAS float* scr, int lane, const float* ksc = nullptr) {
    const int nblk = N / 32, kb = item / nblk, nb = item % nblk, k0 = 64 * kb, n0 = 32 * nb;
    int drow0 = n0;
    if (ffn_map == 1) { const int up = n0 >= DFF ? 1 : 0, j = n0 - up * DFF; drow0 = (j >> 7) * 256 + up * 128 + (j & 127); }
    if (ffn_map == 2) { drow0 = (n0 / 192) * 256 + (n0 % 192); }
    p0_transpose_item(W, K, N, WT, k0, n0, drow0, scr, lane, ksc);
}
__device__ __forceinline__ void phase_prologue(Frame& F) {
#ifdef PROBE_PRO
    unsigned long long pt0_ = rt(); F.pacc = 0;
#define PSTAMP(k) do { const unsigned long long n_ = rt(); if (PROBE_PRO == (k)) F.pacc += n_ - pt0_; pt0_ = n_; } while (0)
#else
#define PSTAMP(k) do { } while (0)
#endif
    {
        LAS float* sil = (LAS float*)F.lds;
        LAS float* red = sil + 5 * 2048;
        const float* c = kin(6); const float* cctx = kin(7);
        for (int i = F.tid; i < 5 * 2048; i += 512) { const int cc = i >> 11, k = i & 2047; const float x = cc == 0 ? cctx[k] : c[(cc - 1) * 2048 + k]; sil[i] = x / (1.0f + __expf(-x)); }
        __syncthreads();
        const float* w_ada = kin(10); const float* b_ada = kin(11); float* mod = (float*)(F.ws + WS_MOD);
        for (int task = F.vcu; task < 4 * 192; task += F.G) {
            const int l = task / 192, n = (task % 192) * 64 + F.lane;
            const float* wp = w_ada + ((size_t)l * 2048 + F.wave * 256) * 12288 + n;
            float a0 = 0.f, a1 = 0.f, a2 = 0.f, a3 = 0.f, a4 = 0.f;
            for (int k = 0; k < 256; k += 16) {
                float w[16];
#pragma unroll
                for (int u = 0; u < 16; ++u) w[u] = wp[(size_t)(k + u) * 12288];
#pragma unroll
                for (int u = 0; u < 16; ++u) { const int kk = F.wave * 256 + k + u; a0 += sil[kk] * w[u]; a1 += sil[2048 + kk] * w[u]; a2 += sil[4096 + kk] * w[u]; a3 += sil[6144 + kk] * w[u]; a4 += sil[8192 + kk] * w[u]; }
            }
            red[(F.wave * 5 + 0) * 64 + F.lane] = a0; red[(F.wave * 5 + 1) * 64 + F.lane] = a1; red[(F.wave * 5 + 2) * 64 + F.lane] = a2; red[(F.wave * 5 + 3) * 64 + F.lane] = a3; red[(F.wave * 5 + 4) * 64 + F.lane] = a4;
            __syncthreads();
            if (F.tid < 320) { const int cc = F.tid >> 6, ln = F.tid & 63; float s = 0.f;
#pragma unroll
                for (int w8 = 0; w8 < 8; ++w8) s += red[(w8 * 5 + cc) * 64 + ln];
                const int nn = (task % 192) * 64 + ln; mod[((size_t)l * 5 + cc) * 12288 + nn] = s + b_ada[(size_t)l * 12288 + nn]; }
            __syncthreads();
        }
    }
    PSTAMP(1);
    {
        LAS float* scr = (LAS float*)(F.lds + F.wave * 16384);
        constexpr int I_FI = 32 * 352, I_FO = 88 * 64, I_IA = 32 * 192, I_DD = 32 * 64, I_DN = 32 * 26, I_UQ = 8 * 96, I_UK = 4 * 128;
        constexpr int NITEMS = 4 * I_FI + 4 * I_FO + 2 * I_IA + 2 * I_DD + 2 * I_DN + 2 * I_UQ + 2 * I_UK + 2 * I_DD;
        unsigned char* ws = (unsigned char*)F.ws;
        for (int it = F.gw; it < NITEMS; it += F.NGW) {
            int r = it;
            if (r < 4 * I_FI) { const int l = r / I_FI; p0_do_matrix(kin(26) + (size_t)l * D * 2 * DFF, D, 2 * DFF, (bf16*)(ws + W_FFN_IN + l * SZ_FFN_IN), r % I_FI, 1, scr, F.lane); continue; } r -= 4 * I_FI;
            if (r < 4 * I_FO) { const int l = r / I_FO; p0_do_matrix(kin(27) + (size_t)l * DFF * D, DFF, D, (bf16*)(ws + W_FFN_OUT + l * SZ_FFN_OUT), r % I_FO, 0, scr, F.lane); continue; } r -= 4 * I_FO;
            if (r < 2 * I_IA) { const int l = r / I_IA; p0_do_matrix(kin(12) + (size_t)l * D * IN_AB, D, IN_AB, (bf16*)(ws + W_IN_AB + l * SZ_IN_AB), r % I_IA, 0, scr, F.lane); continue; } r -= 2 * I_IA;
            if (r < 2 * I_DD) { const int l = r / I_DD; p0_do_matrix(kin(17) + (size_t)l * D * D, D, D, (bf16*)(ws + W_OUT_AB + l * SZ_DD), r % I_DD, 0, scr, F.lane); continue; } r -= 2 * I_DD;
            if (r < 2 * I_DN) { const int l = r / I_DN; p0_do_matrix(kin(18) + (size_t)l * D * NDOWN, D, NDOWN, (bf16*)(ws + W_DOWN + l * SZ_DOWN), r % I_DN, 0, scr, F.lane); continue; } r -= 2 * I_DN;
            if (r < 2 * I_UQ) { const int l = r / I_UQ; p0_do_matrix(kin(21) + (size_t)l * QL * 3072, QL, 3072, (bf16*)(ws + W_UQ + l * SZ_UQ), r % I_UQ, 0, scr, F.lane, kin(19) + l * QL); continue; } r -= 2 * I_UQ;
            if (r < 2 * I_UK) { const int l = r / I_UK; p0_do_matrix(kin(22) + (size_t)l * KVL * 4096, KVL, 4096, (bf16*)(ws + W_UKV + l * SZ_UKV), r % I_UK, 0, scr, F.lane); continue; } r -= 2 * I_UK;
            { const int l = r / I_DD; p0_do_matrix(kin(25) + (size_t)l * D * D, D, D, (bf16*)(ws + W_O + l * SZ_DD), r % I_DD, 0, scr, F.lane); }
        }
        PSTAMP(2);
        const int gt = F.vcu * 512 + F.tid, NT = F.G * 512;
        for (int i = gt; i < 2 * (NDOWN_P - NDOWN) * D / 8; i += NT) { const int l = i / ((NDOWN_P - NDOWN) * D / 8), e = i % ((NDOWN_P - NDOWN) * D / 8);
            *(v4u*)(ws + W_DOWN + l * SZ_DOWN + (size_t)NDOWN * D * 2 + (size_t)e * 16) = (v4u){0u, 0u, 0u, 0u}; }
        if (gt < 1024) { const int pos = gt >> 4, j = gt & 15; const float ang = (float)pos * exp2f(-(float)j * (13.287712379549449f / 16.0f));
            ((float*)(ws + WS_CS))[gt] = __cosf(ang); ((float*)(ws + WS_CS))[1024 + gt] = __sinf(ang); }
        for (int rr = F.gw; rr < 2 * 1024; rr += F.NGW) { const int i = rr >> 10, cr = rr & 1023, b = cr >> 8, t = cr & 255; const size_t row = (size_t)NTOK + cr;
            const f32x4 y = *(const f32x4*)(kin(4) + (((size_t)b * 2 + i) * 256 + t) * 256 + F.lane * 4);
            u32x2 w; w.x = pk2(y[0], y[1]); w.y = pk2(y[2], y[3]); *(u32x2*)((bf16*)(ws + SM_CKVN + i * SZ_CKVN) + row * KVL + F.lane * 4) = w;
            const float krv = kin(5)[(((size_t)b * 2 + i) * 256 + t) * 64 + F.lane];
            ((float*)(ws + SM_KR + i * SZ_KR))[row * 64 + F.lane] = krv * (kin(24) + i * 192)[128 + F.lane];
            const float q2 = wave_sum(krv * krv); if (F.lane == 0) ((float*)(ws + SM_KRSQ + i * SZ_KRSQ))[row] = q2; }
        const float* ck = kin(2); const float* cv = kin(3);
        for (int i = gt; i < 2 * 262144; i += NT) { const bool isk = i < 262144; const int e = isk ? i : i - 262144; const float* s = (isk ? ck : cv) + (size_t)e * 8;
            const f32x4 a = *(const f32x4*)s, b = *(const f32x4*)(s + 4); v4u o; o.x = pk2(a[0], a[1]); o.y = pk2(a[2], a[3]); o.z = pk2(b[0], b[1]); o.w = pk2(b[2], b[3]);
            *(v4u*)(ws + (isk ? SM_CK : SM_CV) + (size_t)e * 16) = o; }
        PSTAMP(3);
    }
}

#ifndef MOD_ROWS
#define MOD_ROWS 4
#endif
__device__ __forceinline__ void phase_mod(Frame& F, const float* xc32, const float* xs32, _Float16* X16, const float* g, const float* mod_l, int chunk, bf16* Hb) {
    for (int rb = F.gw; rb < NTOK / 8; rb += F.NGW) {
        const int row0 = rb * 8, cond = row0 < NCTX ? 0 : 1 + ((row0 - NCTX) >> 11);
        const float* sh = mod_l + (size_t)cond * 12288 + chunk * 2048; const float* scl = sh + 2048;
        f32x4 a[8], b[8];
#pragma unroll
        for (int j = 0; j < 8; ++j) { const int c = 4 * (64 * j + F.lane); const f32x4 gv = *(const f32x4*)(g + c), sv = *(const f32x4*)(scl + c); a[j] = gv * (sv + 1.0f); b[j] = *(const f32x4*)(sh + c); }
        if (xc32) {
            for (int rr = 0; rr < 8; rr += 2) {
                f32x4 v[2][8];
#pragma unroll
                for (int q = 0; q < 2; ++q) { const int row = row0 + rr + q; const float* xr = (row < NCTX ? xc32 : xs32) + (size_t)row * D;
#pragma unroll
                    for (int j = 0; j < 8; ++j) v[q][j] = *(const f32x4*)(xr + 4 * (64 * j + F.lane)); }
#pragma unroll
                for (int q = 0; q < 2; ++q) {
                    const int row = row0 + rr + q; _Float16* xh = X16 + (size_t)row * D; float ss = 0.f;
#pragma unroll
                    for (int j = 0; j < 8; ++j) { const h16x4 hv = __builtin_convertvector(v[q][j], h16x4); *(h16x4*)(xh + 4 * (64 * j + F.lane)) = hv; v[q][j] = __builtin_convertvector(hv, f32x4); }
#pragma unroll
                    for (int j = 0; j < 8; ++j) ss += (v[q][j][0] * v[q][j][0] + v[q][j][1] * v[q][j][1]) + (v[q][j][2] * v[q][j][2] + v[q][j][3] * v[q][j][3]);
                    const float rstd = 1.0f / sqrtf(wave_sum(ss) * (1.0f / D) + EPS);
                    bf16* orow = Hb + (size_t)row * D;
#pragma unroll
                    for (int j = 0; j < 8; ++j) { const f32x4 y = v[q][j] * rstd * a[j] + b[j]; u32x2 w; w.x = pk2(y[0], y[1]); w.y = pk2(y[2], y[3]); *(u32x2*)(orow + 4 * (64 * j + F.lane)) = w; }
                }
            }
        } else {
            for (int rr = 0; rr < 8; rr += MOD_ROWS) {
                h16x4 xr[MOD_ROWS][8];
#pragma unroll
                for (int q = 0; q < MOD_ROWS; ++q) { const _Float16* xh = X16 + (size_t)(row0 + rr + q) * D;
#pragma unroll
                    for (int j = 0; j < 8; ++j) xr[q][j] = *(const h16x4*)(xh + 4 * (64 * j + F.lane)); }
#pragma unroll
                for (int q = 0; q < MOD_ROWS; ++q) {
                    f32x4 v[8]; float ss = 0.f;
#pragma unroll
                    for (int j = 0; j < 8; ++j) { v[j] = __builtin_convertvector(xr[q][j], f32x4); ss += (v[j][0] * v[j][0] + v[j][1] * v[j][1]) + (v[j][2] * v[j][2] + v[j][3] * v[j][3]); }
                    const float rstd = 1.0f / sqrtf(wave_sum(ss) * (1.0f / D) + EPS);
                    bf16* orow = Hb + (size_t)(row0 + rr + q) * D;
#pragma unroll
                    for (int j = 0; j < 8; ++j) { const f32x4 y = v[j] * rstd * a[j] + b[j]; u32x2 w; w.x = pk2(y[0], y[1]); w.y = pk2(y[2], y[3]); *(u32x2*)(orow + 4 * (64 * j + F.lane)) = w; }
                }
            }
        }
    }
}

__device__ __forceinline__ void phase_even_conv(Frame& F, int i, const bf16* P, bf16* Cb) {
    const float* cw = kin(16) + (size_t)i * 3 * 1024;
    const int gt = F.vcu * 512 + F.tid, NT = F.G * 512;
    for (int idx = gt; idx < (NTOK / 8) * 128; idx += NT) {
        const int row0 = (idx >> 7) * 8, c = (idx & 127) * 8;
        int t0, L; if (row0 < NCTX) { t0 = row0 & 255; L = 256; } else { t0 = (row0 - NCTX) & 2047; L = 2048; }
        const bf16* pr = P + (size_t)row0 * IN_AB;
        v4u gcv[10], uv[10], gbv[8];
#pragma unroll
        for (int r = 0; r < 10; ++r) { const int tt = t0 + r - 1; const bool ok = tt >= 0 && tt < L; const bf16* p2 = pr + (ptrdiff_t)(r - 1) * IN_AB;
            gcv[r] = ok ? *(const v4u*)(p2 + 4096 + c) : (v4u){0u, 0u, 0u, 0u}; uv[r] = ok ? *(const v4u*)(p2 + 5120 + c) : (v4u){0u, 0u, 0u, 0u}; }
#pragma unroll
        for (int r = 0; r < 8; ++r) gbv[r] = *(const v4u*)(pr + (size_t)r * IN_AB + 3072 + c);
        f32x4 w[3][2];
#pragma unroll
        for (int j = 0; j < 3; ++j) { w[j][0] = *(const f32x4*)(cw + j * 1024 + c); w[j][1] = *(const f32x4*)(cw + j * 1024 + c + 4); }
        f32x4 pa[3][2];
#define CONV_PROD(dst, r) do { const v4u g_ = gcv[r], u_ = uv[r]; dst[0] = (f32x4){bflo(g_.x) * bflo(u_.x), bfhi(g_.x) * bfhi(u_.x), bflo(g_.y) * bflo(u_.y), bfhi(g_.y) * bfhi(u_.y)}; \
            dst[1] = (f32x4){bflo(g_.z) * bflo(u_.z), bfhi(g_.z) * bfhi(u_.z), bflo(g_.w) * bflo(u_.w), bfhi(g_.w) * bfhi(u_.w)}; } while (0)
        CONV_PROD(pa[0], 0); CONV_PROD(pa[1], 1);
#pragma unroll
        for (int r = 0; r < 8; ++r) {
            CONV_PROD(pa[(r + 2) % 3], r + 2);
            const f32x4 a0 = w[0][0] * pa[r % 3][0] + w[1][0] * pa[(r + 1) % 3][0] + w[2][0] * pa[(r + 2) % 3][0];
            const f32x4 a1 = w[0][1] * pa[r % 3][1] + w[1][1] * pa[(r + 1) % 3][1] + w[2][1] * pa[(r + 2) % 3][1];
            const v4u gb = gbv[r];
            v4u o; o.x = pk2(bflo(gb.x) * a0[0], bfhi(gb.x) * a0[1]); o.y = pk2(bflo(gb.y) * a0[2], bfhi(gb.y) * a0[3]); o.z = pk2(bflo(gb.z) * a1[0], bfhi(gb.z) * a1[1]); o.w = pk2(bflo(gb.w) * a1[2], bfhi(gb.w) * a1[3]);
            *(v4u*)(Cb + (size_t)(row0 + r) * D + 1024 + c) = o;
        }
#undef CONV_PROD
    }
}

#ifdef PROBE_SUB
#define PT_ARG , PT
#define PT_PARAM , att::ProbeT& PT
#else
#define PT_ARG
#define PT_PARAM
#endif
__device__ __forceinline__ void phase_even_attn(Frame& F, int i, const bf16* P, bf16* Cb PT_PARAM) {
    const bf16* CK = (const bf16*)(F.ws + SM_CK); const bf16* CV = (const bf16*)(F.ws + SM_CV);
    for (int u = F.vcu; u < 512; u += F.G) {
        att::AUnit U;
        U.scale = 0.08838834764831845f; U.ldq = IN_AB; U.ldo = D; U.r0 = 0; U.kr_lo = 0; U.rpb = nullptr; U.qsq = nullptr;
        if (u < 256) {
            const int b = u >> 3, h = u & 7; const size_t r0 = (size_t)b * 256;
            U.q = P + r0 * IN_AB + h * 128; U.o = Cb + r0 * D + h * 128;
            U.k0 = P + r0 * IN_AB + 1024 + h * 128; U.v0 = P + r0 * IN_AB + 2048 + h * 128; U.ldk0 = IN_AB; U.ldv0 = IN_AB; U.n0 = 4; U.ntiles = 4;
            U.k1 = U.k0; U.v1 = U.v0; U.ldk1 = IN_AB; U.ldv1 = IN_AB;
            att::attn_unit<128, false>(U, F.ldsg, F.wave PT_ARG);
        } else {
            const int n = u - 256, b = n >> 6, h = (n >> 3) & 7, rb = n & 7, r0 = 4 * rb;
            const size_t row0 = (size_t)NCTX + (size_t)b * 2048 + (size_t)r0 * 64;
            U.q = P + row0 * IN_AB + h * 128; U.o = Cb + row0 * D + h * 128;
            const size_t coff = ((((size_t)b * 2 + i) * 8 + h) * 256) * 128;
            U.k0 = CK + coff; U.v0 = CV + coff; U.ldk0 = 128; U.ldv0 = 128; U.n0 = 4;
            const int kr_lo = min(max(r0 - 4, 0), 24), kr_hi = min(max(r0 - 1, 0), 24) + 7;
            const size_t krow0 = (size_t)NCTX + (size_t)b * 2048 + (size_t)kr_lo * 64;
            U.k1 = P + krow0 * IN_AB + 1024 + h * 128; U.v1 = P + krow0 * IN_AB + 2048 + h * 128; U.ldk1 = IN_AB; U.ldv1 = IN_AB;
            U.ntiles = 4 + (kr_hi - kr_lo + 1); U.r0 = r0; U.kr_lo = kr_lo; U.rpb = kin(15) + ((size_t)i * 8 + h) * 15 * 31;
            att::attn_unit<128, true>(U, F.ldsg, F.wave PT_ARG);
        }
    }
}
#ifndef PROBE_NT
#define PROBE_NT 36
#endif
__device__ __forceinline__ void phase_odd_attn(Frame& F, const bf16* Qn, const bf16* Kn, const bf16* Vn, bf16* Ob, int probe PT_PARAM) {
    for (int u = F.vcu; u < 1024; u += F.G) {
        att::AUnit U;
        U.scale = 0.07216878364870323f; U.ldq = 3072; U.ldo = D; U.r0 = 0; U.kr_lo = 0; U.rpb = nullptr;
        U.ldk0 = 3072; U.ldv0 = 2048; U.ldk1 = 3072; U.ldv1 = 2048;
        if (u < 512) {
            const int b = u >> 4, h = u & 15; const size_t r0 = (size_t)b * 256;
            U.q = Qn + r0 * 3072 + h * 192; U.o = Ob + r0 * D + h * 128; U.qsq = (const float*)(F.ws + SM_QSQ) + r0 * 96 + 6 * h;
            U.k0 = Kn + r0 * 3072 + h * 192; U.v0 = Vn + r0 * 2048 + h * 128; U.n0 = 4; U.ntiles = 4; U.k1 = U.k0; U.v1 = U.v0;
        } else {
            const int n = u - 512, b = n >> 7, h = (n >> 3) & 15, qb = n & 7;
            const size_t row0 = (size_t)NCTX + (size_t)b * 2048 + (size_t)qb * 256, kc0 = (size_t)NTOK + (size_t)b * 256, kl0 = (size_t)NCTX + (size_t)b * 2048;
            U.q = Qn + row0 * 3072 + h * 192; U.o = Ob + row0 * D + h * 128; U.qsq = (const float*)(F.ws + SM_QSQ) + row0 * 96 + 6 * h;
            U.k0 = Kn + kc0 * 3072 + h * 192; U.v0 = Vn + kc0 * 2048 + h * 128; U.n0 = 4;
            U.k1 = Kn + kl0 * 3072 + h * 192; U.v1 = Vn + kl0 * 2048 + h * 128; U.ntiles = probe ? PROBE_NT : 36;
        }
        att::attn_unit<192, false>(U, F.ldsg, F.wave PT_ARG);
    }
}

struct Args { const float* in[28]; float* out; unsigned char* ws; int ph_lo, ph_hi; };
constexpr int PH_END = 1 + DEPTH * 10;
__host__ __device__ constexpr int pid(int l, int s) { return 1 + l * 10 + s; }

__global__ void __launch_bounds__(NWAVES * 64, 2) fwd_kernel(Args args) {
    extern __shared__ __attribute__((aligned(16))) unsigned char lds[];
    Frame F;
    F.lds = (LAS unsigned char*)lds; F.ldsg = (char*)lds;
    F.tid = threadIdx.x; F.lane = F.tid & 63; F.wave = __builtin_amdgcn_readfirstlane(F.tid >> 6);
    F.G = gridDim.x; { const int bx = blockIdx.x; F.vcu = (F.G % 8 == 0) ? (bx % 8) * (F.G / 8) + bx / 8 : bx; }
    F.gw = F.vcu * NWAVES + F.wave; F.NGW = F.G * NWAVES;
    F.out = (GAS float*)args.out; F.ws = (GAS unsigned char*)args.ws; F.l = 0;
    unsigned char* ws = args.ws;
    for (int u = F.tid; u < (LDS_BYTES - LDSCTL_OFF) / 4; u += NWAVES * 64) ((LAS unsigned*)(F.lds + LDSCTL_OFF))[u] = 0u;
    __syncthreads();
    const int lo = args.ph_lo, hi = args.ph_hi;
    XcdBarrier bar; bar.bar = (unsigned*)(ws + WS_CTL) + CW_BAR; bar.x = 0; bar.st = nullptr;
    if (hi - lo > 1) bar = xcd_barrier_post((unsigned*)(ws + WS_CTL) + CW_BAR, (volatile LAS unsigned*)(F.lds + LDSCTL_OFF) + 8);
#ifndef PH_MASK
#define PH_MASK 0xFFFF
#endif
#define EN(k) ((PH_MASK >> (k)) & 1)
#ifndef REP_MASK
#define REP_MASK 0
#endif
#define REPS(k) for (int rep_ = 0; rep_ < 1 + ((REP_MASK >> (k)) & 1); ++rep_)
#define RUN(p) (lo <= (p) && (p) < hi && fresh(F))
#ifdef PROBE_SUB
    att::ProbeT PT; PT.acc = 0; PT.last = 0; PT.state = -1;
#ifdef PROBE_SUB_EVEN
#define PT_ARG_E , PT
#else
#define PT_ARG_E , PTdummy
    att::ProbeT PTdummy; PTdummy.acc = 0; PTdummy.last = 0; PTdummy.state = -1;
#endif
#else
#define PT_ARG_E
#endif
#ifdef PROBE_SLOT
#ifndef PROBE_MULT
#define PROBE_MULT 4
#endif
    unsigned long long t_last_ = rt(), t_acc_ = 0;
#define STAMP(p) do { const unsigned long long now_ = rt(); const int s_ = (p) == 0 ? 99 : (((p) - 1) % 10) + 10 * ((((p) - 1) / 10) & 1); if (s_ == PROBE_SLOT || (PROBE_SLOT >= 100 && (s_ % 10) == (PROBE_SLOT - 100) && s_ != 99)) t_acc_ += now_ - t_last_; t_last_ = now_; } while (0)
#else
#define STAMP(p) do { } while (0)
#endif
#define SEAM(p) do { if ((p) + 1 < hi) xcd_barrier(bar); STAMP(p); } while (0)

#define WSP (F.ws)
#define XP ((float*)(F.out + O_X))
#define MODL ((const float*)(WSP + WS_MOD) + (size_t)F.l * 5 * 12288)
#define HB ((bf16*)(WSP + WS_H))
#define CB ((bf16*)(WSP + WS_C))
#define FB ((bf16*)(WSP + B_F))
#define X16P ((_Float16*)(WSP + WS_X16))

#define REDP ((PG8_LAS float*)(F.lds + LDSCTL_OFF + 1024))

    REPS(0) if (EN(0) && RUN(0)) { phase_prologue(F); SEAM(0); }

    for (int l = 0; l < DEPTH; ++l) {
        F.l = l;
        if (EN(1) && RUN(pid(l, 0))) {
            const float* xc = F.l == 0 ? kin(0) : (const float*)nullptr; const float* xs = F.l == 0 ? kin(1) - (size_t)NCTX * D : (const float*)nullptr;
            phase_mod(F, xc, xs, X16P, kin(8) + (size_t)F.l * D, MODL, 0, HB); SEAM(pid(l, 0)); }
        if ((l & 1) == 0) {
            REPS(2) if (EN(2) && RUN(pid(l, 1))) {
                const int i = F.l >> 1; bf16* P = (bf16*)(WSP + B_P);
                pg8::Gemm g{HB, (const bf16*)(WSP + W_IN_AB + i * SZ_IN_AB), NTOK, IN_AB, D}; pg8::StaticOrder S; S.init(NTOK, IN_AB, F.G, (int)blockIdx.x);
                pg8::EpiInAB E{P, kin(13) + i * 128, kin(14) + i * 128, (float*)(F.out + O_NATK + (size_t)i * 8 * 32768), (float*)(F.out + O_NATV + (size_t)i * 8 * 32768), REDP};
                pg8::gemm_phase<pg8::EpiInAB, pg8::StaticOrder, true, true>(F.lds, g, S, E, F.wave);
                SEAM(pid(l, 1));
            }
            REPS(4) if (EN(4) && RUN(pid(l, 5))) { const int i = F.l >> 1; bf16* P = (bf16*)(WSP + B_P);
                if (F.vcu & 1) { phase_even_conv(F, i, P, CB); fresh(F); phase_even_attn(F, i, P, CB PT_ARG_E); }
                else { phase_even_attn(F, i, P, CB PT_ARG_E); fresh(F); phase_even_conv(F, i, P, CB); }
                SEAM(pid(l, 5)); }
        } else {
            REPS(5) if (EN(5) && RUN(pid(l, 1))) {
                const int i = F.l >> 1;
                pg8::Gemm g{HB, (const bf16*)(WSP + W_DOWN + i * SZ_DOWN), NTOK, NDOWN_P, D}; pg8::StaticOrder S; S.init(NTOK, NDOWN_P, F.G, (int)blockIdx.x);
                pg8::EpiDown E{(bf16*)(WSP + SM_CQN), (float*)(WSP + SM_CQP), (bf16*)(WSP + SM_CKVN + i * SZ_CKVN), kin(20) + i * KVL, (float*)(F.out + O_CKV + (size_t)i * 65536), (float*)(F.out + O_KR + (size_t)i * 16384),
                               kin(24) + i * 192 + 128, (float*)(WSP + SM_KR + i * SZ_KR), (float*)(WSP + SM_KRSQ + i * SZ_KRSQ), REDP};
                pg8::gemm_phase<pg8::EpiDown, pg8::StaticOrder, true, true>(F.lds, g, S, E, F.wave);
                SEAM(pid(l, 1));
            }
            REPS(7) if (EN(7) && RUN(pid(l, 3))) {
                { const int i = F.l >> 1;
                  pg8::Gemm g{(const bf16*)(WSP + SM_CQN), (const bf16*)(WSP + W_UQ + i * SZ_UQ), NTOK, 3072, QL}; pg8::StaticOrder S; S.init(NTOK, 3072, F.G, (int)blockIdx.x);
                  pg8::EpiUQ E{(bf16*)(WSP + B_QC), kin(23) + i * 192, (const float*)(WSP + SM_CQP), (float*)(WSP + SM_QSQ)};
#ifndef NO_UQ
                  pg8::gemm_phase<pg8::EpiUQ, pg8::StaticOrder, true, true>(F.lds, g, S, E, F.wave);
#endif
                }
                fresh(F);
                { const int i = F.l >> 1;
                  pg8::Gemm g{(const bf16*)(WSP + SM_CKVN + i * SZ_CKVN), (const bf16*)(WSP + W_UKV + i * SZ_UKV), NKVROWS, 4096, KVL}; pg8::StaticOrder S; S.init(NKVROWS, 4096, F.G, (int)blockIdx.x);
                  pg8::EpiUKV E{(bf16*)(WSP + B_KN), (bf16*)(WSP + B_KV), kin(24) + i * 192, (const float*)(WSP + SM_KR + i * SZ_KR), (const float*)(WSP + SM_KRSQ + i * SZ_KRSQ), REDP};
#ifndef NO_UKV
                  pg8::gemm_phase<pg8::EpiUKV, pg8::StaticOrder, true, true>(F.lds, g, S, E, F.wave);
#endif
                }
                SEAM(pid(l, 3));
            }
            REPS(9) if (EN(9) && RUN(pid(l, 5))) { phase_odd_attn(F, (const bf16*)(WSP + B_QC), (const bf16*)(WSP + B_KN), (const bf16*)(WSP + B_KV), rep_ == 0 ? CB : (bf16*)(WSP + WS_BIG + 420 * MiB), rep_ PT_ARG); SEAM(pid(l, 5)); }
        }
        REPS(10) if (EN(10) && RUN(pid(l, 6))) {
            const int i = F.l >> 1;
            const bf16* Wt = (F.l & 1) ? (const bf16*)(WSP + W_O + i * SZ_DD) : (const bf16*)(WSP + W_OUT_AB + i * SZ_DD);
            pg8::Gemm g{CB, Wt, NTOK, D, D}; pg8::StaticOrder S; S.init(NTOK, D, F.G, (int)blockIdx.x);
            pg8::EpiYX E{rep_ == 0 ? X16P : (_Float16*)(WSP + WS_BIG + 320 * MiB), MODL + 2 * 2048};
            pg8::gemm_phase<pg8::EpiYX, pg8::StaticOrder, true, true>(F.lds, g, S, E, F.wave);
            SEAM(pid(l, 6));
        }
        REPS(11) if (EN(11) && RUN(pid(l, 7))) {
            phase_mod(F, (const float*)nullptr, (const float*)nullptr, X16P, kin(9) + (size_t)F.l * D, MODL, 3, HB); SEAM(pid(l, 7)); }
        REPS(12) if (EN(12) && RUN(pid(l, 8))) {
            pg8::Gemm g{HB, (const bf16*)(WSP + W_FFN_IN + F.l * SZ_FFN_IN), NTOK, 2 * DFF, D}; pg8::StaticOrder S; S.init(NTOK, 2 * DFF, F.G, (int)blockIdx.x);
            pg8::EpiSwiGLU E{FB, DFF};
            pg8::gemm_phase<pg8::EpiSwiGLU, pg8::StaticOrder, true, true>(F.lds, g, S, E, F.wave);
            SEAM(pid(l, 8));
        }
        if (EN(13) && RUN(pid(l, 9))) {
            pg8::Gemm g{FB, (const bf16*)(WSP + W_FFN_OUT + F.l * SZ_FFN_OUT), NTOK, D, DFF}; pg8::StaticOrder S; S.init(NTOK, D, F.G, (int)blockIdx.x);
            if (F.l == DEPTH - 1) { pg8::EpiRes E{X16P, XP, MODL + 5 * 2048};
                pg8::gemm_phase<pg8::EpiRes, pg8::StaticOrder, true, true>(F.lds, g, S, E, F.wave); }
            else { pg8::EpiYX E{X16P, MODL + 5 * 2048};
                pg8::gemm_phase<pg8::EpiYX, pg8::StaticOrder, true, true>(F.lds, g, S, E, F.wave); }
            SEAM(pid(l, 9));
        }
    }
#ifdef PROBE_SUB
    if (blockIdx.x == 0) { const unsigned long long t0_ = rt(); while (rt() - t0_ < 4ull * PT.acc) __builtin_amdgcn_s_sleep(8); }
#endif
#ifdef PROBE_PRO
    if (blockIdx.x == 0) { const unsigned long long t0_ = rt(); while (rt() - t0_ < 8ull * F.pacc) __builtin_amdgcn_s_sleep(8); }
#endif
#ifdef PROBE_SLOT
    if (blockIdx.x == 0) { const unsigned long long t0_ = rt(); while (rt() - t0_ < (unsigned long long)PROBE_MULT * t_acc_) __builtin_amdgcn_s_sleep(8); }
#endif
#undef RUN
#undef SEAM
}

#ifndef MK_ONE_LAUNCH
#define MK_ONE_LAUNCH 1
#endif
extern "C" void kernel_launch(void* const* d_in, const int* in_sizes, int n_in, void* d_out, int out_size, void* d_ws, size_t ws_size, hipStream_t stream) {
    static int grid = 0;
    if (grid == 0) {
        if (n_in != 28 || (size_t)out_size != O_END || ws_size < WS_END) { fprintf(stderr, "kernel_launch: unexpected shapes: n_in %d out %d ws %zu (need %zu)\n", n_in, out_size, ws_size, (size_t)WS_END); grid = -1; return; }
        int dev = 0, cus = 0, per_cu = 0;
        if (hipGetDevice(&dev) != hipSuccess || hipDeviceGetAttribute(&cus, hipDeviceAttributeMultiprocessorCount, dev) != hipSuccess) { grid = -1; return; }
        if (hipFuncSetAttribute((const void*)fwd_kernel, hipFuncAttributeMaxDynamicSharedMemorySize, LDS_BYTES) != hipSuccess) { fprintf(stderr, "kernel_launch: hipFuncSetAttribute failed\n"); grid = -1; return; }
        if (hipOccupancyMaxActiveBlocksPerMultiprocessor(&per_cu, (const void*)fwd_kernel, NWAVES * 64, LDS_BYTES) != hipSuccess || per_cu < 1) { fprintf(stderr, "kernel_launch: occupancy query says %d blocks per CU\n", per_cu); }
        (void)hipGetLastError();
        grid = cus;
    }
    if (grid < 0) return;
    (void)in_sizes;
    if (hipMemsetAsync((char*)d_ws + WS_CTL, 0, CTL_ZERO_BYTES, stream) != hipSuccess) { fprintf(stderr, "kernel_launch: memset failed\n"); return; }
    Args a{};
    for (int k = 0; k < 28; ++k) a.in[k] = (const float*)d_in[k];
    a.out = (float*)d_out; a.ws = (unsigned char*)d_ws;
#if MK_ONE_LAUNCH
    a.ph_lo = 0; a.ph_hi = PH_END;
    hipLaunchKernelGGL(fwd_kernel, dim3(grid), dim3(NWAVES * 64), LDS_BYTES, stream, a);
#else
    for (int p = 0; p < PH_END; ++p) {
        if (p > 0) { const int l = (p - 1) / 10, s = (p - 1) % 10; if ((l & 1) == 0 && (s == 2 || s == 3 || s == 4)) continue; if ((l & 1) == 1 && (s == 2 || s == 4)) continue; }
        a.ph_lo = p; a.ph_hi = p + 1;
        hipLaunchKernelGGL(fwd_kernel, dim3(grid), dim3(NWAVES * 64), LDS_BYTES, stream, a);
    }
#endif
    const hipError_t le = hipPeekAtLastError();
    if (le != hipSuccess) fprintf(stderr, "kernel_launch: launch failed: %s\n", hipGetErrorName(le));
}
```

```cpp
#include <hip/hip_runtime.h>
#include <cstdio>
#include <cstdint>
#include <cstddef>
__device__ __forceinline__ int lane_id_fresh() { int l = (int)__builtin_amdgcn_mbcnt_hi(~0u, __builtin_amdgcn_mbcnt_lo(~0u, 0u)); asm volatile("" : "+v"(l)); return l; }
namespace pg8 {
#define PG8_LAS __attribute__((address_space(3)))
typedef unsigned short bf16_t;
typedef short bf16x8 __attribute__((ext_vector_type(8)));
typedef float f32x4 __attribute__((ext_vector_type(4)));
typedef unsigned u32x4 __attribute__((ext_vector_type(4)));
constexpr int BM = 256, BK = 64, HALF = 128, HTB = HALF * BK * 2  , STAGE_BYTES = 8 * HTB, NXCD = 8, WGM = 8;

__host__ __device__ __forceinline__ int lds_byte(int r, int c) { const int st = (r >> 4) * 2 + (c >> 5), rr = r & 15, cc = c & 31, ob = rr * 64 + cc * 2; return st * 1024 + (ob ^ (((ob >> 9) & 1) << 5)); }
__host__ __device__ __forceinline__ void stage_rc(int b, int& R, int& C) { const int st = b / 1024, sb = b % 1024, swz = sb ^ (((sb >> 9) & 1) << 5); R = (st >> 1) * 16 + swz / 64; C = (st & 1) * 32 + (swz % 64) / 2; }
__host__ __device__ __forceinline__ int perm32(int rho) { const int n = rho >> 4, i = rho & 15; return 8 * (i >> 2) + 4 * n + (i & 3); }

struct Unit { int pm, pn; };
struct Gemm { const bf16_t* A; const bf16_t* Bt; int M, N, K; };

struct StaticOrder {
    int nM, nN, nwg, G, c; bool ilv = false;
    __host__ __device__ void init(int M, int N, int G_, int c_) { nM = M / BM; nN = N / BM; nwg = nM * nN; G = G_; c = c_; }
    __host__ __device__ bool next(int i, Unit& u) const {
        const long L = (long)i * G + c; if (L >= nwg) return false;
        int wgid = (int)L; { const int q = nwg / NXCD, r = nwg % NXCD, xcd = wgid % NXCD, off = wgid / NXCD; wgid = (xcd < r ? xcd * (q + 1) : r * (q + 1) + (xcd - r) * q) + off; }
        const int nig = WGM * nN, gid = wgid / nig, fm = gid * WGM, gsz = (nM - fm) < WGM ? (nM - fm) : WGM;
        u.pm = fm + ((wgid % nig) % gsz); u.pn = (wgid % nig) / gsz;
        if (ilv && u.pm < 64) u.pm = ((u.pm & 1) << 5) | (u.pm >> 1);
        return true;
    }
    __device__ __forceinline__ void a_ready(const Unit&) const {}
    __device__ __forceinline__ void done(const Unit&) const {}
};
__device__ __forceinline__ unsigned cvt_pk_bf16(float lo, float hi) { unsigned r; asm volatile("v_cvt_pk_bf16_f32 %0, %1, %2" : "=v"(r) : "v"(lo), "v"(hi)); return r; }

__device__ __forceinline__ int cond_of_pm(int pm) { return pm < 32 ? 0 : 1 + ((pm - 32) >> 3); }

struct EpiBf16P {
    static constexpr bool PERM = true, AFTER_DRAIN = false;
    bf16_t* O; int ldc;
    __device__ __forceinline__ void operator()(const f32x4 (&acc)[2][2][4][2], const Unit& u, int wr, int wc, int fr_in, int fq_in) const {
        (void)fr_in; (void)fq_in; const int lane_e = lane_id_fresh(), fr = lane_e & 15, fq = lane_e >> 4;
        const int row0 = u.pm * BM + wr * 64 + fr, col0 = u.pn * BM + wc * 32 + 8 * fq;
#pragma unroll
        for (int ai = 0; ai < 2; ++ai)
#pragma unroll
            for (int m = 0; m < 4; ++m) { bf16_t* rowp = O + (unsigned)(row0 + ai * HALF + m * 16) * (unsigned)ldc + col0;
#pragma unroll
                for (int bj = 0; bj < 2; ++bj) { const f32x4 v0 = acc[ai][bj][m][0], v1 = acc[ai][bj][m][1];
                    u32x4 w; w.x = cvt_pk_bf16(v0[0], v0[1]); w.y = cvt_pk_bf16(v0[2], v0[3]); w.z = cvt_pk_bf16(v1[0], v1[1]); w.w = cvt_pk_bf16(v1[2], v1[3]);
                    *(u32x4*)(rowp + bj * HALF) = w; } }
    }
};
struct EpiF32P {
    static constexpr bool PERM = false, AFTER_DRAIN = false;
    float* C; int ldc;
    __device__ __forceinline__ void operator()(const f32x4 (&acc)[2][2][4][2], const Unit& u, int wr, int wc, int fr_in, int fq_in) const {
        (void)fr_in; (void)fq_in; const int lane_e = lane_id_fresh(), fr = lane_e & 15, fq = lane_e >> 4;
        const int row0 = u.pm * BM + wr * 64 + fr, col0 = u.pn * BM + wc * 32 + 4 * fq;
#pragma unroll
        for (int ai = 0; ai < 2; ++ai)
#pragma unroll
            for (int m = 0; m < 4; ++m) { float* rowp = C + (unsigned)(row0 + ai * HALF + m * 16) * (unsigned)ldc + col0;
#pragma unroll
                for (int bj = 0; bj < 2; ++bj)
#pragma unroll
                    for (int n = 0; n < 2; ++n) *(f32x4*)(rowp + bj * HALF + n * 16) = acc[ai][bj][m][n]; }
    }
};
struct EpiRes {
    static constexpr bool PERM = false, AFTER_DRAIN = false;
    const _Float16* base; float* out; const float* gate;
    __device__ __forceinline__ void operator()(const f32x4 (&acc)[2][2][4][2], const Unit& u, int wr, int wc, int fr_in, int fq_in) const {
        typedef _Float16 h16x4 __attribute__((ext_vector_type(4)));
        (void)fr_in; (void)fq_in; const int lane_e = lane_id_fresh(), fr = lane_e & 15, fq = lane_e >> 4;
        const int row0 = u.pm * BM + wr * 64 + fr, col0 = u.pn * BM + wc * 32 + 4 * fq;
        const float* g = gate + (unsigned)cond_of_pm(u.pm) * 12288u + col0;
        f32x4 gv[2][2];
#pragma unroll
        for (int bj = 0; bj < 2; ++bj)
#pragma unroll
            for (int n = 0; n < 2; ++n) gv[bj][n] = *(const f32x4*)(g + bj * HALF + n * 16);
#pragma unroll
        for (int ai = 0; ai < 2; ++ai)
#pragma unroll
            for (int m = 0; m < 4; ++m) { const unsigned off = (unsigned)(row0 + ai * HALF + m * 16) * 2048u + col0;
#pragma unroll
                for (int bj = 0; bj < 2; ++bj)
#pragma unroll
                    for (int n = 0; n < 2; ++n) { const f32x4 bs = __builtin_convertvector(*(const h16x4*)(base + off + bj * HALF + n * 16), f32x4);
                        *(f32x4*)(out + off + bj * HALF + n * 16) = bs + gv[bj][n] * acc[ai][bj][m][n]; }
                if (m & 1) asm volatile("" ::: "memory"); }
    }
};
__device__ __forceinline__ float silu_f(float x) { return x * __builtin_amdgcn_rcpf(1.0f + __builtin_amdgcn_exp2f(-1.4426950408889634f * x)); }
__device__ __forceinline__ f32x4 swiglu4(const f32x4 g, const f32x4 u) {
    const f32x4 t = g * (-1.4426950408889634f);
    f32x4 d; d[0] = __builtin_amdgcn_exp2f(t[0]); d[1] = __builtin_amdgcn_exp2f(t[1]); d[2] = __builtin_amdgcn_exp2f(t[2]); d[3] = __builtin_amdgcn_exp2f(t[3]);
    d = d + 1.0f;
    f32x4 r; r[0] = __builtin_amdgcn_rcpf(d[0]); r[1] = __builtin_amdgcn_rcpf(d[1]); r[2] = __builtin_amdgcn_rcpf(d[2]); r[3] = __builtin_amdgcn_rcpf(d[3]);
    return (g * u) * r;
}
struct EpiSwiGLU {
    static constexpr bool PERM = true, AFTER_DRAIN = false;
    bf16_t* O; int ldc;
    __device__ __forceinline__ void operator()(const f32x4 (&acc)[2][2][4][2], const Unit& u, int wr, int wc, int fr_in, int fq_in) const {
        (void)fr_in; (void)fq_in; const int lane_e = lane_id_fresh(), fr = lane_e & 15, fq = lane_e >> 4;
        const int row0 = u.pm * BM + wr * 64 + fr, col0 = u.pn * HALF + wc * 32 + 8 * fq;
#pragma unroll
        for (int ai = 0; ai < 2; ++ai)
#pragma unroll
            for (int m = 0; m < 4; ++m) { bf16_t* rowp = O + (unsigned)(row0 + ai * HALF + m * 16) * (unsigned)ldc + col0;
                const f32x4 g0 = acc[ai][0][m][0], g1 = acc[ai][0][m][1], u0 = acc[ai][1][m][0], u1 = acc[ai][1][m][1];
                const f32x4 h0 = swiglu4(g0, u0), h1 = swiglu4(g1, u1);
                u32x4 w; w.x = cvt_pk_bf16(h0[0], h0[1]); w.y = cvt_pk_bf16(h0[2], h0[3]); w.z = cvt_pk_bf16(h1[0], h1[1]); w.w = cvt_pk_bf16(h1[2], h1[3]);
                *(u32x4*)rowp = w; }
    }
};

constexpr float NORM_EPS = 1e-6f;
__device__ __forceinline__ float sum_rows4(float s) {
    const auto a = __builtin_amdgcn_permlane16_swap(__float_as_uint(s), __float_as_uint(s), false, false); s = __uint_as_float(a[0]) + __uint_as_float(a[1]);
    const auto b = __builtin_amdgcn_permlane32_swap(__float_as_uint(s), __float_as_uint(s), false, false); return __uint_as_float(b[0]) + __uint_as_float(b[1]);
}
__device__ __forceinline__ float xor32(float y, bool upper) { const auto b = __builtin_amdgcn_permlane32_swap(__float_as_uint(y), __float_as_uint(y), false, false); return __uint_as_float(upper ? b[0] : b[1]); }
__device__ __forceinline__ void row_half_allreduce(float (&ss)[2][4][2], PG8_LAS float* red, int wr, int wc, int fr, int fq) {
#pragma unroll
    for (int ai = 0; ai < 2; ++ai)
#pragma unroll
        for (int m = 0; m < 4; ++m)
#pragma unroll
            for (int bj = 0; bj < 2; ++bj) ss[ai][m][bj] = sum_rows4(ss[ai][m][bj]);
    if (fq == 0) {
#pragma unroll
        for (int ai = 0; ai < 2; ++ai)
#pragma unroll
            for (int m = 0; m < 4; ++m)
#pragma unroll
                for (int bj = 0; bj < 2; ++bj) red[((ai * HALF + wr * 64 + m * 16 + fr) * 2 + bj) * 4 + wc] = ss[ai][m][bj];
    }
    asm volatile("s_waitcnt lgkmcnt(0)" ::: "memory"); __builtin_amdgcn_s_barrier(); asm volatile("" ::: "memory");
}
__device__ __forceinline__ void row_half_read(const PG8_LAS float* red, int ai, int m, int wr, int fr, float& s0, float& s1) {
    const PG8_LAS f32x4* p = (const PG8_LAS f32x4*)(red + (ai * HALF + wr * 64 + m * 16 + fr) * 8);
    const f32x4 a = p[0], b = p[1]; s0 = (a[0] + a[1]) + (a[2] + a[3]); s1 = (b[0] + b[1]) + (b[2] + b[3]);
}
__device__ __forceinline__ float dot4(const f32x4 a) { return (a[0] * a[0] + a[1] * a[1]) + (a[2] * a[2] + a[3] * a[3]); }
__device__ __forceinline__ u32x4 pack8(const f32x4 a, const f32x4 b) { u32x4 w; w.x = cvt_pk_bf16(a[0], a[1]); w.y = cvt_pk_bf16(a[2], a[3]); w.z = cvt_pk_bf16(b[0], b[1]); w.w = cvt_pk_bf16(b[2], b[3]); return w; }

struct EpiInAB {
    static constexpr bool PERM = true, AFTER_DRAIN = false;
    bf16_t* P; const float* gq; const float* gk; float* natk; float* natv; PG8_LAS float* red;
    __device__ __forceinline__ void operator()(const f32x4 (&acc)[2][2][4][2], const Unit& u, int wr, int wc, int fr_in, int fq_in) const {
        (void)fr_in; (void)fq_in; const int lane_e = lane_id_fresh(), fr = lane_e & 15, fq = lane_e >> 4;
        const int row0 = u.pm * BM + wr * 64 + fr, col0 = u.pn * BM + wc * 32 + 8 * fq, dh = wc * 32 + 8 * fq;
        if (u.pn < 8) {
            float ss[2][4][2];
#pragma unroll
            for (int ai = 0; ai < 2; ++ai)
#pragma unroll
                for (int m = 0; m < 4; ++m)
#pragma unroll
                    for (int bj = 0; bj < 2; ++bj) ss[ai][m][bj] = dot4(acc[ai][bj][m][0]) + dot4(acc[ai][bj][m][1]);
            row_half_allreduce(ss, red, wr, wc, fr, fq);
            const float* g = (u.pn < 4 ? gq : gk) + dh; const f32x4 g0 = *(const f32x4*)g, g1 = *(const f32x4*)(g + 4);
            const bool emit = u.pn >= 4 && u.pm < 32;
#pragma unroll
            for (int ai = 0; ai < 2; ++ai)
#pragma unroll
                for (int m = 0; m < 4; ++m) { bf16_t* rowp = P + (unsigned)(row0 + ai * HALF + m * 16) * 6144u + col0;
                    float st[2]; row_half_read(red, ai, m, wr, fr, st[0], st[1]);
#pragma unroll
                    for (int bj = 0; bj < 2; ++bj) { const float rstd = __builtin_amdgcn_rsqf(st[bj] * (1.0f / 128.0f) + NORM_EPS);
                        const f32x4 y0 = acc[ai][bj][m][0] * rstd * g0, y1 = acc[ai][bj][m][1] * rstd * g1;
                        *(u32x4*)(rowp + bj * HALF) = pack8(y0, y1);
                        if (emit) { const int h = (u.pn - 4) * 2 + bj, t = ai * HALF + wr * 64 + m * 16 + fr; float* dst = natk + ((unsigned)(u.pm * 16 + h) * 256u + (unsigned)t) * 128u + dh;
                            *(f32x4*)dst = y0; *(f32x4*)(dst + 4) = y1; } }
                    asm volatile("" ::: "memory"); }
        } else {
            const bool emit = u.pn < 12 && u.pm < 32;
#pragma unroll
            for (int ai = 0; ai < 2; ++ai)
#pragma unroll
                for (int m = 0; m < 4; ++m) { bf16_t* rowp = P + (unsigned)(row0 + ai * HALF + m * 16) * 6144u + col0;
#pragma unroll
                    for (int bj = 0; bj < 2; ++bj) { const f32x4 y0 = acc[ai][bj][m][0], y1 = acc[ai][bj][m][1];
                        *(u32x4*)(rowp + bj * HALF) = pack8(y0, y1);
                        if (emit) { const int h = (u.pn - 8) * 2 + bj, t = ai * HALF + wr * 64 + m * 16 + fr; float* dst = natv + ((unsigned)(u.pm * 16 + h) * 256u + (unsigned)t) * 128u + dh;
                            *(f32x4*)dst = y0; *(f32x4*)(dst + 4) = y1; } } }
        }
    }
};
struct EpiUQ {
    static constexpr bool PERM = true, AFTER_DRAIN = false;
    bf16_t* Qn; const float* gq; const float* CQP; float* QSQ;
    __device__ __forceinline__ void operator()(const f32x4 (&acc)[2][2][4][2], const Unit& u, int wr, int wc, int fr_in, int fq_in) const {
        (void)fr_in; (void)fq_in; const int lane_e = lane_id_fresh(), fr = lane_e & 15, fq = lane_e >> 4;
        const int row0 = u.pm * BM + wr * 64 + fr;
        float rq[2][4];
#pragma unroll
        for (int ai = 0; ai < 2; ++ai)
#pragma unroll
            for (int m = 0; m < 4; ++m) { const float* cp = CQP + (unsigned)(row0 + ai * HALF + m * 16) * 8u; const f32x4 a = *(const f32x4*)cp, b = *(const f32x4*)(cp + 4);
                rq[ai][m] = __builtin_amdgcn_rsqf((((a[0] + a[1]) + (a[2] + a[3])) + ((b[0] + b[1]) + (b[2] + b[3]))) * (1.0f / 512.0f) + NORM_EPS); }
        const bool lat = u.pm >= 32; const int jf = 8 * (fq & 1); const bool isx2 = (fq >> 1) != 0;
        f32x4 fr0, fr1;
#pragma unroll
        for (int e4 = 0; e4 < 4; ++e4) { fr0[e4] = exp2f(-(float)(jf + e4) * (13.287712379549449f / 16.0f)) * 0.15915494309189535f; fr1[e4] = exp2f(-(float)(jf + 4 + e4) * (13.287712379549449f / 16.0f)) * 0.15915494309189535f; }
#pragma unroll
        for (int bj = 0; bj < 2; ++bj) {
            const int blk = 4 * u.pn + 2 * bj + (wc >> 1), hd = blk / 3, part = blk - 3 * hd;
            const int dh = part * 64 + (wc & 1) * 32 + 8 * fq;
            const f32x4 g0 = *(const f32x4*)(gq + dh), g1 = *(const f32x4*)(gq + dh + 4);
            const bool rope = part == 2 && lat;
#pragma unroll
            for (int ai = 0; ai < 2; ++ai)
#pragma unroll
                for (int m = 0; m < 4; ++m) { const unsigned row = (unsigned)(row0 + ai * HALF + m * 16);
                    const f32x4 q0 = acc[ai][bj][m][0] * rq[ai][m], q1 = acc[ai][bj][m][1] * rq[ai][m];
                    const float s = sum_rows4(dot4(q0) + dot4(q1));
                    if (fq == 0) QSQ[row * 96u + 2 * blk + (wc & 1)] = s;
                    f32x4 y0 = q0 * g0, y1 = q1 * g1;
                    if (rope) {
                        const int t = ((int)row - 8192) & 2047; const float pos = (float)((wc & 1) ? (t & 63) : (t >> 6));
                        f32x4 c0, c1, s0, s1, p0, p1;
#pragma unroll
                        for (int e4 = 0; e4 < 4; ++e4) { c0[e4] = __builtin_amdgcn_cosf(pos * fr0[e4]); s0[e4] = __builtin_amdgcn_sinf(pos * fr0[e4]); c1[e4] = __builtin_amdgcn_cosf(pos * fr1[e4]); s1[e4] = __builtin_amdgcn_sinf(pos * fr1[e4]); }
#pragma unroll
                        for (int e4 = 0; e4 < 4; ++e4) { p0[e4] = xor32(y0[e4], isx2); p1[e4] = xor32(y1[e4], isx2); }
                        if (isx2) { y0 = p0 * s0 + y0 * c0; y1 = p1 * s1 + y1 * c1; } else { y0 = y0 * c0 - p0 * s0; y1 = y1 * c1 - p1 * s1; }
                    }
                    *(u32x4*)(Qn + row * 3072u + u.pn * BM + bj * HALF + wc * 32 + 8 * fq) = pack8(y0, y1);
                    asm volatile("" ::: "memory"); }
        }
    }
};
struct EpiUKV {
    static constexpr bool PERM = true, AFTER_DRAIN = false;
    bf16_t* Kn; bf16_t* Vn; const float* gk; const float* RK; const float* KRSQ; PG8_LAS float* red;
    __device__ __forceinline__ void operator()(const f32x4 (&acc)[2][2][4][2], const Unit& u, int wr, int wc, int fr_in, int fq_in) const {
        typedef unsigned u32x2v __attribute__((ext_vector_type(2)));
        (void)fr_in; (void)fq_in; const int lane_e = lane_id_fresh(), fr = lane_e & 15, fq = lane_e >> 4;
        const int row0 = u.pm * BM + wr * 64 + fr, dh = wc * 32 + 8 * fq, kc = wc * 16 + 4 * fq;
        f32x4 rk[2][4]; float ksq[2][4];
#pragma unroll
        for (int ai = 0; ai < 2; ++ai)
#pragma unroll
            for (int m = 0; m < 4; ++m) { const unsigned row = (unsigned)(row0 + ai * HALF + m * 16); rk[ai][m] = *(const f32x4*)(RK + row * 64u + kc); ksq[ai][m] = KRSQ[row]; }
        const f32x4 ga0 = *(const f32x4*)(gk + dh), ga1 = *(const f32x4*)(gk + dh + 4);
        float ss[2][4][2];
#pragma unroll
        for (int ai = 0; ai < 2; ++ai)
#pragma unroll
            for (int m = 0; m < 4; ++m) { ss[ai][m][0] = dot4(acc[ai][0][m][0]) + dot4(acc[ai][0][m][1]); ss[ai][m][1] = 0.f; }
        row_half_allreduce(ss, red, wr, wc, fr, fq);
#pragma unroll
        for (int ai = 0; ai < 2; ++ai)
#pragma unroll
            for (int m = 0; m < 4; ++m) { const unsigned row = (unsigned)(row0 + ai * HALF + m * 16); bf16_t* rowp = Kn + row * 3072u + u.pn * 192;
                float st0, st1; row_half_read(red, ai, m, wr, fr, st0, st1);
                const float rstd = __builtin_amdgcn_rsqf((st0 + ksq[ai][m]) * (1.0f / 192.0f) + NORM_EPS);
                *(u32x4*)(rowp + dh) = pack8(acc[ai][0][m][0] * rstd * ga0, acc[ai][0][m][1] * rstd * ga1);
                *(u32x4*)(Vn + row * 2048u + u.pn * 128 + dh) = pack8(acc[ai][1][m][0], acc[ai][1][m][1]);
                const f32x4 y = rk[ai][m] * rstd; u32x2v w; w.x = cvt_pk_bf16(y[0], y[1]); w.y = cvt_pk_bf16(y[2], y[3]);
                *(u32x2v*)(rowp + 128 + kc) = w; }
    }
};
struct EpiYX {
    static constexpr bool PERM = true, AFTER_DRAIN = false;
    _Float16* X; const float* gate;
    __device__ __forceinline__ void operator()(const f32x4 (&acc)[2][2][4][2], const Unit& u, int wr, int wc, int fr_in, int fq_in) const {
        typedef _Float16 h16x4 __attribute__((ext_vector_type(4)));
        typedef _Float16 h16x8 __attribute__((ext_vector_type(8)));
        (void)fr_in; (void)fq_in; const int lane_e = lane_id_fresh(), fr = lane_e & 15, fq = lane_e >> 4;
        const int row0 = u.pm * BM + wr * 64 + fr, col0 = u.pn * BM + wc * 32 + 8 * fq;
        const float* g = gate + (unsigned)cond_of_pm(u.pm) * 12288u + col0;
        _Float16* xb = X + (unsigned)row0 * 2048u + col0;
        h16x8 xr[2][4][2];
#pragma unroll
        for (int ai = 0; ai < 2; ++ai)
#pragma unroll
            for (int m = 0; m < 4; ++m)
#pragma unroll
                for (int bj = 0; bj < 2; ++bj) xr[ai][m][bj] = *(const h16x8*)(xb + (unsigned)(ai * HALF + m * 16) * 2048u + bj * HALF);
        f32x4 gv[2][2];
#pragma unroll
        for (int bj = 0; bj < 2; ++bj)
#pragma unroll
            for (int n = 0; n < 2; ++n) gv[bj][n] = *(const f32x4*)(g + bj * HALF + n * 4);
        asm volatile("" ::: "memory");
#pragma unroll
        for (int ai = 0; ai < 2; ++ai)
#pragma unroll
            for (int m = 0; m < 4; ++m)
#pragma unroll
                for (int bj = 0; bj < 2; ++bj) {
                    const f32x4 x0 = __builtin_convertvector(__builtin_shufflevector(xr[ai][m][bj], xr[ai][m][bj], 0, 1, 2, 3), f32x4) + acc[ai][bj][m][0] * gv[bj][0];
                    const f32x4 x1 = __builtin_convertvector(__builtin_shufflevector(xr[ai][m][bj], xr[ai][m][bj], 4, 5, 6, 7), f32x4) + acc[ai][bj][m][1] * gv[bj][1];
                    const h16x4 h0 = __builtin_convertvector(x0, h16x4), h1 = __builtin_convertvector(x1, h16x4);
                    *(h16x8*)(xb + (unsigned)(ai * HALF + m * 16) * 2048u + bj * HALF) = __builtin_shufflevector(h0, h1, 0, 1, 2, 3, 4, 5, 6, 7); }
    }
};
struct EpiDown {
    static constexpr bool PERM = true, AFTER_DRAIN = false;
    bf16_t* cqn; float* CQP; bf16_t* ckvn; const float* gckv; float* out_ckv; float* out_kr; const float* gkr; float* RK; float* KRSQ; PG8_LAS float* red;
    __device__ __forceinline__ void operator()(const f32x4 (&acc)[2][2][4][2], const Unit& u, int wr, int wc, int fr_in, int fq_in) const {
        (void)fr_in; (void)fq_in; const int lane_e = lane_id_fresh(), fr = lane_e & 15, fq = lane_e >> 4;
        const int row0 = u.pm * BM + wr * 64 + fr, dh = wc * 32 + 8 * fq;
        if (u.pn < 2) {
#pragma unroll
            for (int ai = 0; ai < 2; ++ai)
#pragma unroll
                for (int m = 0; m < 4; ++m) { const unsigned row = (unsigned)(row0 + ai * HALF + m * 16);
                    float s = (dot4(acc[ai][0][m][0]) + dot4(acc[ai][0][m][1])) + (dot4(acc[ai][1][m][0]) + dot4(acc[ai][1][m][1]));
                    s = sum_rows4(s);
                    if (fq == 0) CQP[row * 8u + u.pn * 4 + wc] = s;
#pragma unroll
                    for (int bj = 0; bj < 2; ++bj) *(u32x4*)(cqn + row * 512u + u.pn * 256 + bj * HALF + dh) = pack8(acc[ai][bj][m][0], acc[ai][bj][m][1]); }
        } else if (u.pn == 2) {
            float ss[2][4][2];
#pragma unroll
            for (int ai = 0; ai < 2; ++ai)
#pragma unroll
                for (int m = 0; m < 4; ++m)
#pragma unroll
                    for (int bj = 0; bj < 2; ++bj) ss[ai][m][bj] = dot4(acc[ai][bj][m][0]) + dot4(acc[ai][bj][m][1]);
            row_half_allreduce(ss, red, wr, wc, fr, fq);
            f32x4 g[2][2];
#pragma unroll
            for (int bj = 0; bj < 2; ++bj) { g[bj][0] = *(const f32x4*)(gckv + bj * HALF + dh); g[bj][1] = *(const f32x4*)(gckv + bj * HALF + dh + 4); }
#pragma unroll
            for (int ai = 0; ai < 2; ++ai)
#pragma unroll
                for (int m = 0; m < 4; ++m) { const unsigned row = (unsigned)(row0 + ai * HALF + m * 16);
                    float st0, st1; row_half_read(red, ai, m, wr, fr, st0, st1);
                    const float rstd = __builtin_amdgcn_rsqf((st0 + st1) * (1.0f / 256.0f) + NORM_EPS);
#pragma unroll
                    for (int bj = 0; bj < 2; ++bj) { const f32x4 y0 = acc[ai][bj][m][0] * rstd * g[bj][0], y1 = acc[ai][bj][m][1] * rstd * g[bj][1];
                        *(u32x4*)(ckvn + row * 256u + bj * HALF + dh) = pack8(y0, y1);
                        if (u.pm < 32) { float* dst = out_ckv + ((unsigned)(u.pm * 2) * 256u + (unsigned)(ai * HALF + wr * 64 + m * 16 + fr)) * 256u + bj * HALF + dh; *(f32x4*)dst = y0; *(f32x4*)(dst + 4) = y1; } }
                    asm volatile("" ::: "memory"); }
        } else {
            const bool mine = wc < 2;
            float ss[2][4][2];
#pragma unroll
            for (int ai = 0; ai < 2; ++ai)
#pragma unroll
                for (int m = 0; m < 4; ++m) { ss[ai][m][0] = mine ? dot4(acc[ai][0][m][0]) + dot4(acc[ai][0][m][1]) : 0.f; ss[ai][m][1] = 0.f; }
            row_half_allreduce(ss, red, wr, wc, fr, fq);
            f32x4 g0 = {0.f, 0.f, 0.f, 0.f}, g1 = {0.f, 0.f, 0.f, 0.f};
            if (mine) { g0 = *(const f32x4*)(gkr + dh); g1 = *(const f32x4*)(gkr + dh + 4); }
            const bool lat = u.pm >= 32; const int jf = 8 * (fq & 1); const bool isx2 = (fq >> 1) != 0;
            f32x4 fr0, fr1;
#pragma unroll
            for (int e4 = 0; e4 < 4; ++e4) { fr0[e4] = exp2f(-(float)(jf + e4) * (13.287712379549449f / 16.0f)) * 0.15915494309189535f; fr1[e4] = exp2f(-(float)(jf + 4 + e4) * (13.287712379549449f / 16.0f)) * 0.15915494309189535f; }
#pragma unroll
            for (int ai = 0; ai < 2; ++ai)
#pragma unroll
                for (int m = 0; m < 4; ++m) { const unsigned row = (unsigned)(row0 + ai * HALF + m * 16);
                    float st0, st1; row_half_read(red, ai, m, wr, fr, st0, st1);
                    if (wc == 0 && fq == 0) KRSQ[row] = st0;
                    const f32x4 k0 = acc[ai][0][m][0], k1 = acc[ai][0][m][1];
                    if (mine && u.pm < 32) { float* dst = out_kr + ((unsigned)(u.pm * 2) * 256u + (unsigned)(ai * HALF + wr * 64 + m * 16 + fr)) * 64u + dh; *(f32x4*)dst = k0; *(f32x4*)(dst + 4) = k1; }
                    f32x4 y0 = k0 * g0, y1 = k1 * g1;
                    if (lat && mine) {
                        const int t = ((int)row - 8192) & 2047; const float pos = (float)(wc ? (t & 63) : (t >> 6));
                        f32x4 c0, c1, s0, s1, p0, p1;
#pragma unroll
                        for (int e4 = 0; e4 < 4; ++e4) { c0[e4] = __builtin_amdgcn_cosf(pos * fr0[e4]); s0[e4] = __builtin_amdgcn_sinf(pos * fr0[e4]); c1[e4] = __builtin_amdgcn_cosf(pos * fr1[e4]); s1[e4] = __builtin_amdgcn_sinf(pos * fr1[e4]); }
#pragma unroll
                        for (int e4 = 0; e4 < 4; ++e4) { p0[e4] = xor32(y0[e4], isx2); p1[e4] = xor32(y1[e4], isx2); }
                        if (isx2) { y0 = p0 * s0 + y0 * c0; y1 = p1 * s1 + y1 * c1; } else { y0 = y0 * c0 - p0 * s0; y1 = y1 * c1 - p1 * s1; }
                    }
                    if (mine) { float* dst = RK + row * 64u + dh; *(f32x4*)dst = y0; *(f32x4*)(dst + 4) = y1; }
                    asm volatile("" ::: "memory"); }
        }
    }
};
template <class Epi, class Sched, bool ALIGN_EPI = false, bool SP2 = false>
__device__ __forceinline__ void gemm_phase(PG8_LAS unsigned char* lds, const Gemm g, const Sched& S, const Epi& E, const int wid_in) {
    const int tid_ = wid_in * 64 + lane_id_fresh();
    const int tid = tid_, wid = wid_in, lane = tid & 63, wr = wid >> 2, wc = wid & 3, fr = lane & 15, fq = lane >> 4;
    int K_ = g.K; asm volatile("" : "+s"(K_));
    const int K = K_, nt = K / BK;
    unsigned voffA[2], voffB[2];
#pragma unroll
    for (int i = 0; i < 2; ++i) { int R, C; stage_rc(tid * 16 + i * 8192, R, C); const int Rb = Epi::PERM ? ((R & ~31) + perm32(R & 31)) : R;
        voffA[i] = (unsigned)(R * K + C) * 2u; voffB[i] = (unsigned)(Rb * K + C) * 2u; }
    const size_t kstep = (size_t)(BK * 2);
    const size_t hstep = (size_t)HALF * K * 2;
    const size_t tstep = 2 * hstep;
    const unsigned ldsw = (unsigned)wid * 1024u;
    const int aoff = lds_byte(wr * 64 + fr, fq * 8), boff = lds_byte(wc * 32 + fr, fq * 8);
#define PG8_SA(b, h) (((b) * 2 + (h)) * HTB)
#define PG8_SB(b, h) ((4 + (b) * 2 + (h)) * HTB)
#define PG8_STAGE(bufoff, gbase, voff) do { _Pragma("unroll") for (int _i = 0; _i < 2; ++_i) \
        __builtin_amdgcn_global_load_lds((const unsigned*)((const char*)(gbase) + (voff)[_i]), (PG8_LAS unsigned*)(lds + (bufoff) + ldsw + _i * 8192), 16, 0, 0); } while (0)
#define PG8_LDA(dst, b, h) do { _Pragma("unroll") for (int m = 0; m < 4; ++m) _Pragma("unroll") for (int k = 0; k < 2; ++k) dst[m][k] = *(const PG8_LAS bf16x8*)(lds + PG8_SA(b, h) + aoff + m * 2048 + k * 1024); } while (0)
#define PG8_LDB(dst, b, h) do { _Pragma("unroll") for (int n = 0; n < 2; ++n) _Pragma("unroll") for (int k = 0; k < 2; ++k) dst[n][k] = *(const PG8_LAS bf16x8*)(lds + PG8_SB(b, h) + boff + n * 2048 + k * 1024); } while (0)
#define PG8_MMA(ai, bj, At, Bt) do { __builtin_amdgcn_s_setprio(1); _Pragma("unroll") for (int m = 0; m < 4; ++m) _Pragma("unroll") for (int n = 0; n < 2; ++n) _Pragma("unroll") for (int k = 0; k < 2; ++k) \
        acc[ai][bj][m][n] = __builtin_amdgcn_mfma_f32_16x16x32_bf16(Bt[n][k], At[m][k], acc[ai][bj][m][n], 0, 0, 0); __builtin_amdgcn_s_setprio(0); } while (0)
#define PG8_WAIT_V(n) asm volatile("s_waitcnt vmcnt(" #n ")" ::: "memory")
#define PG8_WAIT_L(n) asm volatile("s_waitcnt lgkmcnt(" #n ")" ::: "memory")
#define PG8_BAR __builtin_amdgcn_s_barrier()
#define PG8_SCHED __builtin_amdgcn_sched_barrier(0)
    Unit cur, nxt; int ui = 0;
    if (!S.next(0, cur)) return;
    f32x4 acc[2][2][4][2];
#pragma unroll
    for (int a = 0; a < 2; ++a)
#pragma unroll
        for (int b = 0; b < 2; ++b)
#pragma unroll
            for (int m = 0; m < 4; ++m)
#pragma unroll
                for (int n = 0; n < 2; ++n) acc[a][b][m][n] = (f32x4){0.f, 0.f, 0.f, 0.f};
    bf16x8 At[4][2], B0[2][2], B1[2][2];
    const char* cA = (const char*)g.A + (size_t)cur.pm * tstep; const char* cB = (const char*)g.Bt + (size_t)cur.pn * tstep;
    S.a_ready(cur);
    if constexpr (SP2) {
        PG8_STAGE(PG8_SB(0, 0), cB, voffB); PG8_STAGE(PG8_SB(0, 1), cB + hstep, voffB); PG8_STAGE(PG8_SA(0, 0), cA, voffA); PG8_STAGE(PG8_SA(0, 1), cA + hstep, voffA);
        if (wr == 1) PG8_BAR;
        PG8_WAIT_V(2); PG8_BAR;
        PG8_STAGE(PG8_SB(1, 0), cB + kstep, voffB); PG8_STAGE(PG8_SA(1, 0), cA + kstep, voffA); PG8_STAGE(PG8_SB(1, 1), cB + hstep + kstep, voffB);
        PG8_WAIT_V(6); PG8_BAR;
    } else {
        PG8_STAGE(PG8_SB(0, 0), cB, voffB); PG8_STAGE(PG8_SA(0, 0), cA, voffA); PG8_STAGE(PG8_SB(0, 1), cB + hstep, voffB); PG8_STAGE(PG8_SA(0, 1), cA + hstep, voffA);
        if (wr == 1) PG8_BAR;
        PG8_WAIT_V(4); PG8_BAR;
        PG8_STAGE(PG8_SB(1, 0), cB + kstep, voffB); PG8_STAGE(PG8_SA(1, 0), cA + kstep, voffA); PG8_STAGE(PG8_SB(1, 1), cB + hstep + kstep, voffB);
        PG8_WAIT_V(6); PG8_BAR;
    }
    for (;;) {
        const bool has_next = S.next(ui + 1, nxt);
        const char* nA = has_next ? (const char*)g.A + (size_t)nxt.pm * tstep : cA; const char* nB = has_next ? (const char*)g.Bt + (size_t)nxt.pn * tstep : cB;
        for (int t = 0; t < nt; t += 2) {
            const bool last = (t == nt - 2);
            const char* a1 = cA + (size_t)(t + 1) * kstep;
            const char* a2 = last ? nA : cA + (size_t)(t + 2) * kstep; const char* b2 = last ? nB : cB + (size_t)(t + 2) * kstep;
            const char* a3 = a2 + kstep; const char* b3 = b2 + kstep;
            if (last && has_next) S.a_ready(nxt);
            if constexpr (SP2) {
            PG8_LDB(B0, 0, 0); PG8_LDB(B1, 0, 1); PG8_SCHED; PG8_LDA(At, 0, 0); PG8_STAGE(PG8_SA(1, 1), a1 + hstep, voffA);
            PG8_WAIT_V(8); PG8_WAIT_L(0); PG8_BAR; PG8_MMA(0, 0, At, B0); PG8_MMA(0, 1, At, B1); PG8_BAR; PG8_SCHED;
            PG8_LDA(At, 0, 1); PG8_STAGE(PG8_SB(0, 0), b2, voffB); PG8_STAGE(PG8_SB(0, 1), b2 + hstep, voffB); PG8_STAGE(PG8_SA(0, 0), a2, voffA);
            PG8_WAIT_V(8); PG8_WAIT_L(0); PG8_BAR; PG8_MMA(1, 0, At, B0); PG8_MMA(1, 1, At, B1); PG8_BAR; PG8_SCHED;
            PG8_LDB(B0, 1, 0); PG8_LDB(B1, 1, 1); PG8_SCHED; PG8_LDA(At, 1, 0); PG8_STAGE(PG8_SA(0, 1), a2 + hstep, voffA);
            PG8_WAIT_V(8); PG8_WAIT_L(0); PG8_BAR; PG8_MMA(0, 0, At, B0); PG8_MMA(0, 1, At, B1); PG8_BAR; PG8_SCHED;
            PG8_LDA(At, 1, 1); PG8_STAGE(PG8_SB(1, 0), b3, voffB); PG8_STAGE(PG8_SB(1, 1), b3 + hstep, voffB); PG8_STAGE(PG8_SA(1, 0), a3, voffA);
            PG8_WAIT_V(8); PG8_WAIT_L(0); PG8_BAR; PG8_MMA(1, 0, At, B0); PG8_MMA(1, 1, At, B1); PG8_BAR; PG8_SCHED;
            } else {
            PG8_LDB(B0, 0, 0); PG8_SCHED; PG8_LDA(At, 0, 0); PG8_STAGE(PG8_SA(1, 1), a1 + hstep, voffA);
            PG8_WAIT_L(8); PG8_BAR; PG8_WAIT_L(0); PG8_MMA(0, 0, At, B0); PG8_BAR; PG8_SCHED;
            PG8_LDB(B1, 0, 1); PG8_STAGE(PG8_SB(0, 0), b2, voffB);
            PG8_BAR; PG8_WAIT_L(0); PG8_MMA(0, 1, At, B1); PG8_BAR;
            PG8_LDA(At, 0, 1); PG8_STAGE(PG8_SA(0, 0), a2, voffA);
            PG8_BAR; PG8_WAIT_L(0); PG8_MMA(1, 0, At, B0); PG8_BAR; PG8_SCHED;
            PG8_STAGE(PG8_SB(0, 1), b2 + hstep, voffB);
            PG8_WAIT_V(6); PG8_BAR; PG8_MMA(1, 1, At, B1); PG8_BAR;
            PG8_LDB(B0, 1, 0); PG8_SCHED; PG8_LDA(At, 1, 0); PG8_STAGE(PG8_SA(0, 1), a2 + hstep, voffA);
            PG8_WAIT_L(8); PG8_BAR; PG8_WAIT_L(0); PG8_MMA(0, 0, At, B0); PG8_BAR; PG8_SCHED;
            PG8_LDB(B1, 1, 1); PG8_STAGE(PG8_SB(1, 0), b3, voffB);
            PG8_BAR; PG8_WAIT_L(0); PG8_MMA(0, 1, At, B1); PG8_BAR;
            PG8_LDA(At, 1, 1); PG8_STAGE(PG8_SA(1, 0), a3, voffA);
            PG8_BAR; PG8_WAIT_L(0); PG8_MMA(1, 0, At, B0); PG8_BAR; PG8_SCHED;
            PG8_STAGE(PG8_SB(1, 1), b3 + hstep, voffB);
            PG8_WAIT_V(6); PG8_BAR; PG8_MMA(1, 1, At, B1); PG8_BAR;
            }
        }
        if constexpr (ALIGN_EPI) { if (wr == 0) PG8_BAR; }
        if constexpr (!Epi::AFTER_DRAIN) { E(acc, cur, wr, wc, fr, fq); S.done(cur); }
        if (!has_next) break;
#pragma unroll
        for (int a = 0; a < 2; ++a)
#pragma unroll
            for (int b = 0; b < 2; ++b)
#pragma unroll
                for (int m = 0; m < 4; ++m)
#pragma unroll
                    for (int n = 0; n < 2; ++n) acc[a][b][m][n] = (f32x4){0.f, 0.f, 0.f, 0.f};
        cur = nxt; cA = nA; cB = nB; ++ui;
        if constexpr (ALIGN_EPI) { if (wr == 1) PG8_BAR; }
    }
    PG8_WAIT_V(0);
    if constexpr (!ALIGN_EPI) { if (wr == 0) PG8_BAR; }
    PG8_BAR;
    if constexpr (Epi::AFTER_DRAIN) { E.fused(acc, cur, wr, wc, fr, fq, lds, wid, lane); S.done(cur); }
#undef PG8_SA
#undef PG8_SB
#undef PG8_STAGE
#undef PG8_LDA
#undef PG8_LDB
#undef PG8_MMA
#undef PG8_WAIT_V
#undef PG8_WAIT_L
#undef PG8_BAR
#undef PG8_SCHED
}
}
#define GAS __attribute__((address_space(1)))
#define LAS __attribute__((address_space(3)))
typedef unsigned short bf16;
typedef unsigned v4u __attribute__((ext_vector_type(4)));
typedef float f32x4 __attribute__((ext_vector_type(4)));
typedef short bf16x8 __attribute__((ext_vector_type(8)));
typedef GAS unsigned gu32;
typedef GAS unsigned long long gu64;
#define RLX_AGENT __ATOMIC_RELAXED, __HIP_MEMORY_SCOPE_AGENT
#define LDS_WAIT() asm volatile("s_waitcnt lgkmcnt(0)" ::: "memory")
#define VM_WAIT() asm volatile("s_waitcnt vmcnt(0)" ::: "memory")
__device__ __forceinline__ unsigned long long rt() { return __builtin_amdgcn_s_memrealtime(); }
__device__ __forceinline__ unsigned f2bf(float f) { unsigned u = __builtin_bit_cast(unsigned, f); return (u + 0x7fffu + ((u >> 16) & 1u)) >> 16; }
__device__ __forceinline__ unsigned pk2(float lo, float hi) { return f2bf(lo) | (f2bf(hi) << 16); }
#define XB_TMO      128
#define XB_XCNT(j)  (256  + 64 * (j))
#define XB_XSUB(j)  (1280 + 64 * (j))
#define XB_XGEN(j)  (2304 + 64 * (j))
#define XB_TOP      3328
#define XB_TOPGEN   3392
#define XCD_BAR_WORDS 3456
#define XB_SPIN_CAP (1u << 18)

__device__ __forceinline__ unsigned xb_ld(unsigned* p)              { return __hip_atomic_load(p, __ATOMIC_RELAXED, __HIP_MEMORY_SCOPE_AGENT); }
__device__ __forceinline__ unsigned xb_add(unsigned* p, unsigned v) { return __hip_atomic_fetch_add(p, v, __ATOMIC_RELAXED, __HIP_MEMORY_SCOPE_AGENT); }
__device__ __forceinline__ unsigned xb_xcc_id() { return (unsigned)__builtin_amdgcn_s_getreg((3 << 11) | 20) & 0xFu; }
#define XB_SPIN(cond, bar) do { unsigned _sp = 0; while (cond) { __builtin_amdgcn_s_sleep(1); \
    if ((++_sp & 255u) == 0u) { if (xb_ld(&(bar)[XB_TMO])) break; if (_sp > XB_SPIN_CAP) { atomicAdd(&(bar)[XB_TMO], 1u); break; } } } } while (0)

struct XcdBarrier {
    unsigned* bar; unsigned x;
    volatile LAS unsigned* st;
};

__device__ __forceinline__ XcdBarrier xcd_barrier_post(unsigned* bar, volatile LAS unsigned* st) {
    XcdBarrier b; b.bar = bar; b.x = xb_xcc_id(); b.st = st;
    if (threadIdx.x == 0) (void)xb_add(&bar[XB_XCNT(b.x)], 1u);
    return b;
}
__device__ __forceinline__ void xcd_barrier_complete(unsigned* bar, unsigned x, unsigned& nloc, unsigned& nx) {
    const unsigned G = gridDim.x * gridDim.y * gridDim.z;
    unsigned sum, cnt, mine, sp = 0u;
    for (;;) {
        sum = 0u; cnt = 0u; mine = 0u;
#pragma unroll
        for (unsigned j = 0; j < 16; ++j) { const unsigned c = xb_ld(&bar[XB_XCNT(j)]); sum += c; cnt += (c > 0u) ? 1u : 0u; mine = (j == x) ? c : mine; }
        if (sum == G) break;
        __builtin_amdgcn_s_sleep(1);
        if ((++sp & 255u) == 0u) { if (xb_ld(&bar[XB_TMO])) break; if (sp > XB_SPIN_CAP) { atomicAdd(&bar[XB_TMO], 1u); break; } }
    }
    nloc = mine > 0u ? mine : 1u; nx = cnt > 0u ? cnt : 1u;
}

__device__ __forceinline__ void xcd_barrier(const XcdBarrier& b) {
    asm volatile("s_waitcnt vmcnt(0)" ::: "memory");
    __syncthreads();
    if (threadIdx.x == 0) {
        unsigned* bar = b.bar;
        __builtin_amdgcn_s_waitcnt(0);
        unsigned nloc = b.st[0], nx = b.st[1];
        if (nloc == 0u) { xcd_barrier_complete(bar, b.x, nloc, nx); b.st[0] = nloc; b.st[1] = nx; }
        const unsigned old = xb_add(&bar[XB_XSUB(b.x)], 1u);
        const unsigned gen = old / nloc;
        if (old + 1u == (gen + 1u) * nloc) {
            __builtin_amdgcn_fence(__ATOMIC_RELEASE, "agent");
            asm volatile("s_waitcnt vmcnt(0)" ::: "memory");
            const unsigned og = xb_add(&bar[XB_TOP], 1u);
            const unsigned tg = og / nx;
            if (og + 1u == (tg + 1u) * nx) xb_add(&bar[XB_TOPGEN], 1u);
            else XB_SPIN(xb_ld(&bar[XB_TOPGEN]) == tg, bar);
            __builtin_amdgcn_fence(__ATOMIC_ACQUIRE, "agent");
            xb_add(&bar[XB_XGEN(b.x)], 1u);
            asm volatile("s_waitcnt vmcnt(0)" ::: "memory");
        } else {
            XB_SPIN(xb_ld(&bar[XB_XGEN(b.x)]) == gen, bar);
            __builtin_amdgcn_fence(__ATOMIC_ACQUIRE, "agent");
            asm volatile("s_waitcnt vmcnt(0)" ::: "memory");
        }
    }
    __syncthreads();
}

namespace att {
struct ProbeT { unsigned long long acc, last; int state; };
#ifdef PROBE_SUB
#define ATT_MARK(k) do { const unsigned long long now_ = __builtin_amdgcn_s_memrealtime(); if (PT.state == PROBE_SUB) PT.acc += now_ - PT.last; PT.last = now_; PT.state = (k); } while (0)
#define ATT_PROBE_PARAM , ProbeT& PT
#else
#define ATT_MARK(k) do { } while (0)
#define ATT_PROBE_PARAM
#endif
typedef unsigned short bf16_t;
using bf16x8 = __attribute__((ext_vector_type(8))) short;
using s16x4  = __attribute__((ext_vector_type(4))) short;
using f32x16 = __attribute__((ext_vector_type(16))) float;
using u32x4  = __attribute__((ext_vector_type(4))) unsigned;
constexpr int NW = 8, QBLK = 32, KVBLK = 64;
constexpr int VBUF = KVBLK * 128 * 2;
#define ATT_SBAR() __builtin_amdgcn_sched_barrier(0)
__device__ __forceinline__ int crow(int r, int hi) { return (r & 3) + 8 * (r >> 2) + 4 * hi; }
__device__ __forceinline__ unsigned cvtpk(float lo, float hi) { unsigned r; asm volatile("v_cvt_pk_bf16_f32 %0, %1, %2" : "=v"(r) : "v"(lo), "v"(hi)); return r; }
template <int DQ> __device__ __forceinline__ int kswz(int row, int colB) { return row * (DQ * 2) + (colB ^ ((row & 7) << 4)); }

__device__ __forceinline__ void partialSM(f32x16& p0, f32x16& p1, float& m_reg, float& mn, float& alpha, const float C, const float thr, const float rs, const bool fixedB) {
  if (fixedB) { mn = m_reg; alpha = 1.f; } else {
  float pmax = p0[0];
#pragma unroll
  for (int r = 1; r < 16; ++r) pmax = fmaxf(pmax, p0[r]);
#pragma unroll
  for (int r = 0; r < 16; ++r) pmax = fmaxf(pmax, p1[r]);
  { auto rr = __builtin_amdgcn_permlane32_swap(__float_as_uint(pmax), __float_as_uint(pmax), false, false);
    pmax = fmaxf(__uint_as_float(rr[0]), __uint_as_float(rr[1])) * rs; }
  if (__builtin_expect(__all(pmax - m_reg <= thr), 1)) { mn = m_reg; alpha = 1.f; }
  else { mn = fmaxf(m_reg, pmax); alpha = __builtin_amdgcn_exp2f((m_reg - mn) * C); m_reg = mn; }
  }
  const float mnC = -mn * C, Cl = C * rs;
#pragma unroll
  for (int r = 0; r < 16; ++r) p0[r] = fmaf(p0[r], Cl, mnC);
#pragma unroll
  for (int r = 0; r < 16; ++r) p1[r] = fmaf(p1[r], Cl, mnC);
#pragma unroll
  for (int r = 0; r < 16; ++r) p0[r] = __builtin_amdgcn_exp2f(p0[r]);
}
__device__ __forceinline__ void finishSM(f32x16& p0, f32x16& p1, float alpha, float& l_reg, bf16x8& pa0, bf16x8& pa1, bf16x8& pa2, bf16x8& pa3) {
#pragma unroll
  for (int r = 0; r < 16; ++r) p1[r] = __builtin_amdgcn_exp2f(p1[r]);
  float ps = 0;
#pragma unroll
  for (int r = 0; r < 16; ++r) ps += p0[r];
#pragma unroll
  for (int r = 0; r < 16; ++r) ps += p1[r];
  { auto rr = __builtin_amdgcn_permlane32_swap(__float_as_uint(ps), __float_as_uint(ps), false, false);
    ps = __uint_as_float(rr[0]) + __uint_as_float(rr[1]); }
  l_reg = l_reg * alpha + ps;
#define ATT_PK4(P, BASE, OUT) do { unsigned a0 = cvtpk(P[BASE + 0], P[BASE + 1]), a1 = cvtpk(P[BASE + 2], P[BASE + 3]);   \
    unsigned b0 = cvtpk(P[BASE + 4], P[BASE + 5]), b1 = cvtpk(P[BASE + 6], P[BASE + 7]);                              \
    auto r0 = __builtin_amdgcn_permlane32_swap(a0, b0, false, false); auto r1 = __builtin_amdgcn_permlane32_swap(a1, b1, false, false); \
    u32x4 w = {r0[0], r1[0], r0[1], r1[1]}; OUT = *reinterpret_cast<bf16x8*>(&w); } while (0)
  ATT_PK4(p0, 0, pa0); ATT_PK4(p0, 8, pa1); ATT_PK4(p1, 0, pa2); ATT_PK4(p1, 8, pa3);
#undef ATT_PK4
}
template <int OFF> __device__ __forceinline__ bf16x8 lds_rd128(unsigned addr) { bf16x8 r; asm volatile("ds_read_b128 %0, %1 offset:%2" : "=&v"(r) : "v"(addr), "i"(OFF) : "memory"); return r; }
template <int N> __device__ __forceinline__ void lgkm_wait() { static_assert(N == 0 || N == 2 || N == 4 || N == 6, "count"); if constexpr (N == 0) asm volatile("s_waitcnt lgkmcnt(0)" ::: "memory"); else if constexpr (N == 2) asm volatile("s_waitcnt lgkmcnt(2)" ::: "memory"); else if constexpr (N == 4) asm volatile("s_waitcnt lgkmcnt(4)" ::: "memory"); else asm volatile("s_waitcnt lgkmcnt(6)" ::: "memory"); }
template <int GS, int G, int S = 0> struct QktLoad {
  static __device__ __forceinline__ void run(unsigned kb, bf16x8 (&f0)[2][GS], bf16x8 (&f1)[2][GS]) {
    f0[G & 1][S] = lds_rd128<(G * GS + S) * 2048>(kb); f1[G & 1][S] = lds_rd128<(G * GS + S) * 2048 + 512>(kb);
    if constexpr (S + 1 < GS) QktLoad<GS, G, S + 1>::run(kb, f0, f1);
  }
};
template <int DQ, int GS, int G = 0> struct QktStep {
  static __device__ __forceinline__ void run(f32x16& p0, f32x16& p1, unsigned kb, const bf16x8* qr, bf16x8 (&f0)[2][GS], bf16x8 (&f1)[2][GS]) {
    constexpr int NG = DQ / 16 / GS;
    if constexpr (G + 1 < NG) { QktLoad<GS, G + 1>::run(kb, f0, f1); lgkm_wait<2 * GS>(); } else lgkm_wait<0>();
    ATT_SBAR();
#pragma unroll
    for (int s_ = 0; s_ < GS; ++s_) { p0 = __builtin_amdgcn_mfma_f32_32x32x16_bf16(f0[G & 1][s_], qr[G * GS + s_], p0, 0, 0, 0); p1 = __builtin_amdgcn_mfma_f32_32x32x16_bf16(f1[G & 1][s_], qr[G * GS + s_], p1, 0, 0, 0); }
    ATT_SBAR();
    if constexpr (G + 1 < NG) QktStep<DQ, GS, G + 1>::run(p0, p1, kb, qr, f0, f1);
  }
};
template <int DQ, int GS> __device__ __forceinline__ void qkt(f32x16& p0, f32x16& p1, const char* Ks, const bf16x8* qr, int r32, int hi) {
  static_assert((DQ / 16) % GS == 0 && GS >= 1 && GS <= 3, "group size");
  p0 = f32x16{}; p1 = f32x16{};
  const unsigned kb = (unsigned)(uintptr_t)Ks + (unsigned)(hi * 1024 + r32 * 16);
  bf16x8 f0[2][GS], f1[2][GS];
  QktLoad<GS, 0>::run(kb, f0, f1);
  QktStep<DQ, GS, 0>::run(p0, p1, kb, qr, f0, f1);
}
__device__ __forceinline__ int v_st(int k, int c) { const int kk = (k & ~0xC) | ((k & 4) << 1) | ((k & 8) >> 1); return ((kk >> 3) * 4 + (c >> 5)) * 512 + ((kk & 7) * 32 + (c & 31)) * 2; }
__device__ __forceinline__ int v_rd_base(int lane) { return ((lane & 3) << 3) | (((lane >> 2) & 3) << 6) | (((lane >> 4) & 1) << 5) | (((lane >> 5) & 1) << 8); }
constexpr int v_rd_off(int d0, int ks, int half) { return d0 * 512 + ks * 4096 + half * 2048; }
template <int OFF> __device__ __forceinline__ s16x4 tr_read(int vb) {
  s16x4 r; asm volatile("ds_read_b64_tr_b16 %0, %1 offset:%2" : "=&v"(r) : "v"(vb), "i"(OFF) : "memory"); return r;
}
template <int HB> __device__ __forceinline__ void pv_rd(s16x4 (&s)[4], int vb) {
  constexpr int D0 = HB >> 1, K0 = 2 * (HB & 1);
  s[0] = tr_read<v_rd_off(D0, K0, 0)>(vb); s[1] = tr_read<v_rd_off(D0, K0, 1)>(vb); s[2] = tr_read<v_rd_off(D0, K0 + 1, 0)>(vb); s[3] = tr_read<v_rd_off(D0, K0 + 1, 1)>(vb);
}
__device__ __forceinline__ void pv_mm(f32x16& od, const s16x4 (&s)[4], bf16x8 pa, bf16x8 pb) {
#define ATT_PK(L, H) (bf16x8){L[0], L[1], L[2], L[3], H[0], H[1], H[2], H[3]}
  od = __builtin_amdgcn_mfma_f32_32x32x16_bf16(pa, ATT_PK(s[0], s[1]), od, 0, 0, 0);
  od = __builtin_amdgcn_mfma_f32_32x32x16_bf16(pb, ATT_PK(s[2], s[3]), od, 0, 0, 0);
#undef ATT_PK
}
template <int H> __device__ __forceinline__ void pv_half(f32x16* o, int vb, bf16x8 pa0, bf16x8 pa1, bf16x8 pa2, bf16x8 pa3) {
  s16x4 s0[4], s1[4], s2[4];
#define ATT_W8() asm volatile("s_waitcnt lgkmcnt(8)" ::: "memory")
#define ATT_W4() asm volatile("s_waitcnt lgkmcnt(4)" ::: "memory")
#define ATT_W0() asm volatile("s_waitcnt lgkmcnt(0)" ::: "memory")
  pv_rd<4 * H + 0>(s0, vb); pv_rd<4 * H + 1>(s1, vb);
  pv_rd<4 * H + 2>(s2, vb); ATT_W8(); ATT_SBAR(); pv_mm(o[2 * H], s0, pa0, pa1); ATT_SBAR();
  pv_rd<4 * H + 3>(s0, vb); ATT_W8(); ATT_SBAR(); pv_mm(o[2 * H], s1, pa2, pa3); ATT_SBAR();
  ATT_W4(); ATT_SBAR(); pv_mm(o[2 * H + 1], s2, pa0, pa1); ATT_SBAR();
  ATT_W0(); ATT_SBAR(); pv_mm(o[2 * H + 1], s0, pa2, pa3); ATT_SBAR();
#undef ATT_W8
#undef ATT_W4
#undef ATT_W0
}

struct AUnit {
  const bf16_t* q; bf16_t* o; const bf16_t *k0, *v0, *k1, *v1;
  int ldq, ldo, ldk0, ldv0, ldk1, ldv1, n0, ntiles; float scale;
  int r0, kr_lo; const float* rpb;
  float mfix;
  const float* qsq;
};
constexpr int TBL_FLOATS = 15 * 128;
constexpr int NBUF = 3;
template <int DQ> constexpr int attn_lds_bytes() { return NBUF * VBUF + NBUF * KVBLK * DQ * 2 + NW * 64 * 4 + TBL_FLOATS * 4; }

template <int DQ, bool NAT>
__device__ __forceinline__ void attn_unit(const AUnit& U, char* lds, const int wid_in ATT_PROBE_PARAM) {
  constexpr int KB = KVBLK * DQ * 2, NKC = DQ / 64, CPR = DQ / 8;
  ATT_MARK(0);
  const int tid = wid_in * 64 + lane_id_fresh(), wid = wid_in, lane = tid & 63, r32 = lane & 31, hi = lane >> 5;
  char* V_lds = lds; char* K_lds = lds + NBUF * VBUF;
  float* ws = (float*)(lds + NBUF * VBUF + NBUF * KB) + wid * 64; float* li_l = ws; float* al_l = ws + 32;
  float* tbl = (float*)(lds + NBUF * VBUF + NBUF * KB + NW * 64 * 4);
  const float C = U.scale * 1.4426950408889634f, thr = 8.f / U.scale;
  const bool fixedB = U.mfix > 0.f;
  float m_reg = fixedB ? U.mfix : -1e30f, l_reg = 0.f; f32x16 o[4] = {}; bf16x8 qr[DQ / 16];
  const bf16_t* Qw = U.q + (long)(wid * QBLK + r32) * U.ldq + hi * 8;
#pragma unroll
  for (int d0 = 0; d0 < DQ / 16; ++d0) qr[d0] = *reinterpret_cast<const bf16x8*>(Qw + d0 * 16);
  float qrs = 1.f;
  if (U.qsq) { typedef float f32x2v __attribute__((ext_vector_type(2))); const float* sp = U.qsq + (long)(wid * QBLK + r32) * 96;
    const f32x2v a = *(const f32x2v*)sp, b = *(const f32x2v*)(sp + 2), c = *(const f32x2v*)(sp + 4); qrs = __builtin_amdgcn_rsqf(((a[0] + a[1]) + (b[0] + b[1]) + (c[0] + c[1])) * (1.0f / 192.0f) + 1e-6f); }
  const int sr = tid >> 4, sc = (tid & 15) * 8, vst0 = v_st(sr, sc), vst1 = v_st(32 + sr, sc);
  const int vb0 = (int)(uintptr_t)V_lds + v_rd_base(lane);
  bf16x8 st[NKC], sv[2];
#define ATT_TILE(j) const int j_ = (j); const bool f_ = j_ < U.n0; const int jj_ = f_ ? j_ : j_ - U.n0; const int ldk_ = f_ ? U.ldk0 : U.ldk1, ldv_ = f_ ? U.ldv0 : U.ldv1; \
    const bf16_t* kp_ = (f_ ? U.k0 : U.k1) + (long)jj_ * KVBLK * ldk_; const bf16_t* vp_ = (f_ ? U.v0 : U.v1) + (long)jj_ * KVBLK * ldv_; (void)kp_; (void)vp_; (void)ldk_; (void)ldv_
#define ATT_KLOAD_TO(dst, j) do { ATT_TILE(j); _Pragma("unroll") for (int i_ = 0; i_ < NKC; ++i_) { const int blk_ = wid + 8 * i_, kr_ = (blk_ & 7) * 8 + (lane & 7), kc_ = (blk_ >> 3) * 8 + (lane >> 3); dst[i_] = *reinterpret_cast<const bf16x8*>(kp_ + (long)kr_ * ldk_ + kc_ * 8); } } while (0)
#define ATT_KLOAD(j) ATT_KLOAD_TO(st, j)
#define ATT_KWRITE_FROM(src, b) do { _Pragma("unroll") for (int i_ = 0; i_ < NKC; ++i_) { const int blk_ = wid + 8 * i_, c_ = ((blk_ >> 3) * 8 + (lane >> 3)) * 64 + (blk_ & 7) * 8 + (lane & 7); *(bf16x8*)(K_lds + (b) * KB + c_ * 16) = src[i_]; } } while (0)
#define ATT_KWRITE(b) ATT_KWRITE_FROM(st, b)
#define ATT_VLOAD_TO(dst, j) do { ATT_TILE(j); dst[0] = *reinterpret_cast<const bf16x8*>(vp_ + (long)sr * ldv_ + sc); dst[1] = *reinterpret_cast<const bf16x8*>(vp_ + (long)(32 + sr) * ldv_ + sc); } while (0)
#define ATT_VLOAD(j) ATT_VLOAD_TO(sv, j)
#define ATT_VWRITE_FROM(src, b) do { *(bf16x8*)(V_lds + (b) * VBUF + vst0) = src[0]; *(bf16x8*)(V_lds + (b) * VBUF + vst1) = src[1]; } while (0)
#define ATT_VWRITE(b) ATT_VWRITE_FROM(sv, b)
#define ATT_BAR() do { asm volatile("s_waitcnt lgkmcnt(0)" ::: "memory"); __builtin_amdgcn_s_barrier(); asm volatile("" ::: "memory"); } while (0)
  const int NT = U.ntiles;
  const int R = U.r0 + (wid >> 1), rs = min(max(R - 4, 0), 24), qc = (wid & 1) * 32 + r32, cs = min(max(qc - 8, 0), 48);
  { bf16x8 k0_[NKC], k1_[NKC], v0_[2], v1_[2];
    ATT_KLOAD_TO(k0_, 0); ATT_VLOAD_TO(v0_, 0); ATT_KLOAD_TO(k1_, 1); ATT_VLOAD_TO(v1_, 1);
    if constexpr (NAT) {
      const float inv = 1.0f / U.scale;
      float tv_[4];
#pragma unroll
      for (int q_ = 0; q_ < 4; ++q_) { const int idx = tid + 512 * q_, ro = idx >> 7, d = (idx & 127) - 48; tv_[q_] = (idx < TBL_FLOATS && d >= 0 && d <= 30) ? U.rpb[ro * 31 + d] * inv : 0.f; }
#pragma unroll
      for (int q_ = 0; q_ < 4; ++q_) { const int idx = tid + 512 * q_; if (idx < TBL_FLOATS) tbl[idx] = tv_[q_]; }
    }
    ATT_KWRITE_FROM(k0_, 0); ATT_VWRITE_FROM(v0_, 0); ATT_KWRITE_FROM(k1_, 1); ATT_VWRITE_FROM(v1_, 1); }
  if (2 < NT) { ATT_KLOAD(2); ATT_VLOAD(2); }
  ATT_BAR();
  if (wid >= 4) { ATT_BAR(); __builtin_amdgcn_s_setprio(1); }
  ATT_MARK(1);
  int b = 0, bn = 1, bp = 2;
  bool act_prev = false; bf16x8 pa0, pa1, pa2, pa3; f32x16 p0, p1;
  for (int j = 0; j <= NT; ++j) {
    bool act = j < NT; int kr = 0;
    if constexpr (NAT) { if (j >= U.n0 && j < NT) { kr = U.kr_lo + (j - U.n0); act = (kr >= rs) && (kr <= rs + 7); } }
    if (j >= 1 && j + 1 < NT) { ATT_KWRITE(bn); if (j + 2 < NT) ATT_KLOAD(j + 2); }
    if (act) {
      qkt<DQ, 2>(p0, p1, K_lds + b * KB, qr, r32, hi);
      if constexpr (NAT) { if (j >= U.n0) {
        const int ro = kr - R + 7; const float* tb = tbl + ro * 128 + 63 - qc + 4 * hi; const int t0 = 4 * hi - cs; const float NEG = -INFINITY;
#pragma unroll
        for (int r = 0; r < 16; ++r) { const int kc = (r & 3) + 8 * (r >> 2);
          p0[r] = ((unsigned)(t0 + kc) < 16u) ? p0[r] + tb[kc] : NEG;
          p1[r] = ((unsigned)(t0 + kc + 32) < 16u) ? p1[r] + tb[kc + 32] : NEG; } } }
    }
    if (act_prev) pv_half<1>(o, vb0 + bp * VBUF, pa0, pa1, pa2, pa3);
    if (j == NT) break;
    ATT_MARK(2); ATT_BAR(); ATT_MARK(3);
    if (j >= 1 && j + 1 < NT) { ATT_VWRITE(bn); if (j + 2 < NT) ATT_VLOAD(j + 2); }
    if (act) {
      float mn, alpha;
      partialSM(p0, p1, m_reg, mn, alpha, C, thr, qrs, fixedB);
      if (__any(alpha < 1.f)) { if (hi == 0) al_l[r32] = alpha; asm volatile("s_waitcnt lgkmcnt(0)" ::: "memory");
#pragma unroll
        for (int d = 0; d < 4; ++d)
#pragma unroll
          for (int r = 0; r < 16; ++r) o[d][r] *= al_l[crow(r, hi)]; }
      finishSM(p0, p1, alpha, l_reg, pa0, pa1, pa2, pa3); ATT_SBAR();
      pv_half<0>(o, vb0 + b * VBUF, pa0, pa1, pa2, pa3);
    }
    ATT_MARK(4); ATT_BAR(); ATT_MARK(1);
    act_prev = act; bp = b; b = bn; bn = (bn == NBUF - 1) ? 0 : bn + 1;
  }
  ATT_MARK(5);
  ATT_BAR();
  if (wid < 4) ATT_BAR();
  __builtin_amdgcn_s_setprio(0);
  if (hi == 0) li_l[r32] = l_reg; asm volatile("s_waitcnt lgkmcnt(0)" ::: "memory");
  float rli[16];
#pragma unroll
  for (int r = 0; r < 16; ++r) rli[r] = __builtin_amdgcn_rcpf(li_l[crow(r, hi)]);
  bf16_t* Ow = U.o + (long)(wid * QBLK) * U.ldo;
#pragma unroll
  for (int r = 0; r < 16; ++r) { const int orow = crow(r, hi);
#pragma unroll
    for (int d0 = 0; d0 < 4; ++d0) { const float v = o[d0][r] * rli[r]; unsigned u = __float_as_uint(v); u = (u + 0x7fffu + ((u >> 16) & 1u)) >> 16; Ow[(long)orow * U.ldo + d0 * 32 + r32] = (bf16_t)u; } }
  ATT_MARK(6);
#undef ATT_TILE
#undef ATT_KLOAD
#undef ATT_KWRITE
#undef ATT_VLOAD
#undef ATT_VWRITE
#undef ATT_KLOAD_TO
#undef ATT_KWRITE_FROM
#undef ATT_VLOAD_TO
#undef ATT_VWRITE_FROM
#undef ATT_BAR
}
}

constexpr int D = 2048, NTOK = 16384, NCTX = 8192, DEPTH = 4;
constexpr int IN_AB = 6144, DFF = 5632, NDOWN = 832, NDOWN_P = 1024, QL = 512, KVL = 256, ROPE_D = 64;
constexpr int NKVROWS = NTOK + 1024;
constexpr float EPS = 1e-6f;
constexpr int NWAVES = 8;
constexpr size_t O_X = 0, O_NATK = (size_t)NTOK * D, O_NATV = O_NATK + 16777216, O_CKV = O_NATV + 16777216, O_KR = O_CKV + 4194304, O_END = O_KR + 1048576;
constexpr size_t MiB = 1u << 20;
constexpr size_t WS_CTL = 0, CTL_ZERO_BYTES = 1 * MiB;
constexpr size_t WS_MOD = 1 * MiB;
constexpr size_t WS_W = 2 * MiB;
constexpr size_t SZ_FFN_IN = (size_t)2 * DFF * D * 2, SZ_FFN_OUT = (size_t)D * DFF * 2, SZ_IN_AB = (size_t)IN_AB * D * 2, SZ_DD = (size_t)D * D * 2;
constexpr size_t SZ_DOWN = (size_t)NDOWN_P * D * 2, SZ_UQ = (size_t)3072 * QL * 2, SZ_UKV = (size_t)4096 * KVL * 2;
constexpr size_t W_FFN_IN = WS_W, W_FFN_OUT = W_FFN_IN + 4 * SZ_FFN_IN, W_IN_AB = W_FFN_OUT + 4 * SZ_FFN_OUT, W_OUT_AB = W_IN_AB + 2 * SZ_IN_AB;
constexpr size_t W_DOWN = W_OUT_AB + 2 * SZ_DD, W_UQ = W_DOWN + 2 * SZ_DOWN, W_UKV = W_UQ + 2 * SZ_UQ, W_O = W_UKV + 2 * SZ_UKV, W_END = W_O + 2 * SZ_DD;
constexpr size_t WS_H = 384 * MiB;
constexpr size_t WS_C = WS_H + 64 * MiB;
constexpr size_t WS_SM = WS_C + 64 * MiB;
constexpr size_t SZ_CKVN = 9 * MiB, SZ_KR = 5 * MiB, SZ_KRSQ = 128 * 1024;
constexpr size_t SM_CQN = WS_SM, SM_CKVN = SM_CQN + (size_t)NTOK * QL * 2, SM_KR = SM_CKVN + 2 * SZ_CKVN, SM_CK = SM_KR + 2 * SZ_KR, SM_CV = SM_CK + 4 * MiB, SM_KRSQ = SM_CV + 4 * MiB, SM_CQP = SM_KRSQ + 1 * MiB, SM_QSQ = SM_CQP + 1 * MiB, SM_END = SM_QSQ + 7 * MiB;
static_assert((size_t)NKVROWS * KVL * 2 <= SZ_CKVN && (size_t)NKVROWS * 64 * 4 <= SZ_KR && (size_t)NKVROWS * 4 <= SZ_KRSQ && (size_t)NTOK * 8 * 4 <= 1 * MiB, "latent buffers");
constexpr size_t WS_BIG = WS_SM + 64 * MiB;
constexpr size_t B_P = WS_BIG;
constexpr size_t B_L = WS_BIG, B_QC = B_L + 64 * MiB, B_KV = B_QC + 96 * MiB, B_KN = B_KV + 136 * MiB;
constexpr size_t WS_CS = WS_MOD + 983040;
constexpr size_t B_F = WS_BIG;
constexpr size_t WS_X16 = WS_BIG + 512 * MiB;
constexpr size_t WS_END = WS_X16 + 64 * MiB;
static_assert(W_END <= WS_H && SM_END <= WS_BIG && B_KN + (size_t)NKVROWS * 3072 * 2 <= WS_X16 && B_F + (size_t)NTOK * DFF * 2 <= WS_END, "d_ws map");
constexpr int CW_BAR = 4096;
constexpr int RING_BYTES = 131072, LDSCTL_OFF = RING_BYTES, LDS_BYTES = 147456;

typedef unsigned short bf16;
typedef float f32x2 __attribute__((ext_vector_type(2)));
typedef unsigned u32x2 __attribute__((ext_vector_type(2)));
typedef _Float16 h16x4 __attribute__((ext_vector_type(4)));

__device__ __forceinline__ float wave_sum(float v) {
    v += __int_as_float(__builtin_amdgcn_ds_swizzle(__float_as_int(v), 0x041F));
    v += __int_as_float(__builtin_amdgcn_ds_swizzle(__float_as_int(v), 0x081F));
    v += __int_as_float(__builtin_amdgcn_ds_swizzle(__float_as_int(v), 0x101F));
    v += __int_as_float(__builtin_amdgcn_ds_swizzle(__float_as_int(v), 0x201F));
    v += __int_as_float(__builtin_amdgcn_ds_swizzle(__float_as_int(v), 0x401F));
    const auto b = __builtin_amdgcn_permlane32_swap(__float_as_uint(v), __float_as_uint(v), false, false);
    return __uint_as_float(b[0]) + __uint_as_float(b[1]);
}
__device__ __forceinline__ float bf2f(unsigned short b) { return __uint_as_float(((unsigned)b) << 16); }
__device__ __forceinline__ float bflo(unsigned w) { return __uint_as_float(w << 16); }
__device__ __forceinline__ float bfhi(unsigned w) { return __uint_as_float(w & 0xffff0000u); }

struct Frame {
    LAS unsigned char* lds; char* ldsg;
    int tid, lane, wave, G, vcu, gw, NGW;
#ifdef PROBE_PRO
    unsigned long long pacc;
#endif
    GAS float* out; GAS unsigned char* ws; int l;
};
__device__ __forceinline__ const float* kin(int k) { asm volatile("" : "+s"(k)); return (const float*)((GAS const float* const __attribute__((address_space(4)))*)__builtin_amdgcn_kernarg_segment_ptr())[k]; }

__device__ __forceinline__ bool fresh(Frame& F) {
    F.lane = lane_id_fresh(); F.tid = F.wave * 64 + F.lane;
    { GAS unsigned char* w = F.ws; GAS float* o = F.out; int l = F.l; asm volatile("" : "+s"(w), "+s"(o), "+s"(l)); F.ws = w; F.out = o; F.l = l; }
    return true;
}
__device__ __forceinline__ void p0_transpose_item(const float* W, int K, int N, bf16* WT, int k0, int n0, int drow0, LAS float* scr, int lane, const float* ksc) {
    { const int r = lane >> 3, n4 = (lane & 7) * 4; f32x4 w[8];
#pragma unroll
      for (int i = 0; i < 8; ++i) w[i] = *(const f32x4*)(W + (size_t)(k0 + r + 8 * i) * N + n0 + n4);
#pragma unroll
      for (int i = 0; i < 8; ++i) { LAS float* d = scr + (r + 8 * i) * 33 + n4; d[0] = w[i][0]; d[1] = w[i][1]; d[2] = w[i][2]; d[3] = w[i][3]; } }
    LDS_WAIT(); asm volatile("" ::: "memory");
    const int c = lane & 7;
    f32x4 sa = {1.f, 1.f, 1.f, 1.f}, sb = {1.f, 1.f, 1.f, 1.f};
    if (ksc) { sa = *(const f32x4*)(ksc + k0 + 8 * c); sb = *(const f32x4*)(ksc + k0 + 8 * c + 4); }
#pragma unroll
    for (int j = 0; j < 4; ++j) { const int n = (lane >> 3) + 8 * j; const LAS float* s = scr + (8 * c) * 33 + n;
        v4u o; o.x = pk2(s[0 * 33] * sa[0], s[1 * 33] * sa[1]); o.y = pk2(s[2 * 33] * sa[2], s[3 * 33] * sa[3]); o.z = pk2(s[4 * 33] * sb[0], s[5 * 33] * sb[1]); o.w = pk2(s[6 * 33] * sb[2], s[7 * 33] * sb[3]);
        *(GAS v4u*)(WT + (size_t)(drow0 + n) * K + k0 + 8 * c) = o; }
    LDS_WAIT(); asm volatile("" ::: "memory");
}
__device__ __forceinline__ void p0_do_matrix(const float* W, int K, int N, bf16* WT, int item, int ffn_map, LAS float* scr, int lane, const float* ksc = nullptr) {
    const int nblk = N / 32, kb = item / nblk, nb = item % nblk, k0 = 64 * kb, n0 = 32 * nb;
    int drow0 = n0;
    if (ffn_map == 1) { const int up = n0 >= DFF ? 1 : 0, j = n0 - up * DFF; drow0 = (j >> 7) * 256 + up * 128 + (j & 127); }
    if (ffn_map == 2) { drow0 = (n0 / 192) * 256 + (n0 % 192); }
    p0_transpose_item(W, K, N, WT, k0, n0, drow0, scr, lane, ksc);
}
__device__ __forceinline__ void phase_prologue(Frame& F) {
#ifdef PROBE_PRO
    unsigned long long pt0_ = rt(); F.pacc = 0;
#define PSTAMP(k) do { const unsigned long long n_ = rt(); if (PROBE_PRO == (k)) F.pacc += n_ - pt0_; pt0_ = n_; } while (0)
#else
#define PSTAMP(k) do { } while (0)
#endif
    {
        LAS float* scr = (LAS float*)(F.lds + F.wave * 16384);
        constexpr int I_FI = 32 * 352, I_FO = 88 * 64, I_IA = 32 * 192, I_DD = 32 * 64, I_DN = 32 * 26, I_UQ = 8 * 96, I_UK = 4 * 128;
        constexpr int NITEMS = 4 * I_FI + 4 * I_FO + 2 * I_IA + 2 * I_DD + 2 * I_DN + 2 * I_UQ + 2 * I_UK + 2 * I_DD;
        unsigned char* ws = (unsigned char*)F.ws;
        for (int pass = 0; pass < 2; ++pass) {
            if ((pass == 0) != ((F.vcu & 1) != 0)) {
            {
                LAS float* sil = (LAS float*)F.lds;
                LAS float* red = sil + 5 * 2048;
                const float* c = kin(6); const float* cctx = kin(7);
                for (int i = F.tid; i < 5 * 2048; i += 512) { const int cc = i >> 11, k = i & 2047; const float x = cc == 0 ? cctx[k] : c[(cc - 1) * 2048 + k]; sil[i] = x / (1.0f + __expf(-x)); }
                __syncthreads();
                const float* w_ada = kin(10); const float* b_ada = kin(11); float* mod = (float*)(F.ws + WS_MOD);
                for (int task = F.vcu; task < 4 * 192; task += F.G) {
                    const int l = task / 192, n = (task % 192) * 64 + F.lane;
                    const float* wp = w_ada + ((size_t)l * 2048 + F.wave * 256) * 12288 + n;
                    float a0 = 0.f, a1 = 0.f, a2 = 0.f, a3 = 0.f, a4 = 0.f;
                    for (int k = 0; k < 256; k += 16) {
                        float w[16];
#pragma unroll
                        for (int u = 0; u < 16; ++u) w[u] = wp[(size_t)(k + u) * 12288];
#pragma unroll
                        for (int u = 0; u < 16; ++u) { const int kk = F.wave * 256 + k + u; a0 += sil[kk] * w[u]; a1 += sil[2048 + kk] * w[u]; a2 += sil[4096 + kk] * w[u]; a3 += sil[6144 + kk] * w[u]; a4 += sil[8192 + kk] * w[u]; }
                    }
                    red[(F.wave * 5 + 0) * 64 + F.lane] = a0; red[(F.wave * 5 + 1) * 64 + F.lane] = a1; red[(F.wave * 5 + 2) * 64 + F.lane] = a2; red[(F.wave * 5 + 3) * 64 + F.lane] = a3; red[(F.wave * 5 + 4) * 64 + F.lane] = a4;
                    __syncthreads();
                    if (F.tid < 320) { const int cc = F.tid >> 6, ln = F.tid & 63; float s = 0.f;
#pragma unroll
                        for (int w8 = 0; w8 < 8; ++w8) s += red[(w8 * 5 + cc) * 64 + ln];
                        const int nn = (task % 192) * 64 + ln; mod[((size_t)l * 5 + cc) * 12288 + nn] = s + b_ada[(size_t)l * 12288 + nn]; }
                    __syncthreads();
                }
            }
            } else {
        for (int it = F.gw; it < NITEMS; it += F.NGW) {
                    int r = it;
                    if (r < 4 * I_FI) { const int l = r / I_FI; p0_do_matrix(kin(26) + (size_t)l * D * 2 * DFF, D, 2 * DFF, (bf16*)(ws + W_FFN_IN + l * SZ_FFN_IN), r % I_FI, 1, scr, F.lane); continue; } r -= 4 * I_FI;
                    if (r < 4 * I_FO) { const int l = r / I_FO; p0_do_matrix(kin(27) + (size_t)l * DFF * D, DFF, D, (bf16*)(ws + W_FFN_OUT + l * SZ_FFN_OUT), r % I_FO, 0, scr, F.lane); continue; } r -= 4 * I_FO;
                    if (r < 2 * I_IA) { const int l = r / I_IA; p0_do_matrix(kin(12) + (size_t)l * D * IN_AB, D, IN_AB, (bf16*)(ws + W_IN_AB + l * SZ_IN_AB), r % I_IA, 0, scr, F.lane); continue; } r -= 2 * I_IA;
                    if (r < 2 * I_DD) { const int l = r / I_DD; p0_do_matrix(kin(17) + (size_t)l * D * D, D, D, (bf16*)(ws + W_OUT_AB + l * SZ_DD), r % I_DD, 0, scr, F.lane); continue; } r -= 2 * I_DD;
                    if (r < 2 * I_DN) { const int l = r / I_DN; p0_do_matrix(kin(18) + (size_t)l * D * NDOWN, D, NDOWN, (bf16*)(ws + W_DOWN + l * SZ_DOWN), r % I_DN, 0, scr, F.lane); continue; } r -= 2 * I_DN;
                    if (r < 2 * I_UQ) { const int l = r / I_UQ; p0_do_matrix(kin(21) + (size_t)l * QL * 3072, QL, 3072, (bf16*)(ws + W_UQ + l * SZ_UQ), r % I_UQ, 0, scr, F.lane, kin(19) + l * QL); continue; } r -= 2 * I_UQ;
                    if (r < 2 * I_UK) { const int l = r / I_UK; p0_do_matrix(kin(22) + (size_t)l * KVL * 4096, KVL, 4096, (bf16*)(ws + W_UKV + l * SZ_UKV), r % I_UK, 0, scr, F.lane); continue; } r -= 2 * I_UK;
                    { const int l = r / I_DD; p0_do_matrix(kin(25) + (size_t)l * D * D, D, D, (bf16*)(ws + W_O + l * SZ_DD), r % I_DD, 0, scr, F.lane); }
                }
            }
            __syncthreads();
        }
        PSTAMP(1);
        PSTAMP(2);
        const int gt = F.vcu * 512 + F.tid, NT = F.G * 512;
        for (int i = gt; i < 2 * (NDOWN_P - NDOWN) * D / 8; i += NT) { const int l = i / ((NDOWN_P - NDOWN) * D / 8), e = i % ((NDOWN_P - NDOWN) * D / 8);
            *(v4u*)(ws + W_DOWN + l * SZ_DOWN + (size_t)NDOWN * D * 2 + (size_t)e * 16) = (v4u){0u, 0u, 0u, 0u}; }
        if (gt < 1024) { const int pos = gt >> 4, j = gt & 15; const float ang = (float)pos * exp2f(-(float)j * (13.287712379549449f / 16.0f));
            ((float*)(ws + WS_CS))[gt] = __cosf(ang); ((float*)(ws + WS_CS))[1024 + gt] = __sinf(ang); }
        for (int rr = F.gw; rr < 2 * 1024; rr += F.NGW) { const int i = rr >> 10, cr = rr & 1023, b = cr >> 8, t = cr & 255; const size_t row = (size_t)NTOK + cr;
            const f32x4 y = *(const f32x4*)(kin(4) + (((size_t)b * 2 + i) * 256 + t) * 256 + F.lane * 4);
            u32x2 w; w.x = pk2(y[0], y[1]); w.y = pk2(y[2], y[3]); *(u32x2*)((bf16*)(ws + SM_CKVN + i * SZ_CKVN) + row * KVL + F.lane * 4) = w;
            const float krv = kin(5)[(((size_t)b * 2 + i) * 256 + t) * 64 + F.lane];
            ((float*)(ws + SM_KR + i * SZ_KR))[row * 64 + F.lane] = krv * (kin(24) + i * 192)[128 + F.lane];
            const float q2 = wave_sum(krv * krv); if (F.lane == 0) ((float*)(ws + SM_KRSQ + i * SZ_KRSQ))[row] = q2; }
        const float* ck = kin(2); const float* cv = kin(3);
        for (int i = gt; i < 2 * 262144; i += NT) { const bool isk = i < 262144; const int e = isk ? i : i - 262144; const float* s = (isk ? ck : cv) + (size_t)e * 8;
            const f32x4 a = *(const f32x4*)s, b = *(const f32x4*)(s + 4); v4u o; o.x = pk2(a[0], a[1]); o.y = pk2(a[2], a[3]); o.z = pk2(b[0], b[1]); o.w = pk2(b[2], b[3]);
            *(v4u*)(ws + (isk ? SM_CK : SM_CV) + (size_t)e * 16) = o; }
        PSTAMP(3);
    }
}

#ifndef MOD_ROWS
#define MOD_ROWS 4
#endif
__device__ __forceinline__ void phase_mod(Frame& F, const float* xc32, const float* xs32, _Float16* X16, const float* g, const float* mod_l, int chunk, bf16* Hb) {
    for (int rb = F.gw; rb < NTOK / 8; rb += F.NGW) {
        const int row0 = rb * 8, cond = row0 < NCTX ? 0 : 1 + ((row0 - NCTX) >> 11);
        const float* sh = mod_l + (size_t)cond * 12288 + chunk * 2048; const float* scl = sh + 2048;
        f32x4 a[8], b[8];
#pragma unroll
        for (int j = 0; j < 8; ++j) { const int c = 4 * (64 * j + F.lane); const f32x4 gv = *(const f32x4*)(g + c), sv = *(const f32x4*)(scl + c); a[j] = gv * (sv + 1.0f); b[j] = *(const f32x4*)(sh + c); }
        if (xc32) {
            for (int rr = 0; rr < 8; rr += 2) {
                f32x4 v[2][8];
#pragma unroll
                for (int q = 0; q < 2; ++q) { const int row = row0 + rr + q; const float* xr = (row < NCTX ? xc32 : xs32) + (size_t)row * D;
#pragma unroll
                    for (int j = 0; j < 8; ++j) v[q][j] = *(const f32x4*)(xr + 4 * (64 * j + F.lane)); }
#pragma unroll
                for (int q = 0; q < 2; ++q) {
                    const int row = row0 + rr + q; _Float16* xh = X16 + (size_t)row * D; float ss = 0.f;
#pragma unroll
                    for (int j = 0; j < 8; ++j) { const h16x4 hv = __builtin_convertvector(v[q][j], h16x4); *(h16x4*)(xh + 4 * (64 * j + F.lane)) = hv; v[q][j] = __builtin_convertvector(hv, f32x4); }
#pragma unroll
                    for (int j = 0; j < 8; ++j) ss += (v[q][j][0] * v[q][j][0] + v[q][j][1] * v[q][j][1]) + (v[q][j][2] * v[q][j][2] + v[q][j][3] * v[q][j][3]);
                    const float rstd = 1.0f / sqrtf(wave_sum(ss) * (1.0f / D) + EPS);
                    bf16* orow = Hb + (size_t)row * D;
#pragma unroll
                    for (int j = 0; j < 8; ++j) { const f32x4 y = v[q][j] * rstd * a[j] + b[j]; u32x2 w; w.x = pk2(y[0], y[1]); w.y = pk2(y[2], y[3]); *(u32x2*)(orow + 4 * (64 * j + F.lane)) = w; }
                }
            }
        } else {
            for (int rr = 0; rr < 8; rr += MOD_ROWS) {
                h16x4 xr[MOD_ROWS][8];
#pragma unroll
                for (int q = 0; q < MOD_ROWS; ++q) { const _Float16* xh = X16 + (size_t)(row0 + rr + q) * D;
#pragma unroll
                    for (int j = 0; j < 8; ++j) xr[q][j] = *(const h16x4*)(xh + 4 * (64 * j + F.lane)); }
#pragma unroll
                for (int q = 0; q < MOD_ROWS; ++q) {
                    f32x4 v[8]; float ss = 0.f;
#pragma unroll
                    for (int j = 0; j < 8; ++j) { v[j] = __builtin_convertvector(xr[q][j], f32x4); ss += (v[j][0] * v[j][0] + v[j][1] * v[j][1]) + (v[j][2] * v[j][2] + v[j][3] * v[j][3]); }
                    const float rstd = 1.0f / sqrtf(wave_sum(ss) * (1.0f / D) + EPS);
                    bf16* orow = Hb + (size_t)(row0 + rr + q) * D;
#pragma unroll
                    for (int j = 0; j < 8; ++j) { const f32x4 y = v[j] * rstd * a[j] + b[j]; u32x2 w; w.x = pk2(y[0], y[1]); w.y = pk2(y[2], y[3]); *(u32x2*)(orow + 4 * (64 * j + F.lane)) = w; }
                }
            }
        }
    }
}

__device__ __forceinline__ void phase_even_conv(Frame& F, int i, const bf16* P, bf16* Cb) {
    const float* cw = kin(16) + (size_t)i * 3 * 1024;
    const int gt = F.vcu * 512 + F.tid, NT = F.G * 512;
    for (int idx = gt; idx < (NTOK / 8) * 128; idx += NT) {
        const int row0 = (idx >> 7) * 8, c = (idx & 127) * 8;
        int t0, L; if (row0 < NCTX) { t0 = row0 & 255; L = 256; } else { t0 = (row0 - NCTX) & 2047; L = 2048; }
        const bf16* pr = P + (size_t)row0 * IN_AB;
        v4u gcv[10], uv[10], gbv[8];
#pragma unroll
        for (int r = 0; r < 10; ++r) { const int tt = t0 + r - 1; const bool ok = tt >= 0 && tt < L; const bf16* p2 = pr + (ptrdiff_t)(r - 1) * IN_AB;
            gcv[r] = ok ? *(const v4u*)(p2 + 4096 + c) : (v4u){0u, 0u, 0u, 0u}; uv[r] = ok ? *(const v4u*)(p2 + 5120 + c) : (v4u){0u, 0u, 0u, 0u}; }
#pragma unroll
        for (int r = 0; r < 8; ++r) gbv[r] = *(const v4u*)(pr + (size_t)r * IN_AB + 3072 + c);
        f32x4 w[3][2];
#pragma unroll
        for (int j = 0; j < 3; ++j) { w[j][0] = *(const f32x4*)(cw + j * 1024 + c); w[j][1] = *(const f32x4*)(cw + j * 1024 + c + 4); }
        f32x4 pa[3][2];
#define CONV_PROD(dst, r) do { const v4u g_ = gcv[r], u_ = uv[r]; dst[0] = (f32x4){bflo(g_.x) * bflo(u_.x), bfhi(g_.x) * bfhi(u_.x), bflo(g_.y) * bflo(u_.y), bfhi(g_.y) * bfhi(u_.y)}; \
            dst[1] = (f32x4){bflo(g_.z) * bflo(u_.z), bfhi(g_.z) * bfhi(u_.z), bflo(g_.w) * bflo(u_.w), bfhi(g_.w) * bfhi(u_.w)}; } while (0)
        CONV_PROD(pa[0], 0); CONV_PROD(pa[1], 1);
#pragma unroll
        for (int r = 0; r < 8; ++r) {
            CONV_PROD(pa[(r + 2) % 3], r + 2);
            const f32x4 a0 = w[0][0] * pa[r % 3][0] + w[1][0] * pa[(r + 1) % 3][0] + w[2][0] * pa[(r + 2) % 3][0];
            const f32x4 a1 = w[0][1] * pa[r % 3][1] + w[1][1] * pa[(r + 1) % 3][1] + w[2][1] * pa[(r + 2) % 3][1];
            const v4u gb = gbv[r];
            v4u o; o.x = pk2(bflo(gb.x) * a0[0], bfhi(gb.x) * a0[1]); o.y = pk2(bflo(gb.y) * a0[2], bfhi(gb.y) * a0[3]); o.z = pk2(bflo(gb.z) * a1[0], bfhi(gb.z) * a1[1]); o.w = pk2(bflo(gb.w) * a1[2], bfhi(gb.w) * a1[3]);
            *(v4u*)(Cb + (size_t)(row0 + r) * D + 1024 + c) = o;
        }
#undef CONV_PROD
    }
}

#ifdef PROBE_SUB
#define PT_ARG , PT
#define PT_PARAM , att::ProbeT& PT
#else
#define PT_ARG
#define PT_PARAM
#endif
__device__ __forceinline__ float wave_max(float v) {
    v = fmaxf(v, __int_as_float(__builtin_amdgcn_ds_swizzle(__float_as_int(v), 0x041F)));
    v = fmaxf(v, __int_as_float(__builtin_amdgcn_ds_swizzle(__float_as_int(v), 0x081F)));
    v = fmaxf(v, __int_as_float(__builtin_amdgcn_ds_swizzle(__float_as_int(v), 0x101F)));
    v = fmaxf(v, __int_as_float(__builtin_amdgcn_ds_swizzle(__float_as_int(v), 0x201F)));
    v = fmaxf(v, __int_as_float(__builtin_amdgcn_ds_swizzle(__float_as_int(v), 0x401F)));
    const auto b = __builtin_amdgcn_permlane32_swap(__float_as_uint(v), __float_as_uint(v), false, false);
    return fmaxf(__uint_as_float(b[0]), __uint_as_float(b[1]));
}
template <int DH> __device__ __forceinline__ float softmax_bound(const float* gq, const float* gk, float scale) {
    const int ln = lane_id_fresh(); float a = 0.f, b = 0.f;
#pragma unroll
    for (int j = 0; j < DH / 64; ++j) { a = fmaxf(a, fabsf(gq[ln + 64 * j])); b = fmaxf(b, fabsf(gk[ln + 64 * j])); }
    a = wave_max(a); b = wave_max(b);
    const float B = (float)DH * a * b * 1.02f;
    return __uint_as_float(__builtin_amdgcn_readfirstlane(__float_as_uint((B * scale <= 40.f && B > 0.f) ? B : 0.f)));
}
__device__ __forceinline__ void phase_even_attn(Frame& F, int i, const bf16* P, bf16* Cb PT_PARAM) {
    const bf16* CK = (const bf16*)(F.ws + SM_CK); const bf16* CV = (const bf16*)(F.ws + SM_CV);
    const float mfix_ctx = softmax_bound<128>(kin(13) + i * 128, kin(14) + i * 128, 0.08838834764831845f);
    for (int u = F.vcu; u < 512; u += F.G) {
        att::AUnit U;
        U.scale = 0.08838834764831845f; U.ldq = IN_AB; U.ldo = D; U.r0 = 0; U.kr_lo = 0; U.rpb = nullptr; U.qsq = nullptr; U.mfix = 0.f;
        if (u < 256) {
            const int b = u >> 3, h = u & 7; const size_t r0 = (size_t)b * 256;
            U.q = P + r0 * IN_AB + h * 128; U.o = Cb + r0 * D + h * 128;
            U.k0 = P + r0 * IN_AB + 1024 + h * 128; U.v0 = P + r0 * IN_AB + 2048 + h * 128; U.ldk0 = IN_AB; U.ldv0 = IN_AB; U.n0 = 4; U.ntiles = 4;
            U.k1 = U.k0; U.v1 = U.v0; U.ldk1 = IN_AB; U.ldv1 = IN_AB; U.mfix = mfix_ctx;
            att::attn_unit<128, false>(U, F.ldsg, F.wave PT_ARG);
        } else {
            const int n = u - 256, b = n >> 6, h = (n >> 3) & 7, rb = n & 7, r0 = 4 * rb;
            const size_t row0 = (size_t)NCTX + (size_t)b * 2048 + (size_t)r0 * 64;
            U.q = P + row0 * IN_AB + h * 128; U.o = Cb + row0 * D + h * 128;
            const size_t coff = ((((size_t)b * 2 + i) * 8 + h) * 256) * 128;
            U.k0 = CK + coff; U.v0 = CV + coff; U.ldk0 = 128; U.ldv0 = 128; U.n0 = 4;
            const int kr_lo = min(max(r0 - 4, 0), 24), kr_hi = min(max(r0 - 1, 0), 24) + 7;
            const size_t krow0 = (size_t)NCTX + (size_t)b * 2048 + (size_t)kr_lo * 64;
            U.k1 = P + krow0 * IN_AB + 1024 + h * 128; U.v1 = P + krow0 * IN_AB + 2048 + h * 128; U.ldk1 = IN_AB; U.ldv1 = IN_AB;
            U.ntiles = 4 + (kr_hi - kr_lo + 1); U.r0 = r0; U.kr_lo = kr_lo; U.rpb = kin(15) + ((size_t)i * 8 + h) * 15 * 31;
            att::attn_unit<128, true>(U, F.ldsg, F.wave PT_ARG);
        }
    }
}
#ifndef PROBE_NT
#define PROBE_NT 36
#endif
__device__ __forceinline__ void phase_odd_attn(Frame& F, const bf16* Qn, const bf16* Kn, const bf16* Vn, bf16* Ob, int probe PT_PARAM) {
    const float mfix = softmax_bound<192>(kin(23) + (F.l >> 1) * 192, kin(24) + (F.l >> 1) * 192, 0.07216878364870323f);
    for (int u0 = F.vcu; u0 < 1024; u0 += F.G) {
        int u = u0;
        if (F.G == 256 && ((F.vcu >> 3) & 1)) { const int kk = u0 >> 8; u = F.vcu + 256 * (kk == 0 ? 2 : kk == 1 ? 0 : kk == 2 ? 1 : 3); }
        att::AUnit U;
        U.scale = 0.07216878364870323f; U.ldq = 3072; U.ldo = D; U.r0 = 0; U.kr_lo = 0; U.rpb = nullptr; U.mfix = mfix;
        U.ldk0 = 3072; U.ldv0 = 2048; U.ldk1 = 3072; U.ldv1 = 2048;
        if (u < 512) {
            const int b = u >> 4, h = u & 15; const size_t r0 = (size_t)b * 256;
            U.q = Qn + r0 * 3072 + h * 192; U.o = Ob + r0 * D + h * 128; U.qsq = (const float*)(F.ws + SM_QSQ) + r0 * 96 + 6 * h;
            U.k0 = Kn + r0 * 3072 + h * 192; U.v0 = Vn + r0 * 2048 + h * 128; U.n0 = 4; U.ntiles = 4; U.k1 = U.k0; U.v1 = U.v0;
        } else {
            const int n = u - 512, b = n >> 7, h = (n >> 3) & 15, qb = n & 7;
            const size_t row0 = (size_t)NCTX + (size_t)b * 2048 + (size_t)qb * 256, kc0 = (size_t)NTOK + (size_t)b * 256, kl0 = (size_t)NCTX + (size_t)b * 2048;
            U.q = Qn + row0 * 3072 + h * 192; U.o = Ob + row0 * D + h * 128; U.qsq = (const float*)(F.ws + SM_QSQ) + row0 * 96 + 6 * h;
            U.k0 = Kn + kc0 * 3072 + h * 192; U.v0 = Vn + kc0 * 2048 + h * 128; U.n0 = 4;
            U.k1 = Kn + kl0 * 3072 + h * 192; U.v1 = Vn + kl0 * 2048 + h * 128; U.ntiles = probe ? PROBE_NT : 36;
        }
        att::attn_unit<192, false>(U, F.ldsg, F.wave PT_ARG);
    }
}

struct Args { const float* in[28]; float* out; unsigned char* ws; int ph_lo, ph_hi; };
constexpr int PH_END = 1 + DEPTH * 10;
__host__ __device__ constexpr int pid(int l, int s) { return 1 + l * 10 + s; }

__global__ void __launch_bounds__(NWAVES * 64, 2) fwd_kernel(Args args) {
    extern __shared__ __attribute__((aligned(16))) unsigned char lds[];
    Frame F;
    F.lds = (LAS unsigned char*)lds; F.ldsg = (char*)lds;
    F.tid = threadIdx.x; F.lane = F.tid & 63; F.wave = __builtin_amdgcn_readfirstlane(F.tid >> 6);
    F.G = gridDim.x; { const int bx = blockIdx.x; F.vcu = (F.G % 8 == 0) ? (bx % 8) * (F.G / 8) + bx / 8 : bx; }
    F.gw = F.vcu * NWAVES + F.wave; F.NGW = F.G * NWAVES;
    F.out = (GAS float*)args.out; F.ws = (GAS unsigned char*)args.ws; F.l = 0;
    unsigned char* ws = args.ws;
    for (int u = F.tid; u < (LDS_BYTES - LDSCTL_OFF) / 4; u += NWAVES * 64) ((LAS unsigned*)(F.lds + LDSCTL_OFF))[u] = 0u;
    __syncthreads();
    const int lo = args.ph_lo, hi = args.ph_hi;
    XcdBarrier bar; bar.bar = (unsigned*)(ws + WS_CTL) + CW_BAR; bar.x = 0; bar.st = nullptr;
    if (hi - lo > 1) bar = xcd_barrier_post((unsigned*)(ws + WS_CTL) + CW_BAR, (volatile LAS unsigned*)(F.lds + LDSCTL_OFF) + 8);
#ifndef PH_MASK
#define PH_MASK 0xFFFF
#endif
#define EN(k) ((PH_MASK >> (k)) & 1)
#ifndef REP_MASK
#define REP_MASK 0
#endif
#define REPS(k) for (int rep_ = 0; rep_ < 1 + ((REP_MASK >> (k)) & 1); ++rep_)
#define RUN(p) (lo <= (p) && (p) < hi && fresh(F))
#ifdef PROBE_SUB
    att::ProbeT PT; PT.acc = 0; PT.last = 0; PT.state = -1;
#ifdef PROBE_SUB_EVEN
#define PT_ARG_E , PT
#else
#define PT_ARG_E , PTdummy
    att::ProbeT PTdummy; PTdummy.acc = 0; PTdummy.last = 0; PTdummy.state = -1;
#endif
#else
#define PT_ARG_E
#endif
#ifdef PROBE_SLOT
#ifndef PROBE_MULT
#define PROBE_MULT 4
#endif
    unsigned long long t_last_ = rt(), t_acc_ = 0;
#define STAMP(p) do { const unsigned long long now_ = rt(); const int s_ = (p) == 0 ? 99 : (((p) - 1) % 10) + 10 * ((((p) - 1) / 10) & 1); if (s_ == PROBE_SLOT || (PROBE_SLOT >= 100 && (s_ % 10) == (PROBE_SLOT - 100) && s_ != 99)) t_acc_ += now_ - t_last_; t_last_ = now_; } while (0)
#else
#define STAMP(p) do { } while (0)
#endif
#ifdef DOUBLE_BAR
#define SEAM(p) do { if ((p) + 1 < hi) { xcd_barrier(bar); xcd_barrier(bar); } STAMP(p); } while (0)
#else
#define SEAM(p) do { if ((p) + 1 < hi) xcd_barrier(bar); STAMP(p); } while (0)
#endif

#define WSP (F.ws)
#define XP ((float*)(F.out + O_X))
#define MODL ((const float*)(WSP + WS_MOD) + (size_t)F.l * 5 * 12288)
#define HB ((bf16*)(WSP + WS_H))
#define CB ((bf16*)(WSP + WS_C))
#define FB ((bf16*)(WSP + B_F))
#define X16P ((_Float16*)(WSP + WS_X16))

#define REDP ((PG8_LAS float*)(F.lds + LDSCTL_OFF + 1024))

    REPS(0) if (EN(0) && RUN(0)) { phase_prologue(F); SEAM(0); }

    for (int l = 0; l < DEPTH; ++l) {
        F.l = l;
        if (EN(1) && RUN(pid(l, 0))) {
            const float* xc = F.l == 0 ? kin(0) : (const float*)nullptr; const float* xs = F.l == 0 ? kin(1) - (size_t)NCTX * D : (const float*)nullptr;
            phase_mod(F, xc, xs, X16P, kin(8) + (size_t)F.l * D, MODL, 0, HB); SEAM(pid(l, 0)); }
        if ((l & 1) == 0) {
            REPS(2) if (EN(2) && RUN(pid(l, 1))) {
                const int i = F.l >> 1; bf16* P = (bf16*)(WSP + B_P);
                pg8::Gemm g{HB, (const bf16*)(WSP + W_IN_AB + i * SZ_IN_AB), NTOK, IN_AB, D}; pg8::StaticOrder S; S.init(NTOK, IN_AB, F.G, (int)blockIdx.x); S.ilv = true;
                pg8::EpiInAB E{P, kin(13) + i * 128, kin(14) + i * 128, (float*)(F.out + O_NATK + (size_t)i * 8 * 32768), (float*)(F.out + O_NATV + (size_t)i * 8 * 32768), REDP};
                pg8::gemm_phase<pg8::EpiInAB, pg8::StaticOrder, true, true>(F.lds, g, S, E, F.wave);
                SEAM(pid(l, 1));
            }
            REPS(4) if (EN(4) && RUN(pid(l, 5))) { const int i = F.l >> 1; bf16* P = (bf16*)(WSP + B_P);
                if ((F.vcu >> 3) & 1) { phase_even_conv(F, i, P, CB); fresh(F); phase_even_attn(F, i, P, CB PT_ARG_E); }
                else { phase_even_attn(F, i, P, CB PT_ARG_E); fresh(F); phase_even_conv(F, i, P, CB); }
                SEAM(pid(l, 5)); }
        } else {
            REPS(5) if (EN(5) && RUN(pid(l, 1))) {
                const int i = F.l >> 1;
                pg8::Gemm g{HB, (const bf16*)(WSP + W_DOWN + i * SZ_DOWN), NTOK, NDOWN_P, D}; pg8::StaticOrder S; S.init(NTOK, NDOWN_P, F.G, (int)blockIdx.x);
                pg8::EpiDown E{(bf16*)(WSP + SM_CQN), (float*)(WSP + SM_CQP), (bf16*)(WSP + SM_CKVN + i * SZ_CKVN), kin(20) + i * KVL, (float*)(F.out + O_CKV + (size_t)i * 65536), (float*)(F.out + O_KR + (size_t)i * 16384),
                               kin(24) + i * 192 + 128, (float*)(WSP + SM_KR + i * SZ_KR), (float*)(WSP + SM_KRSQ + i * SZ_KRSQ), REDP};
                pg8::gemm_phase<pg8::EpiDown, pg8::StaticOrder, true, true>(F.lds, g, S, E, F.wave);
                SEAM(pid(l, 1));
            }
            REPS(7) if (EN(7) && RUN(pid(l, 3))) {
                { const int i = F.l >> 1;
                  pg8::Gemm g{(const bf16*)(WSP + SM_CQN), (const bf16*)(WSP + W_UQ + i * SZ_UQ), NTOK, 3072, QL}; pg8::StaticOrder S; S.init(NTOK, 3072, F.G, (int)blockIdx.x);
                  pg8::EpiUQ E{(bf16*)(WSP + B_QC), kin(23) + i * 192, (const float*)(WSP + SM_CQP), (float*)(WSP + SM_QSQ)};
#ifndef NO_UQ
                  pg8::gemm_phase<pg8::EpiUQ, pg8::StaticOrder, true, true>(F.lds, g, S, E, F.wave);
#endif
                }
                fresh(F);
                { const int i = F.l >> 1;
                  pg8::Gemm g{(const bf16*)(WSP + SM_CKVN + i * SZ_CKVN), (const bf16*)(WSP + W_UKV + i * SZ_UKV), NKVROWS, 4096, KVL}; pg8::StaticOrder S; S.init(NKVROWS, 4096, F.G, (int)blockIdx.x);
                  pg8::EpiUKV E{(bf16*)(WSP + B_KN), (bf16*)(WSP + B_KV), kin(24) + i * 192, (const float*)(WSP + SM_KR + i * SZ_KR), (const float*)(WSP + SM_KRSQ + i * SZ_KRSQ), REDP};
#ifndef NO_UKV
                  pg8::gemm_phase<pg8::EpiUKV, pg8::StaticOrder, true, true>(F.lds, g, S, E, F.wave);
#endif
                }
                SEAM(pid(l, 3));
            }
            REPS(9) if (EN(9) && RUN(pid(l, 5))) { phase_odd_attn(F, (const bf16*)(WSP + B_QC), (const bf16*)(WSP + B_KN), (const bf16*)(WSP + B_KV), rep_ == 0 ? CB : (bf16*)(WSP + WS_BIG + 420 * MiB), rep_ PT_ARG); SEAM(pid(l, 5)); }
        }
        REPS(10) if (EN(10) && RUN(pid(l, 6))) {
            const int i = F.l >> 1;
            const bf16* Wt = (F.l & 1) ? (const bf16*)(WSP + W_O + i * SZ_DD) : (const bf16*)(WSP + W_OUT_AB + i * SZ_DD);
            pg8::Gemm g{CB, Wt, NTOK, D, D}; pg8::StaticOrder S; S.init(NTOK, D, F.G, (int)blockIdx.x);
            pg8::EpiYX E{rep_ == 0 ? X16P : (_Float16*)(WSP + WS_BIG + 320 * MiB), MODL + 2 * 2048};
            pg8::gemm_phase<pg8::EpiYX, pg8::StaticOrder, true, true>(F.lds, g, S, E, F.wave);
            SEAM(pid(l, 6));
        }
        REPS(11) if (EN(11) && RUN(pid(l, 7))) {
            phase_mod(F, (const float*)nullptr, (const float*)nullptr, X16P, kin(9) + (size_t)F.l * D, MODL, 3, HB); SEAM(pid(l, 7)); }
        REPS(12) if (EN(12) && RUN(pid(l, 8))) {
            pg8::Gemm g{HB, (const bf16*)(WSP + W_FFN_IN + F.l * SZ_FFN_IN), NTOK, 2 * DFF, D}; pg8::StaticOrder S; S.init(NTOK, 2 * DFF, F.G, (int)blockIdx.x);
            pg8::EpiSwiGLU E{FB, DFF};
            pg8::gemm_phase<pg8::EpiSwiGLU, pg8::StaticOrder, true, true>(F.lds, g, S, E, F.wave);
            SEAM(pid(l, 8));
        }
        if (EN(13) && RUN(pid(l, 9))) {
            pg8::Gemm g{FB, (const bf16*)(WSP + W_FFN_OUT + F.l * SZ_FFN_OUT), NTOK, D, DFF}; pg8::StaticOrder S; S.init(NTOK, D, F.G, (int)blockIdx.x);
            if (F.l == DEPTH - 1) { pg8::EpiRes E{X16P, XP, MODL + 5 * 2048};
                pg8::gemm_phase<pg8::EpiRes, pg8::StaticOrder, true, true>(F.lds, g, S, E, F.wave); }
            else { pg8::EpiYX E{X16P, MODL + 5 * 2048};
                pg8::gemm_phase<pg8::EpiYX, pg8::StaticOrder, true, true>(F.lds, g, S, E, F.wave); }
            SEAM(pid(l, 9));
        }
    }
#ifdef PROBE_SUB
    if (blockIdx.x == 0) { const unsigned long long t0_ = rt(); while (rt() - t0_ < 4ull * PT.acc) __builtin_amdgcn_s_sleep(8); }
#endif
#ifdef PROBE_PRO
    if (blockIdx.x == 0) { const unsigned long long t0_ = rt(); while (rt() - t0_ < 8ull * F.pacc) __builtin_amdgcn_s_sleep(8); }
#endif
#ifdef PROBE_SLOT
    if (blockIdx.x == 0) { const unsigned long long t0_ = rt(); while (rt() - t0_ < (unsigned long long)PROBE_MULT * t_acc_) __builtin_amdgcn_s_sleep(8); }
#endif
#undef RUN
#undef SEAM
}

#ifndef MK_ONE_LAUNCH
#define MK_ONE_LAUNCH 1
#endif
extern "C" void kernel_launch(void* const* d_in, const int* in_sizes, int n_in, void* d_out, int out_size, void* d_ws, size_t ws_size, hipStream_t stream) {
    static int grid = 0;
    if (grid == 0) {
        if (n_in != 28 || (size_t)out_size != O_END || ws_size < WS_END) { fprintf(stderr, "kernel_launch: unexpected shapes: n_in %d out %d ws %zu (need %zu)\n", n_in, out_size, ws_size, (size_t)WS_END); grid = -1; return; }
        int dev = 0, cus = 0, per_cu = 0;
        if (hipGetDevice(&dev) != hipSuccess || hipDeviceGetAttribute(&cus, hipDeviceAttributeMultiprocessorCount, dev) != hipSuccess) { grid = -1; return; }
        if (hipFuncSetAttribute((const void*)fwd_kernel, hipFuncAttributeMaxDynamicSharedMemorySize, LDS_BYTES) != hipSuccess) { fprintf(stderr, "kernel_launch: hipFuncSetAttribute failed\n"); grid = -1; return; }
        if (hipOccupancyMaxActiveBlocksPerMultiprocessor(&per_cu, (const void*)fwd_kernel, NWAVES * 64, LDS_BYTES) != hipSuccess || per_cu < 1) { fprintf(stderr, "kernel_launch: occupancy query says %d blocks per CU\n", per_cu); }
        (void)hipGetLastError();
        grid = cus;
    }
    if (grid < 0) return;
    (void)in_sizes;
    if (hipMemsetAsync((char*)d_ws + WS_CTL, 0, CTL_ZERO_BYTES, stream) != hipSuccess) { fprintf(stderr, "kernel_launch: memset failed\n"); return; }
    Args a{};
    for (int k = 0; k < 28; ++k) a.in[k] = (const float*)d_in[k];
    a.out = (float*)d_out; a.ws = (unsigned char*)d_ws;
#if MK_ONE_LAUNCH
    a.ph_lo = 0; a.ph_hi = PH_END;
    hipLaunchKernelGGL(fwd_kernel, dim3(grid), dim3(NWAVES * 64), LDS_BYTES, stream, a);
#else
    for (int p = 0; p < PH_END; ++p) {
        if (p > 0) { const int l = (p - 1) / 10, s = (p - 1) % 10; if ((l & 1) == 0 && (s == 2 || s == 3 || s == 4)) continue; if ((l & 1) == 1 && (s == 2 || s == 4)) continue; }
        a.ph_lo = p; a.ph_hi = p + 1;
        hipLaunchKernelGGL(fwd_kernel, dim3(grid), dim3(NWAVES * 64), LDS_BYTES, stream, a);
    }
#endif
    const hipError_t le = hipPeekAtLastError();
    if (le != hipSuccess) fprintf(stderr, "kernel_launch: launch failed: %s\n", hipGetErrorName(le));
}
```
